# Optimizing an MI355X kernel written in HIP

```python
import jax, jax.numpy as jnp
from jax import lax
import numpy as np

D_MODEL = 1024
BATCH = 8
SEQ = 2048
DEPTH = 1
DEC_BATCH = 128
DEC_SEQ = 4
PAST_LEN = 16384
PAGE_SIZE = 128

C_A = D_MODEL
C_B = D_MODEL
CONV_A_W = 31
CHUNK = 128
H_B = 8
HD_B = C_B // H_B
D_FF = ((8 * D_MODEL // 3 + 127) // 128) * 128
CONV_F_W = 3
EPS = 1e-6
N_IN = 2 * C_A + 2 * C_B + 2 * D_MODEL

kernel_name = "hybrid_conformer_conv_chunk_gmlp_convffn_step"


def _rmsnorm(x, g):
    xf = x.astype(jnp.float32)
    y = xf * lax.rsqrt(jnp.mean(xf * xf, axis=-1, keepdims=True) + EPS)
    return (y * g.astype(jnp.float32)).astype(x.dtype)


def _layernorm(x, g, b):
    xf = x.astype(jnp.float32)
    mu = jnp.mean(xf, axis=-1, keepdims=True)
    xc = xf - mu
    var = jnp.mean(xc * xc, axis=-1, keepdims=True)
    y = xc * lax.rsqrt(var + EPS) * g.astype(jnp.float32) + b.astype(jnp.float32)
    return y.astype(x.dtype)


def _causal_dwconv(x_full, w, b):
    c = x_full.shape[-1]
    out = lax.conv_general_dilated(
        x_full, w[:, None, :].astype(x_full.dtype), window_strides=(1,), padding='VALID',
        dimension_numbers=('NWC', 'WIO', 'NWC'), feature_group_count=c)
    return out + b.astype(out.dtype)


def _chunk_spatial_mix(v, w_s, b_s):
    n, t, c = v.shape
    L = min(t, CHUNK)
    t_pad = -(-t // L) * L
    if t_pad != t:
        v = jnp.pad(v, ((0, 0), (0, t_pad - t), (0, 0)))
    nc = t_pad // L
    vh = v.reshape(n, nc, L, H_B, HD_B)
    mask = jnp.tril(jnp.ones((L, L), dtype=bool))
    w = jnp.where(mask[None], w_s[:, :L, :L], 0.0).astype(v.dtype)
    bias = jnp.transpose(b_s[:, :L])[None, None, :, :, None].astype(v.dtype)
    s = jnp.einsum('hts,ncshd->ncthd', w, vh) + bias
    return s.reshape(n, t_pad, c)[:, :t]


def _token_mixers(xn, conv_prev, w_in, dw_a, b_dw_a, ln_a_g, ln_a_b, w_a_out,
                  ln_b_g, ln_b_b, w_s, b_s, w_b_out, w_out):
    proj = xn @ w_in.astype(xn.dtype)
    pa, pb, pg = jnp.split(proj, [2 * C_A, 2 * C_A + 2 * C_B], axis=-1)
    a_val, a_gate = jnp.split(pa, 2, axis=-1)
    glu = a_val * jax.nn.sigmoid(a_gate)
    glu_full = jnp.concatenate([conv_prev.astype(glu.dtype), glu], axis=1)
    conv_new = glu_full[:, -(CONV_A_W - 1):]
    ca = _causal_dwconv(glu_full, dw_a, b_dw_a)
    y_a = jax.nn.silu(_layernorm(ca, ln_a_g, ln_a_b)) @ w_a_out.astype(xn.dtype)
    z = jax.nn.gelu(pb, approximate=False)
    u, v = jnp.split(z, 2, axis=-1)
    v_n = _layernorm(v, ln_b_g, ln_b_b)
    y_b = (u * _chunk_spatial_mix(v_n, w_s, b_s)) @ w_b_out.astype(xn.dtype)
    g_a, g_b = jnp.split(jax.nn.sigmoid(pg), 2, axis=-1)
    out = (g_a * y_a + g_b * y_b) @ w_out.astype(xn.dtype)
    return out, conv_new, v_n


def _conv_ffn(xn, ffn_prev, w_up, dw_f, b_dw_f, w_down):
    h = xn @ w_up.astype(xn.dtype)
    a, b = jnp.split(h, 2, axis=-1)
    a_full = jnp.concatenate([ffn_prev.astype(a.dtype), a], axis=1)
    ffn_new = a_full[:, -(CONV_F_W - 1):]
    ac = _causal_dwconv(a_full, dw_f, b_dw_f)
    return (jax.nn.gelu(ac, approximate=False) * b) @ w_down.astype(xn.dtype), ffn_new


def setup_inputs(seed: int = 0) -> dict:
    key = jax.random.key(seed)
    ks = jax.random.split(key, 24)
    f32 = jnp.float32
    nrm = lambda k, shape, s: jax.random.normal(k, shape, f32) * s
    return {
        "x_prompt": nrm(ks[0], (BATCH, SEQ, D_MODEL), 1.0),
        "x_sample": nrm(ks[1], (DEC_BATCH, DEC_SEQ, D_MODEL), 1.0),
        "state_conv_a": nrm(ks[2], (DEPTH, DEC_BATCH, CONV_A_W - 1, C_A), 0.5),
        "state_ffn_conv": nrm(ks[3], (DEPTH, DEC_BATCH, CONV_F_W - 1, D_FF), 1.0),
        "g_mix": 1.0 + nrm(ks[4], (DEPTH, D_MODEL), 0.02),
        "w_in": nrm(ks[5], (DEPTH, D_MODEL, N_IN), D_MODEL ** -0.5),
        "dw_a": nrm(ks[6], (DEPTH, CONV_A_W, C_A), CONV_A_W ** -0.5),
        "b_dw_a": nrm(ks[7], (DEPTH, C_A), 0.01),
        "ln_a_g": 1.0 + nrm(ks[8], (DEPTH, C_A), 0.02),
        "ln_a_b": nrm(ks[9], (DEPTH, C_A), 0.01),
        "w_a_out": nrm(ks[10], (DEPTH, C_A, D_MODEL), C_A ** -0.5),
        "ln_b_g": 1.0 + nrm(ks[11], (DEPTH, C_B), 0.02),
        "ln_b_b": nrm(ks[12], (DEPTH, C_B), 0.01),
        "w_s": nrm(ks[13], (DEPTH, H_B, CHUNK, CHUNK), CHUNK ** -0.5),
        "b_s": 1.0 + nrm(ks[14], (DEPTH, H_B, CHUNK), 0.01),
        "w_b_out": nrm(ks[15], (DEPTH, C_B, D_MODEL), C_B ** -0.5),
        "w_out": nrm(ks[16], (DEPTH, D_MODEL, D_MODEL), D_MODEL ** -0.5),
        "g_ffn": 1.0 + nrm(ks[17], (DEPTH, D_MODEL), 0.02),
        "w_up": nrm(ks[18], (DEPTH, D_MODEL, 2 * D_FF), D_MODEL ** -0.5),
        "dw_f": nrm(ks[19], (DEPTH, CONV_F_W, D_FF), CONV_F_W ** -0.5),
        "b_dw_f": nrm(ks[20], (DEPTH, D_FF), 0.01),
        "w_down": nrm(ks[21], (DEPTH, D_FF, D_MODEL), D_FF ** -0.5),
        "g_final": 1.0 + nrm(ks[22], (D_MODEL,), 0.02),
    }


def reference(x_prompt, x_sample, state_conv_a, state_ffn_conv, g_mix, w_in, dw_a, b_dw_a,
              ln_a_g, ln_a_b, w_a_out, ln_b_g, ln_b_b, w_s, b_s, w_b_out, w_out,
              g_ffn, w_up, dw_f, b_dw_f, w_down, g_final):
    hp, hs = x_prompt, x_sample
    nb = x_prompt.shape[0]
    conv_p_list, conv_s_list, v_s_list, ffn_p_list, ffn_s_list = [], [], [], [], []
    for l in range(DEPTH):
        mix_w = (w_in[l], dw_a[l], b_dw_a[l], ln_a_g[l], ln_a_b[l], w_a_out[l],
                 ln_b_g[l], ln_b_b[l], w_s[l], b_s[l], w_b_out[l], w_out[l])
        ffn_w = (w_up[l], dw_f[l], b_dw_f[l], w_down[l])
        zero_conv = jnp.zeros((nb, CONV_A_W - 1, C_A), hp.dtype)
        zero_ffn = jnp.zeros((nb, CONV_F_W - 1, D_FF), hp.dtype)
        mp, conv_p, _ = _token_mixers(_rmsnorm(hp, g_mix[l]), zero_conv, *mix_w)
        hp = hp + mp
        fp, ffn_p = _conv_ffn(_rmsnorm(hp, g_ffn[l]), zero_ffn, *ffn_w)
        hp = hp + fp
        ms, conv_s, v_s = _token_mixers(_rmsnorm(hs, g_mix[l]), state_conv_a[l], *mix_w)
        hs = hs + ms
        fs, ffn_s = _conv_ffn(_rmsnorm(hs, g_ffn[l]), state_ffn_conv[l], *ffn_w)
        hs = hs + fs
        conv_p_list.append(conv_p)
        conv_s_list.append(conv_s)
        v_s_list.append(v_s)
        ffn_p_list.append(ffn_p)
        ffn_s_list.append(ffn_s)
    y_prompt = _rmsnorm(hp, g_final)
    y_sample = _rmsnorm(hs, g_final)
    new_conv_a_prompt = jnp.stack(conv_p_list, axis=0)
    new_conv_a_sample = jnp.stack(conv_s_list, axis=0)
    new_chunk_v_sample = jnp.stack(v_s_list, axis=0)
    new_ffn_conv_prompt = jnp.stack(ffn_p_list, axis=0)
    new_ffn_conv_sample = jnp.stack(ffn_s_list, axis=0)
    return (y_prompt, y_sample, new_conv_a_prompt, new_conv_a_sample, new_chunk_v_sample,
            new_ffn_conv_prompt, new_ffn_conv_sample)
```

```cpp
#include <hip/hip_runtime.h>
#include <hip/hip_cooperative_groups.h>
#include <cstdio>
#include <cstdint>
namespace cg = cooperative_groups;
namespace pg8 {
#define PG8_LAS __attribute__((address_space(3)))
typedef unsigned short bf16_t;
typedef short bf16x8 __attribute__((ext_vector_type(8)));
typedef float f32x4 __attribute__((ext_vector_type(4)));
typedef unsigned u32x4 __attribute__((ext_vector_type(4)));
constexpr int BM = 256, BK = 64, HALF = 128, HTB = HALF * BK * 2  , STAGE_BYTES = 8 * HTB, NXCD = 8, WGM = 8;

__host__ __device__ __forceinline__ int lds_byte(int r, int c) { const int st = (r >> 4) * 2 + (c >> 5), rr = r & 15, cc = c & 31, ob = rr * 64 + cc * 2; return st * 1024 + (ob ^ (((ob >> 9) & 1) << 5)); }
__host__ __device__ __forceinline__ void stage_rc(int b, int& R, int& C) { const int st = b / 1024, sb = b % 1024, swz = sb ^ (((sb >> 9) & 1) << 5); R = (st >> 1) * 16 + swz / 64; C = (st & 1) * 32 + (swz % 64) / 2; }
__host__ __device__ __forceinline__ int perm32(int rho) { const int n = rho >> 4, i = rho & 15; return 8 * (i >> 2) + 4 * n + (i & 3); }

struct Unit { int pm, pn; };
struct Gemm { const bf16_t* A; const bf16_t* Bt; int M, N, K, lda; };

struct StaticOrder {
    int nM, nN, nwg, G, c;
    __host__ __device__ void init(int M, int N, int G_, int c_) { nM = M / BM; nN = N / BM; nwg = nM * nN; G = G_; c = c_; }
    __host__ __device__ bool next(int i, Unit& u) const {
        const long L = (long)i * G + c; if (L >= nwg) return false;
        int wgid = (int)L; { const int q = nwg / NXCD, r = nwg % NXCD, xcd = wgid % NXCD, off = wgid / NXCD; wgid = (xcd < r ? xcd * (q + 1) : r * (q + 1) + (xcd - r) * q) + off; }
        const int nig = WGM * nN, gid = wgid / nig, fm = gid * WGM, gsz = (nM - fm) < WGM ? (nM - fm) : WGM;
        u.pm = fm + ((wgid % nig) % gsz); u.pn = (wgid % nig) / gsz; return true;
    }
    __device__ __forceinline__ void a_ready(const Unit&) const {}
    __device__ __forceinline__ void done(const Unit&) const {}
};

__device__ __forceinline__ unsigned cvt_pk_bf16(float lo, float hi) { unsigned r; asm volatile("v_cvt_pk_bf16_f32 %0, %1, %2" : "=v"(r) : "v"(lo), "v"(hi)); return r; }
typedef float f32x2 __attribute__((ext_vector_type(2)));
__device__ __forceinline__ f32x2 gelu_pk(f32x2 v) {
    const f32x2 av = __builtin_elementwise_abs(v), d = av * 0.2316418882f + 1.0f;
    f32x2 t; t.x = __builtin_amdgcn_rcpf(d.x); t.y = __builtin_amdgcn_rcpf(d.y);
    f32x2 q = t * 0.5307027145f + (-0.7265760135f); q = q * t + 0.7107068705f; q = q * t + (-0.142248368f); q = q * t + 0.127414796f; q = q * t;
    const f32x2 s = (v * v) * (-0.72134752044f);
    f32x2 e; e.x = __builtin_amdgcn_exp2f(s.x); e.y = __builtin_amdgcn_exp2f(s.y);
    const f32x2 m = v * (q * e), r = v - m;
    f32x2 o; o.x = v.x < 0.f ? m.x : r.x; o.y = v.y < 0.f ? m.y : r.y; return o;
}
typedef unsigned u32x2 __attribute__((ext_vector_type(2)));
__device__ __forceinline__ float sigm(float x) { return __builtin_amdgcn_rcpf(1.0f + __builtin_amdgcn_exp2f(x * -1.44269504089f)); }
__device__ __forceinline__ float bf_lo(unsigned u) { return __uint_as_float(u << 16); }
__device__ __forceinline__ float bf_hi(unsigned u) { return __uint_as_float(u & 0xffff0000u); }

struct EpiG1 {
    static constexpr bool PERM = true, AFTER_DRAIN = false;
    bf16_t* GLU; bf16_t* UV; bf16_t* GG;
    __device__ __forceinline__ void operator()(const f32x4 (&acc)[2][2][4][2], const Unit& u, int wr, int wc, int fr, int fq) const {
        const int row0 = u.pm * BM + wr * 64 + fr;
        if (u.pn < 8) {
            const int col = u.pn * 128 + wc * 32 + 8 * fq;
#pragma unroll
            for (int ai = 0; ai < 2; ++ai)
#pragma unroll
                for (int m = 0; m < 4; ++m) {
                    const f32x4 v0 = acc[ai][0][m][0], v1 = acc[ai][0][m][1], g0 = acc[ai][1][m][0], g1 = acc[ai][1][m][1];
                    u32x4 w; w.x = cvt_pk_bf16(v0[0] * sigm(g0[0]), v0[1] * sigm(g0[1])); w.y = cvt_pk_bf16(v0[2] * sigm(g0[2]), v0[3] * sigm(g0[3]));
                    w.z = cvt_pk_bf16(v1[0] * sigm(g1[0]), v1[1] * sigm(g1[1])); w.w = cvt_pk_bf16(v1[2] * sigm(g1[2]), v1[3] * sigm(g1[3]));
                    *(u32x4*)(GLU + (size_t)(row0 + ai * HALF + m * 16) * 1024 + col) = w; }
        } else {
            const bool isg = u.pn < 16;
            bf16_t* base = isg ? UV : GG;
            const int col0 = (isg ? (u.pn - 8) : (u.pn - 16)) * BM + wc * 32 + 8 * fq;
#pragma unroll
            for (int ai = 0; ai < 2; ++ai)
#pragma unroll
                for (int m = 0; m < 4; ++m) { bf16_t* rowp = base + (size_t)(row0 + ai * HALF + m * 16) * 2048 + col0;
#pragma unroll
                    for (int bj = 0; bj < 2; ++bj) { f32x4 v0 = acc[ai][bj][m][0], v1 = acc[ai][bj][m][1];
                        if (isg) { f32x2 a = gelu_pk((f32x2){v0[0], v0[1]}), b = gelu_pk((f32x2){v0[2], v0[3]}), c = gelu_pk((f32x2){v1[0], v1[1]}), d = gelu_pk((f32x2){v1[2], v1[3]});
                            v0 = (f32x4){a.x, a.y, b.x, b.y}; v1 = (f32x4){c.x, c.y, d.x, d.y}; }
                        else { v0 = (f32x4){sigm(v0[0]), sigm(v0[1]), sigm(v0[2]), sigm(v0[3])}; v1 = (f32x4){sigm(v1[0]), sigm(v1[1]), sigm(v1[2]), sigm(v1[3])}; }
                        u32x4 w; w.x = cvt_pk_bf16(v0[0], v0[1]); w.y = cvt_pk_bf16(v0[2], v0[3]); w.z = cvt_pk_bf16(v1[0], v1[1]); w.w = cvt_pk_bf16(v1[2], v1[3]);
                        *(u32x4*)(rowp + bj * HALF) = w; } }
        }
    }
};
template <int MODE> struct EpiMerge {
    static constexpr bool PERM = true, AFTER_DRAIN = false;
    bf16_t* MG; const bf16_t* GG;
    __device__ __forceinline__ void operator()(const f32x4 (&acc)[2][2][4][2], const Unit& u, int wr, int wc, int fr, int fq) const {
        const int row0 = u.pm * BM + wr * 64 + fr, col0 = u.pn * BM + wc * 32 + 8 * fq;
#pragma unroll
        for (int ai = 0; ai < 2; ++ai)
#pragma unroll
            for (int m = 0; m < 4; ++m) { const size_t row = (size_t)(row0 + ai * HALF + m * 16);
#pragma unroll
                for (int bj = 0; bj < 2; ++bj) { const int col = col0 + bj * HALF;
                    const u32x4 g = *(const u32x4*)(GG + row * 2048 + MODE * 1024 + col);
                    f32x4 v0 = acc[ai][bj][m][0], v1 = acc[ai][bj][m][1];
                    v0 = v0 * (f32x4){bf_lo(g.x), bf_hi(g.x), bf_lo(g.y), bf_hi(g.y)}; v1 = v1 * (f32x4){bf_lo(g.z), bf_hi(g.z), bf_lo(g.w), bf_hi(g.w)};
                    if (MODE == 1) { const u32x4 p = *(const u32x4*)(MG + row * 1024 + col);
                        v0 = v0 + (f32x4){bf_lo(p.x), bf_hi(p.x), bf_lo(p.y), bf_hi(p.y)}; v1 = v1 + (f32x4){bf_lo(p.z), bf_hi(p.z), bf_lo(p.w), bf_hi(p.w)}; }
                    u32x4 w; w.x = cvt_pk_bf16(v0[0], v0[1]); w.y = cvt_pk_bf16(v0[2], v0[3]); w.z = cvt_pk_bf16(v1[0], v1[1]); w.w = cvt_pk_bf16(v1[2], v1[3]);
                    *(u32x4*)(MG + row * 1024 + col) = w; }
                asm volatile("" ::: "memory"); }
    }
};
struct EpiRes {
    static constexpr bool PERM = false, AFTER_DRAIN = false;
    const float* R0; const float* R1; int msplit; float* Y; bf16_t* YB; float* ss;
    __device__ __forceinline__ void operator()(const f32x4 (&acc)[2][2][4][2], const Unit& u, int wr, int wc, int fr, int fq) const {
        const int row0 = u.pm * BM + wr * 64 + fr, col0 = u.pn * BM + wc * 32 + 4 * fq;
        const float* rb = (u.pm * BM < msplit) ? R0 : (R1 - (size_t)msplit * 1024);
#pragma unroll
        for (int ai = 0; ai < 2; ++ai)
#pragma unroll
            for (int m = 0; m < 4; ++m) { const size_t row = (size_t)(row0 + ai * HALF + m * 16); float s = 0.f;
#pragma unroll
                for (int bj = 0; bj < 2; ++bj)
#pragma unroll
                    for (int n = 0; n < 2; ++n) { const size_t off = row * 1024 + col0 + bj * HALF + n * 16;
                        const f32x4 h = *(const f32x4*)(rb + off) + acc[ai][bj][m][n];
                        *(f32x4*)(Y + off) = h; s += (h[0] * h[0] + h[1] * h[1]) + (h[2] * h[2] + h[3] * h[3]);
                        if (YB) { u32x2 w; w.x = cvt_pk_bf16(h[0], h[1]); w.y = cvt_pk_bf16(h[2], h[3]); *(u32x2*)(YB + off) = w; } }
                s += __shfl_xor(s, 16); s += __shfl_xor(s, 32);
                if (fq == 0) atomicAdd(ss + row, s);
                asm volatile("" ::: "memory"); }
    }
};
struct EpiUp {
    static constexpr bool PERM = true, AFTER_DRAIN = false;
    bf16_t* AB; const float* ss; int ldc;
    __device__ __forceinline__ void operator()(const f32x4 (&acc)[2][2][4][2], const Unit& u, int wr, int wc, int fr, int fq) const {
        const int row0 = u.pm * BM + wr * 64 + fr, col0 = u.pn * BM + wc * 32 + 8 * fq;
#pragma unroll
        for (int ai = 0; ai < 2; ++ai)
#pragma unroll
            for (int m = 0; m < 4; ++m) { const size_t row = (size_t)(row0 + ai * HALF + m * 16);
                const float rs = __builtin_amdgcn_rsqf(ss[row] * (1.0f / 1024.0f) + 1e-6f);
#pragma unroll
                for (int bj = 0; bj < 2; ++bj) { const f32x4 v0 = acc[ai][bj][m][0] * rs, v1 = acc[ai][bj][m][1] * rs;
                    u32x4 w; w.x = cvt_pk_bf16(v0[0], v0[1]); w.y = cvt_pk_bf16(v0[2], v0[3]); w.z = cvt_pk_bf16(v1[0], v1[1]); w.w = cvt_pk_bf16(v1[2], v1[3]);
                    *(u32x4*)(AB + row * ldc + col0 + bj * HALF) = w; } }
    }
};
template <class Epi, class Sched, bool ALIGN_EPI = false, bool SP2 = false>
__device__ __forceinline__ void gemm_phase(PG8_LAS unsigned char* lds, const Gemm g, const Sched& S, const Epi& E) {
    int tid_ = threadIdx.x; asm volatile("" : "+v"(tid_));
    const int tid = tid_, wid = __builtin_amdgcn_readfirstlane(tid >> 6), lane = tid & 63, wr = wid >> 2, wc = wid & 3, fr = lane & 15, fq = lane >> 4;
    const int K = g.K, nt = K / BK;
    unsigned voffA[2], voffB[2];
#pragma unroll
    for (int i = 0; i < 2; ++i) { int R, C; stage_rc(tid * 16 + i * 8192, R, C); const int Rb = Epi::PERM ? ((R & ~31) + perm32(R & 31)) : R;
        voffA[i] = (unsigned)(R * g.lda + C) * 2u; voffB[i] = (unsigned)(Rb * K + C) * 2u; }
    const size_t kstep = (size_t)(BK * 2);
    const size_t hA = (size_t)HALF * g.lda * 2, hB = (size_t)HALF * K * 2;
    const size_t tA = 2 * hA, tB = 2 * hB;
    const unsigned ldsw = (unsigned)wid * 1024u;
    const int aoff = lds_byte(wr * 64 + fr, fq * 8), boff = lds_byte(wc * 32 + fr, fq * 8);
#define PG8_SA(b, h) (((b) * 2 + (h)) * HTB)
#define PG8_SB(b, h) ((4 + (b) * 2 + (h)) * HTB)
#define PG8_STAGE(bufoff, gbase, voff) do { _Pragma("unroll") for (int _i = 0; _i < 2; ++_i) \
        __builtin_amdgcn_global_load_lds((const unsigned*)((const char*)(gbase) + (voff)[_i]), (PG8_LAS unsigned*)(lds + (bufoff) + ldsw + _i * 8192), 16, 0, 0); } while (0)
#define PG8_LDA(dst, b, h) do { _Pragma("unroll") for (int m = 0; m < 4; ++m) _Pragma("unroll") for (int k = 0; k < 2; ++k) dst[m][k] = *(const PG8_LAS bf16x8*)(lds + PG8_SA(b, h) + aoff + m * 2048 + k * 1024); } while (0)
#define PG8_LDB(dst, b, h) do { _Pragma("unroll") for (int n = 0; n < 2; ++n) _Pragma("unroll") for (int k = 0; k < 2; ++k) dst[n][k] = *(const PG8_LAS bf16x8*)(lds + PG8_SB(b, h) + boff + n * 2048 + k * 1024); } while (0)
#define PG8_MMA(ai, bj, At, Bt) do { __builtin_amdgcn_s_setprio(1); _Pragma("unroll") for (int m = 0; m < 4; ++m) _Pragma("unroll") for (int n = 0; n < 2; ++n) _Pragma("unroll") for (int k = 0; k < 2; ++k) \
        acc[ai][bj][m][n] = __builtin_amdgcn_mfma_f32_16x16x32_bf16(Bt[n][k], At[m][k], acc[ai][bj][m][n], 0, 0, 0); __builtin_amdgcn_s_setprio(0); } while (0)
#define PG8_WAIT_V(n) asm volatile("s_waitcnt vmcnt(" #n ")" ::: "memory")
#define PG8_WAIT_L(n) asm volatile("s_waitcnt lgkmcnt(" #n ")" ::: "memory")
#define PG8_BAR __builtin_amdgcn_s_barrier()
#define PG8_SCHED __builtin_amdgcn_sched_barrier(0)
    Unit cur, nxt; int ui = 0;
    if (!S.next(0, cur)) return;
    f32x4 acc[2][2][4][2];
#pragma unroll
    for (int a = 0; a < 2; ++a)
#pragma unroll
        for (int b = 0; b < 2; ++b)
#pragma unroll
            for (int m = 0; m < 4; ++m)
#pragma unroll
                for (int n = 0; n < 2; ++n) acc[a][b][m][n] = (f32x4){0.f, 0.f, 0.f, 0.f};
    bf16x8 At[4][2], B0[2][2], B1[2][2];
    const char* cA = (const char*)g.A + (size_t)cur.pm * tA; const char* cB = (const char*)g.Bt + (size_t)cur.pn * tB;
    S.a_ready(cur);
    if constexpr (SP2) {
        PG8_STAGE(PG8_SB(0, 0), cB, voffB); PG8_STAGE(PG8_SB(0, 1), cB + hB, voffB); PG8_STAGE(PG8_SA(0, 0), cA, voffA); PG8_STAGE(PG8_SA(0, 1), cA + hA, voffA);
        if (wr == 1) PG8_BAR;
        PG8_WAIT_V(2); PG8_BAR;
        PG8_STAGE(PG8_SB(1, 0), cB + kstep, voffB); PG8_STAGE(PG8_SA(1, 0), cA + kstep, voffA); PG8_STAGE(PG8_SB(1, 1), cB + hB + kstep, voffB);
        PG8_WAIT_V(6); PG8_BAR;
    } else {
        PG8_STAGE(PG8_SB(0, 0), cB, voffB); PG8_STAGE(PG8_SA(0, 0), cA, voffA); PG8_STAGE(PG8_SB(0, 1), cB + hB, voffB); PG8_STAGE(PG8_SA(0, 1), cA + hA, voffA);
        if (wr == 1) PG8_BAR;
        PG8_WAIT_V(4); PG8_BAR;
        PG8_STAGE(PG8_SB(1, 0), cB + kstep, voffB); PG8_STAGE(PG8_SA(1, 0), cA + kstep, voffA); PG8_STAGE(PG8_SB(1, 1), cB + hB + kstep, voffB);
        PG8_WAIT_V(6); PG8_BAR;
    }
    for (;;) {
        const bool has_next = S.next(ui + 1, nxt);
        const char* nA = has_next ? (const char*)g.A + (size_t)nxt.pm * tA : cA; const char* nB = has_next ? (const char*)g.Bt + (size_t)nxt.pn * tB : cB;
        for (int t = 0; t < nt; t += 2) {
            const bool last = (t == nt - 2);
            const char* a1 = cA + (size_t)(t + 1) * kstep;
            const char* a2 = last ? nA : cA + (size_t)(t + 2) * kstep; const char* b2 = last ? nB : cB + (size_t)(t + 2) * kstep;
            const char* a3 = a2 + kstep; const char* b3 = b2 + kstep;
            if (last && has_next) S.a_ready(nxt);
            if constexpr (SP2) {
            PG8_LDB(B0, 0, 0); PG8_LDB(B1, 0, 1); PG8_SCHED; PG8_LDA(At, 0, 0); PG8_STAGE(PG8_SA(1, 1), a1 + hA, voffA);
            PG8_WAIT_V(8); PG8_WAIT_L(0); PG8_BAR; PG8_MMA(0, 0, At, B0); PG8_MMA(0, 1, At, B1); PG8_BAR; PG8_SCHED;
            PG8_LDA(At, 0, 1); PG8_STAGE(PG8_SB(0, 0), b2, voffB); PG8_STAGE(PG8_SB(0, 1), b2 + hB, voffB); PG8_STAGE(PG8_SA(0, 0), a2, voffA);
            PG8_WAIT_V(8); PG8_WAIT_L(0); PG8_BAR; PG8_MMA(1, 0, At, B0); PG8_MMA(1, 1, At, B1); PG8_BAR; PG8_SCHED;
            PG8_LDB(B0, 1, 0); PG8_LDB(B1, 1, 1); PG8_SCHED; PG8_LDA(At, 1, 0); PG8_STAGE(PG8_SA(0, 1), a2 + hA, voffA);
            PG8_WAIT_V(8); PG8_WAIT_L(0); PG8_BAR; PG8_MMA(0, 0, At, B0); PG8_MMA(0, 1, At, B1); PG8_BAR; PG8_SCHED;
            PG8_LDA(At, 1, 1); PG8_STAGE(PG8_SB(1, 0), b3, voffB); PG8_STAGE(PG8_SB(1, 1), b3 + hB, voffB); PG8_STAGE(PG8_SA(1, 0), a3, voffA);
            PG8_WAIT_V(8); PG8_WAIT_L(0); PG8_BAR; PG8_MMA(1, 0, At, B0); PG8_MMA(1, 1, At, B1); PG8_BAR; PG8_SCHED;
            } else {
            PG8_LDB(B0, 0, 0); PG8_SCHED; PG8_LDA(At, 0, 0); PG8_STAGE(PG8_SA(1, 1), a1 + hA, voffA);
            PG8_WAIT_L(8); PG8_BAR; PG8_WAIT_L(0); PG8_MMA(0, 0, At, B0); PG8_BAR; PG8_SCHED;
            PG8_LDB(B1, 0, 1); PG8_STAGE(PG8_SB(0, 0), b2, voffB);
            PG8_BAR; PG8_WAIT_L(0); PG8_MMA(0, 1, At, B1); PG8_BAR;
            PG8_LDA(At, 0, 1); PG8_STAGE(PG8_SA(0, 0), a2, voffA);
            PG8_BAR; PG8_WAIT_L(0); PG8_MMA(1, 0, At, B0); PG8_BAR; PG8_SCHED;
            PG8_STAGE(PG8_SB(0, 1), b2 + hB, voffB);
            PG8_WAIT_V(6); PG8_BAR; PG8_MMA(1, 1, At, B1); PG8_BAR;
            PG8_LDB(B0, 1, 0); PG8_SCHED; PG8_LDA(At, 1, 0); PG8_STAGE(PG8_SA(0, 1), a2 + hA, voffA);
            PG8_WAIT_L(8); PG8_BAR; PG8_WAIT_L(0); PG8_MMA(0, 0, At, B0); PG8_BAR; PG8_SCHED;
            PG8_LDB(B1, 1, 1); PG8_STAGE(PG8_SB(1, 0), b3, voffB);
            PG8_BAR; PG8_WAIT_L(0); PG8_MMA(0, 1, At, B1); PG8_BAR;
            PG8_LDA(At, 1, 1); PG8_STAGE(PG8_SA(1, 0), a3, voffA);
            PG8_BAR; PG8_WAIT_L(0); PG8_MMA(1, 0, At, B0); PG8_BAR; PG8_SCHED;
            PG8_STAGE(PG8_SB(1, 1), b3 + hB, voffB);
            PG8_WAIT_V(6); PG8_BAR; PG8_MMA(1, 1, At, B1); PG8_BAR;
            }
        }
        if constexpr (ALIGN_EPI) { if (wr == 0) PG8_BAR; }
        if constexpr (!Epi::AFTER_DRAIN) { E(acc, cur, wr, wc, fr, fq); S.done(cur); }
        if (!has_next) break;
#pragma unroll
        for (int a = 0; a < 2; ++a)
#pragma unroll
            for (int b = 0; b < 2; ++b)
#pragma unroll
                for (int m = 0; m < 4; ++m)
#pragma unroll
                    for (int n = 0; n < 2; ++n) acc[a][b][m][n] = (f32x4){0.f, 0.f, 0.f, 0.f};
        cur = nxt; cA = nA; cB = nB; ++ui;
        if constexpr (ALIGN_EPI) { if (wr == 1) PG8_BAR; }
    }
    PG8_WAIT_V(0);
    if constexpr (!ALIGN_EPI) { if (wr == 0) PG8_BAR; }
    PG8_BAR;
    if constexpr (Epi::AFTER_DRAIN) { E.fused(acc, cur, wr, wc, fr, fq, lds, wid, lane); S.done(cur); }
#undef PG8_SA
#undef PG8_SB
#undef PG8_STAGE
#undef PG8_LDA
#undef PG8_LDB
#undef PG8_MMA
#undef PG8_WAIT_V
#undef PG8_WAIT_L
#undef PG8_BAR
#undef PG8_SCHED
}
}

constexpr int DM = 1024, NBP = 8, SEQ = 2048, NBS = 128, TS = 4, MP = NBP * SEQ, MS = NBS * TS, MT = MP + MS;
constexpr int NIN = 6144, DFF = 2816, NUP = 2 * DFF, CAW = 31, HB = 8;
constexpr float EPS = 1e-6f;
constexpr int NWAVES = 8, NTHR = 512;
constexpr size_t O_Y = 0, O_CAP = (size_t)MT * DM, O_CAS = O_CAP + (size_t)NBP * 30 * DM, O_VS = O_CAS + (size_t)NBS * 30 * DM, O_FP = O_VS + (size_t)MS * DM, O_FS = O_FP + (size_t)NBP * 2 * DFF, O_END = O_FS + (size_t)NBS * 2 * DFF;
constexpr size_t MiB = 1u << 20;
constexpr size_t WS_SS1 = 0, WS_SS2 = 128 * 1024;
constexpr size_t WS_WUP = 1 * MiB, WS_WDN = 12 * MiB, WS_WIN = 18 * MiB, WS_WA = 30 * MiB, WS_WB = 32 * MiB, WS_WO = 34 * MiB;
constexpr size_t WS_XN = 36 * MiB;
constexpr size_t WS_GLU = 69 * MiB, WS_UV = 102 * MiB, WS_GG = 168 * MiB;
constexpr size_t WS_MG = WS_GLU;
constexpr size_t WS_AB = WS_GLU;
constexpr size_t WS_END = WS_AB + (size_t)MT * NUP * 2;
static_assert(WS_END <= 256 * MiB && WS_GG + (size_t)MT * 2048 * 2 <= 256 * MiB, "d_ws map");
constexpr int LDS_BYTES = 147456;

#define LAS __attribute__((address_space(3)))
typedef unsigned short bf16;
typedef unsigned v4u __attribute__((ext_vector_type(4)));
typedef unsigned v2u __attribute__((ext_vector_type(2)));
typedef float f32x4 __attribute__((ext_vector_type(4)));
typedef float f32x2 __attribute__((ext_vector_type(2)));
typedef short bf16x8 __attribute__((ext_vector_type(8)));
#define LDS_WAIT() asm volatile("s_waitcnt lgkmcnt(0)" ::: "memory")
__device__ __forceinline__ unsigned f2bf(float f) { unsigned u = __builtin_bit_cast(unsigned, f); return (u + 0x7fffu + ((u >> 16) & 1u)) >> 16; }
__device__ __forceinline__ unsigned pk2(float lo, float hi) { return f2bf(lo) | (f2bf(hi) << 16); }
__device__ __forceinline__ float blo(unsigned u) { return __uint_as_float(u << 16); }
__device__ __forceinline__ float bhi(unsigned u) { return __uint_as_float(u & 0xffff0000u); }
__device__ __forceinline__ float sigmf(float x) { return __builtin_amdgcn_rcpf(1.0f + __builtin_amdgcn_exp2f(x * -1.44269504089f)); }
__device__ __forceinline__ float wave_sum(float v) {
#pragma unroll
    for (int o = 1; o < 64; o <<= 1) v += __shfl_xor(v, o);
    return v;
}

struct Args { const float* in[23]; float* out; unsigned char* ws; };
struct Frame { LAS unsigned char* lds; int tid, lane, wave, vcu, G; };
__device__ __forceinline__ Frame phase_frame(const Frame& F0) { Frame F = F0; int t = F0.tid; asm volatile("" : "+v"(t)); F.tid = t; F.lane = t & 63; return F; }

__device__ __forceinline__ void p0_transpose_item(const float* W, int K, int N, bf16* WT, int mode, const float* kscale, LAS float* scr, int item, int lane) {
    const int nblk = N / 32, kb = item / nblk, nb = item % nblk, k0 = 64 * kb, n0 = 32 * nb;
#pragma unroll 8
    for (int i = 0; i < 32; ++i) { const int kk = 2 * i + (lane >> 5); float v = W[(size_t)(k0 + kk) * N + n0 + (lane & 31)]; if (kscale) v *= kscale[k0 + kk]; scr[kk * 33 + (lane & 31)] = v; }
    LDS_WAIT(); asm volatile("" ::: "memory");
    int n0m = n0;
    if (mode == 1 && n0 < 2048) { const int half = n0 >= 1024 ? 1 : 0, ch = n0 - 1024 * half; n0m = 256 * (ch >> 7) + 128 * half + (ch & 127); }
    const int c = lane & 7;
#pragma unroll
    for (int j = 0; j < 4; ++j) { const int n = (lane >> 3) + 8 * j; const LAS float* s = scr + (8 * c) * 33 + n;
        v4u o; o.x = pk2(s[0 * 33], s[1 * 33]); o.y = pk2(s[2 * 33], s[3 * 33]); o.z = pk2(s[4 * 33], s[5 * 33]); o.w = pk2(s[6 * 33], s[7 * 33]);
        *(v4u*)(WT + (size_t)(n0m + n) * K + k0 + 8 * c) = o; }
    LDS_WAIT(); asm volatile("" ::: "memory");
}
__device__ __forceinline__ void rms_row_to_bf16(const float* xrow, const float* g, bf16* orow, int lane) {
    const f32x4* xr = (const f32x4*)xrow + lane; const f32x4* gr = (const f32x4*)g + lane;
    f32x4 v[4]; float s = 0.f;
#pragma unroll
    for (int j = 0; j < 4; ++j) { v[j] = xr[64 * j]; s += (v[j].x * v[j].x + v[j].y * v[j].y) + (v[j].z * v[j].z + v[j].w * v[j].w); }
    const float rstd = 1.0f / sqrtf(wave_sum(s) * (1.f / DM) + EPS);
    unsigned long long* o8 = (unsigned long long*)orow + lane;
#pragma unroll
    for (int j = 0; j < 4; ++j) { const f32x4 gg = gr[64 * j]; o8[64 * j] = (unsigned long long)pk2(v[j].x * rstd * gg.x, v[j].y * rstd * gg.y) | ((unsigned long long)pk2(v[j].z * rstd * gg.z, v[j].w * rstd * gg.w) << 32); }
}
__device__ __forceinline__ void p0_prologue(const Frame& F0, const Args& a) {
    const Frame F = phase_frame(F0);
    unsigned char* ws = a.ws;
    LAS float* scr = (LAS float*)(F.lds + F.wave * 16384);
    const int gw = F.vcu * NWAVES + F.wave, NGW = F.G * NWAVES;
    constexpr int I_IN = (DM / 64) * (NIN / 32), I_SQ = (DM / 64) * (DM / 32), I_UP = (DM / 64) * (NUP / 32), I_DN = (DFF / 64) * (DM / 32);
    constexpr int NITEMS = I_IN + 3 * I_SQ + I_UP + I_DN;
    for (int it = gw; it < NITEMS; it += NGW) {
        int r = it;
        if (r < I_IN) { p0_transpose_item(a.in[5], DM, NIN, (bf16*)(ws + WS_WIN), 1, nullptr, scr, r, F.lane); continue; } r -= I_IN;
        if (r < I_SQ) { p0_transpose_item(a.in[10], DM, DM, (bf16*)(ws + WS_WA), 0, nullptr, scr, r, F.lane); continue; } r -= I_SQ;
        if (r < I_SQ) { p0_transpose_item(a.in[15], DM, DM, (bf16*)(ws + WS_WB), 0, nullptr, scr, r, F.lane); continue; } r -= I_SQ;
        if (r < I_SQ) { p0_transpose_item(a.in[16], DM, DM, (bf16*)(ws + WS_WO), 0, nullptr, scr, r, F.lane); continue; } r -= I_SQ;
        if (r < I_UP) { p0_transpose_item(a.in[18], DM, NUP, (bf16*)(ws + WS_WUP), 0, a.in[17], scr, r, F.lane); continue; } r -= I_UP;
        p0_transpose_item(a.in[21], DFF, DM, (bf16*)(ws + WS_WDN), 0, nullptr, scr, r, F.lane);
    }
    bf16* XN = (bf16*)(ws + WS_XN);
    for (int m = gw; m < MT; m += NGW) {
        const float* xr = m < MP ? a.in[0] + (size_t)m * DM : a.in[1] + (size_t)(m - MP) * DM;
        rms_row_to_bf16(xr, a.in[4], XN + (size_t)m * DM, F.lane);
    }
    float* ss = (float*)(ws + WS_SS1);
    for (int i = F.vcu * NTHR + F.tid; i < (int)(2 * WS_SS2 / 4); i += F.G * NTHR) ss[i] = 0.f;
}

__device__ __forceinline__ void ln_silu_row(const LAS float* src, bf16* dst, const float* g, const float* bt, int lane) {
    f32x4 v[4]; float s = 0.f;
#pragma unroll
    for (int j = 0; j < 4; ++j) { v[j] = *(const LAS f32x4*)(src + 4 * lane + 256 * j); s += (v[j].x + v[j].y) + (v[j].z + v[j].w); }
    const float mean = wave_sum(s) * (1.f / DM); float s2 = 0.f;
#pragma unroll
    for (int j = 0; j < 4; ++j) { v[j] = v[j] - mean; s2 += (v[j].x * v[j].x + v[j].y * v[j].y) + (v[j].z * v[j].z + v[j].w * v[j].w); }
    const float rstd = 1.0f / sqrtf(wave_sum(s2) * (1.f / DM) + EPS);
#pragma unroll
    for (int j = 0; j < 4; ++j) { const f32x4 gg = *(const f32x4*)(g + 4 * lane + 256 * j), bb = *(const f32x4*)(bt + 4 * lane + 256 * j);
        f32x4 y = v[j] * rstd * gg + bb; y = (f32x4){y.x * sigmf(y.x), y.y * sigmf(y.y), y.z * sigmf(y.z), y.w * sigmf(y.w)};
        v2u w; w.x = pk2(y.x, y.y); w.y = pk2(y.z, y.w); *(v2u*)(dst + 4 * lane + 256 * j) = w; }
}
__device__ __forceinline__ void convA_prompt(const Frame& F0, const Args& a, const unsigned* G32, bf16* ACTA, size_t grow0, bool has_hist, float* capout) {
    const Frame F = phase_frame(F0);
    const int c0 = 2 * F.tid;
    LAS float* CB = (LAS float*)F.lds;
    const float* dw = a.in[6];
    f32x2 w[CAW];
#pragma unroll
    for (int k = 0; k < CAW; ++k) w[k] = *(const f32x2*)(dw + k * DM + c0);
    const f32x2 bias = *(const f32x2*)(a.in[7] + c0);
    f32x2 ring[32];
#pragma unroll
    for (int j = 0; j < 32; ++j) ring[j] = (f32x2){0.f, 0.f};
    if (has_hist) {
        const unsigned* hp = G32 + (grow0 - 30) * 512 + F.tid;
#pragma unroll
        for (int j = 0; j < 30; ++j) { const unsigned u = hp[(size_t)j * 512]; ring[2 + j] = (f32x2){blo(u), bhi(u)}; }
    }
    for (int base = 0; base < 64; base += 32) {
        const unsigned* gp = G32 + (grow0 + base) * 512 + F.tid;
#pragma unroll
        for (int jg = 0; jg < 32; jg += 8) {
            unsigned tmp[8];
#pragma unroll
            for (int jj = 0; jj < 8; ++jj) tmp[jj] = gp[(size_t)(jg + jj) * 512];
#pragma unroll
            for (int jj = 0; jj < 8; ++jj) {
                const int j = jg + jj;
                const f32x2 nv = (f32x2){blo(tmp[jj]), bhi(tmp[jj])};
                ring[j] = nv;
                f32x2 o = bias;
#pragma unroll
                for (int k = 0; k < CAW; ++k) o += ring[(j + k + 2) & 31] * w[k];
                *(LAS f32x2*)(CB + j * DM + c0) = o;
            }
            __builtin_amdgcn_sched_barrier(0);
        }
        if (capout && base == 32) {
#pragma unroll
            for (int j = 2; j < 32; ++j) *(f32x2*)(capout + (size_t)(j - 2) * DM + c0) = ring[j];
        }
        __syncthreads();
#pragma unroll 1
        for (int r = F.wave; r < 32; r += NWAVES) ln_silu_row(CB + r * DM, ACTA + (grow0 + base + r) * DM, a.in[8], a.in[9], F.lane);
        __syncthreads();
    }
}
__device__ __forceinline__ void convA_sample(const Frame& F0, const Args& a, const unsigned* G32, bf16* ACTA, int s, const float* hst, float* casout) {
    const Frame F = phase_frame(F0);
    const int c0 = 2 * F.tid;
    LAS float* CB = (LAS float*)F.lds;
    const float* dw = a.in[6];
    f32x2 w[CAW];
#pragma unroll
    for (int k = 0; k < CAW; ++k) w[k] = *(const f32x2*)(dw + k * DM + c0);
    const f32x2 bias = *(const f32x2*)(a.in[7] + c0);
    f32x2 o[4] = {bias, bias, bias, bias};
    const size_t grow0 = (size_t)MP + 4 * s;
#pragma unroll
    for (int i = 0; i < 34; ++i) {
        f32x2 x;
        if (i < 30) x = *(const f32x2*)(hst + i * DM + c0);
        else { const unsigned u = G32[(grow0 + (i - 30)) * 512 + F.tid]; x = (f32x2){blo(u), bhi(u)}; }
        if (i >= 4) *(f32x2*)(casout + (i - 4) * DM + c0) = x;
#pragma unroll
        for (int t = 0; t < 4; ++t) { const int k = i - t; if (k >= 0 && k < CAW) o[t] += x * w[k]; }
    }
#pragma unroll
    for (int t = 0; t < 4; ++t) *(LAS f32x2*)(CB + t * DM + c0) = o[t];
    __syncthreads();
    if (F.wave < 4) ln_silu_row(CB + F.wave * DM, ACTA + (grow0 + F.wave) * DM, a.in[8], a.in[9], F.lane);
    __syncthreads();
}

__device__ __forceinline__ void ln_stats16(const bf16* vrow, int lane, float (&x)[16], float& mean, float& rstd) {
    const v4u p = *(const v4u*)(vrow + 8 * lane), q = *(const v4u*)(vrow + 512 + 8 * lane);
    x[0] = blo(p.x); x[1] = bhi(p.x); x[2] = blo(p.y); x[3] = bhi(p.y); x[4] = blo(p.z); x[5] = bhi(p.z); x[6] = blo(p.w); x[7] = bhi(p.w);
    x[8] = blo(q.x); x[9] = bhi(q.x); x[10] = blo(q.y); x[11] = bhi(q.y); x[12] = blo(q.z); x[13] = bhi(q.z); x[14] = blo(q.w); x[15] = bhi(q.w);
    float s = 0.f;
#pragma unroll
    for (int i = 0; i < 16; ++i) s += x[i];
    mean = wave_sum(s) * (1.f / DM); float s2 = 0.f;
#pragma unroll
    for (int i = 0; i < 16; ++i) { const float d = x[i] - mean; s2 += d * d; }
    rstd = 1.0f / sqrtf(wave_sum(s2) * (1.f / DM) + EPS);
}
constexpr int VT_LD = 130, WT_LD = 136;
constexpr int MB_STAT = 0, MB_VT = 1024, MB_WT = MB_VT + 128 * VT_LD * 2 + 64;
static_assert(MB_WT % 16 == 0 && MB_WT + 128 * WT_LD * 2 <= 131072, "mixer-B LDS map");
__device__ __forceinline__ void mixB_prompt(const Frame& F0, const Args& a, bf16* UV, int ch, int hh) {
    const Frame F = phase_frame(F0);
    const size_t R0 = (size_t)ch * 128;
    LAS f32x2* STAT = (LAS f32x2*)(F.lds + MB_STAT);
    LAS unsigned char* VT = F.lds + MB_VT; LAS unsigned char* WT = F.lds + MB_WT;
    const float* lng = a.in[11]; const float* lnb = a.in[12]; const float* w_s = a.in[13]; const float* b_s = a.in[14];
    for (int i = 0; i < 16; ++i) { const int r = F.wave * 16 + i; float x[16], mean, rstd; ln_stats16(UV + (R0 + r) * 2048 + 1024, F.lane, x, mean, rstd); if (F.lane == 0) STAT[r] = (f32x2){mean, rstd}; }
    __syncthreads();
    const int lr = F.lane & 15, lq = F.lane >> 4;
    for (int hq = 0; hq < 4; ++hq) {
        const int h = hh * 4 + hq;
#pragma unroll
        for (int i = 0; i < 4; ++i) { const int idx = F.tid + NTHR * i, r = idx >> 4, cgp = idx & 15, c = h * 128 + cgp * 8;
            const v4u p = *(const v4u*)(UV + (R0 + r) * 2048 + 1024 + c); const f32x2 st = STAT[r];
            const f32x4 g0 = *(const f32x4*)(lng + c), g1 = *(const f32x4*)(lng + c + 4), b0 = *(const f32x4*)(lnb + c), b1 = *(const f32x4*)(lnb + c + 4);
            LAS unsigned* dst = (LAS unsigned*)(VT + (r * VT_LD + cgp * 8) * 2);
            dst[0] = pk2((blo(p.x) - st.x) * st.y * g0.x + b0.x, (bhi(p.x) - st.x) * st.y * g0.y + b0.y);
            dst[1] = pk2((blo(p.y) - st.x) * st.y * g0.z + b0.z, (bhi(p.y) - st.x) * st.y * g0.w + b0.w);
            dst[2] = pk2((blo(p.z) - st.x) * st.y * g1.x + b1.x, (bhi(p.z) - st.x) * st.y * g1.y + b1.y);
            dst[3] = pk2((blo(p.w) - st.x) * st.y * g1.z + b1.z, (bhi(p.w) - st.x) * st.y * g1.w + b1.w); }
#pragma unroll
        for (int i = 0; i < 8; ++i) { const int idx = F.tid + NTHR * i, t = idx >> 5, sg = idx & 31;
            const f32x4 wv = *(const f32x4*)(w_s + ((size_t)h * 128 + t) * 128 + sg * 4); const int s0 = sg * 4;
            v2u o; o.x = pk2(s0 <= t ? wv.x : 0.f, s0 + 1 <= t ? wv.y : 0.f); o.y = pk2(s0 + 2 <= t ? wv.z : 0.f, s0 + 3 <= t ? wv.w : 0.f);
            *(LAS v2u*)(WT + (t * WT_LD + s0) * 2) = o; }
        __syncthreads();
        bf16x8 af[4];
#pragma unroll
        for (int ks = 0; ks < 4; ++ks) {
#pragma unroll
            for (int kk = 0; kk < 8; ++kk) af[ks][kk] = (short)*(const LAS unsigned short*)(VT + ((32 * ks + 8 * lq + kk) * VT_LD + 16 * F.wave + lr) * 2);
        }
#pragma unroll
        for (int tb = 0; tb < 8; ++tb) {
            f32x4 acc = (f32x4){0.f, 0.f, 0.f, 0.f};
#pragma unroll
            for (int ks = 0; ks < 4; ++ks) {
                if (32 * ks <= 16 * tb + 15) {
                    const bf16x8 bfr = *(const LAS bf16x8*)(WT + ((16 * tb + lr) * WT_LD + 32 * ks + 8 * lq) * 2);
                    acc = __builtin_amdgcn_mfma_f32_16x16x32_bf16(af[ks], bfr, acc, 0, 0, 0);
                }
            }
            const int t = 16 * tb + lr, c = h * 128 + 16 * F.wave + 4 * lq;
            bf16* up = UV + (R0 + t) * 2048 + c;
            const v2u uu = *(const v2u*)up; const float bsv = b_s[h * 128 + t];
            v2u o; o.x = pk2(blo(uu.x) * (acc[0] + bsv), bhi(uu.x) * (acc[1] + bsv)); o.y = pk2(blo(uu.y) * (acc[2] + bsv), bhi(uu.y) * (acc[3] + bsv));
            *(v2u*)up = o;
        }
        __syncthreads();
    }
}
__device__ __forceinline__ void mixB_sample(const Frame& F0, const Args& a, bf16* UV, int s, float* out_vs) {
    const Frame F = phase_frame(F0);
    LAS float* SV = (LAS float*)F.lds;
    const float* lng = a.in[11]; const float* lnb = a.in[12]; const float* w_s = a.in[13]; const float* b_s = a.in[14];
    const size_t R0 = (size_t)MP + 4 * s;
    if (F.wave < 4) {
        const int t = F.wave; float x[16], mean, rstd; ln_stats16(UV + (R0 + t) * 2048 + 1024, F.lane, x, mean, rstd);
#pragma unroll
        for (int hf = 0; hf < 2; ++hf) { const int c = 512 * hf + 8 * F.lane;
#pragma unroll
            for (int q = 0; q < 2; ++q) { const f32x4 g = *(const f32x4*)(lng + c + 4 * q), b = *(const f32x4*)(lnb + c + 4 * q);
                const f32x4 xv = (f32x4){x[8 * hf + 4 * q], x[8 * hf + 4 * q + 1], x[8 * hf + 4 * q + 2], x[8 * hf + 4 * q + 3]};
                const f32x4 y = (xv - mean) * rstd * g + b;
                *(f32x4*)(out_vs + ((size_t)4 * s + t) * DM + c + 4 * q) = y; *(LAS f32x4*)(SV + t * DM + c + 4 * q) = y; } }
    }
    __syncthreads();
    const int c0 = 2 * F.tid, h = c0 >> 7;
#pragma unroll
    for (int t = 0; t < 4; ++t) {
        const float bsv = b_s[h * 128 + t]; float s0 = bsv, s1 = bsv;
#pragma unroll
        for (int sp = 0; sp <= t; ++sp) { const float wv = w_s[((size_t)h * 128 + t) * 128 + sp]; const f32x2 vv = *(const LAS f32x2*)(SV + sp * DM + c0); s0 += wv * vv.x; s1 += wv * vv.y; }
        unsigned* up = (unsigned*)(UV + (R0 + t) * 2048 + c0); const unsigned uu = *up;
        *up = pk2(blo(uu) * s0, bhi(uu) * s1);
    }
    __syncthreads();
}

__device__ __forceinline__ void unpack8(const v4u p, float (&x)[8]) { x[0] = blo(p.x); x[1] = bhi(p.x); x[2] = blo(p.y); x[3] = bhi(p.y); x[4] = blo(p.z); x[5] = bhi(p.z); x[6] = blo(p.w); x[7] = bhi(p.w); }
__device__ __forceinline__ void ld8f(const float* p, float (&x)[8]) { const f32x4 a = *(const f32x4*)p, b = *(const f32x4*)(p + 4); x[0] = a.x; x[1] = a.y; x[2] = a.z; x[3] = a.w; x[4] = b.x; x[5] = b.y; x[6] = b.z; x[7] = b.w; }
__device__ __forceinline__ void st8f(float* p, const float (&x)[8]) { *(f32x4*)p = (f32x4){x[0], x[1], x[2], x[3]}; *(f32x4*)(p + 4) = (f32x4){x[4], x[5], x[6], x[7]}; }
__device__ __forceinline__ void p6_ffn_act(const Frame& F0, const Args& a, float* out) {
    const Frame F = phase_frame(F0);
    bf16* AB = (bf16*)(a.ws + WS_AB);
    constexpr int NG = DFF / 8, RUN = 16, NPI = (MP / RUN) * NG, NSI = NBS * NG;
    const float* dwf = a.in[19]; const float* bdw = a.in[20]; const float* stf = a.in[3];
    for (int it = F.vcu * NTHR + F.tid; it < NPI + NSI; it += F.G * NTHR) {
        float a2[8], a1[8]; size_t row0; int nrows, c; float* fo = nullptr; int fofrom = 0;
        if (it < NPI) { const int run = it / NG, cgp = it - run * NG; c = cgp * 8; row0 = (size_t)run * RUN; nrows = RUN; const int t0 = (int)(row0 & (SEQ - 1));
            if (t0 > 0) { unpack8(*(const v4u*)(AB + (row0 - 2) * NUP + c), a2); unpack8(*(const v4u*)(AB + (row0 - 1) * NUP + c), a1); }
            else {
#pragma unroll
                for (int j = 0; j < 8; ++j) { a2[j] = 0.f; a1[j] = 0.f; } }
            if (t0 == SEQ - RUN) { fo = out + O_FP + (size_t)(row0 >> 11) * 2 * DFF + c; fofrom = RUN - 2; }
        } else { const int i2 = it - NPI, s = i2 / NG, cgp = i2 - s * NG; c = cgp * 8; row0 = (size_t)MP + 4 * s; nrows = 4;
            ld8f(stf + ((size_t)s * 2 + 0) * DFF + c, a2); ld8f(stf + ((size_t)s * 2 + 1) * DFF + c, a1);
            fo = out + O_FS + (size_t)s * 2 * DFF + c; fofrom = 2; }
        float w0[8], w1[8], w2[8], bs[8]; ld8f(dwf + c, w0); ld8f(dwf + DFF + c, w1); ld8f(dwf + 2 * DFF + c, w2); ld8f(bdw + c, bs);
        for (int i = 0; i < nrows; ++i) {
            bf16* ap = AB + (row0 + i) * NUP + c; float a0[8], bb[8]; unpack8(*(const v4u*)ap, a0); unpack8(*(const v4u*)(ap + DFF), bb);
            float o[8];
#pragma unroll
            for (int j = 0; j < 8; j += 2) { f32x2 cv = (f32x2){a2[j] * w0[j] + a1[j] * w1[j] + a0[j] * w2[j] + bs[j], a2[j + 1] * w0[j + 1] + a1[j + 1] * w1[j + 1] + a0[j + 1] * w2[j + 1] + bs[j + 1]};
                cv = pg8::gelu_pk(cv); o[j] = cv.x * bb[j]; o[j + 1] = cv.y * bb[j + 1]; }
            v4u w; w.x = pk2(o[0], o[1]); w.y = pk2(o[2], o[3]); w.z = pk2(o[4], o[5]); w.w = pk2(o[6], o[7]);
            *(v4u*)(ap + DFF) = w;
            if (fo && i >= fofrom) st8f(fo + (size_t)(i - fofrom) * DFF, a0);
#pragma unroll
            for (int j = 0; j < 8; ++j) { a2[j] = a1[j]; a1[j] = a0[j]; }
        }
    }
}

__global__ void __launch_bounds__(NTHR, 2) fwd_mega(Args a) {
    extern __shared__ __attribute__((aligned(16))) unsigned char lds_raw[];
    cg::grid_group grid = cg::this_grid();
    Frame F; F.lds = (LAS unsigned char*)lds_raw; F.tid = threadIdx.x; F.lane = F.tid & 63; F.wave = __builtin_amdgcn_readfirstlane(F.tid >> 6);
    F.G = gridDim.x; { const int bx = blockIdx.x; F.vcu = (F.G % 8 == 0) ? (bx % 8) * (F.G / 8) + bx / 8 : bx; }
    unsigned char* ws = a.ws; float* out = a.out;
    bf16* XN = (bf16*)(ws + WS_XN); bf16* GLU = (bf16*)(ws + WS_GLU); bf16* UV = (bf16*)(ws + WS_UV); bf16* GG = (bf16*)(ws + WS_GG);
    bf16* MG = (bf16*)(ws + WS_MG); bf16* AB = (bf16*)(ws + WS_AB); bf16* ACTA = (bf16*)(out + O_Y);
    float* ss1 = (float*)(ws + WS_SS1); float* ss2 = (float*)(ws + WS_SS2);

    p0_prologue(F, a);
    grid.sync();
    { pg8::Gemm g{XN, (const bf16*)(ws + WS_WIN), MT, NIN, DM, DM}; pg8::StaticOrder S; S.init(MT, NIN, F.G, (int)blockIdx.x);
      pg8::EpiG1 E{GLU, UV, GG};
      pg8::gemm_phase<pg8::EpiG1, pg8::StaticOrder, true, true>(F.lds, g, S, E); }
    grid.sync();
    for (int u = F.vcu; u < 256; u += F.G) {
        mixB_prompt(F, a, UV, u >> 1, u & 1);
        { const int b = u >> 5, t0 = (u & 31) * 64; const bool last = (u & 31) == 31;
          convA_prompt(F, a, (const unsigned*)GLU, ACTA, (size_t)b * SEQ + t0, t0 > 0, last ? out + O_CAP + (size_t)b * 30 * DM : nullptr); }
        if (u < 128) convA_sample(F, a, (const unsigned*)GLU, ACTA, u, a.in[2] + (size_t)u * 30 * DM, out + O_CAS + (size_t)u * 30 * DM);
        else mixB_sample(F, a, UV, u - 128, out + O_VS);
    }
    grid.sync();
    { pg8::Gemm g{ACTA, (const bf16*)(ws + WS_WA), MT, DM, DM, DM}; pg8::StaticOrder S; S.init(MT, DM, F.G, (int)blockIdx.x);
      pg8::EpiMerge<0> E{MG, GG};
      pg8::gemm_phase<pg8::EpiMerge<0>, pg8::StaticOrder, true, true>(F.lds, g, S, E); }
    { pg8::Gemm g{UV, (const bf16*)(ws + WS_WB), MT, DM, DM, 2048}; pg8::StaticOrder S; S.init(MT, DM, F.G, (int)blockIdx.x);
      pg8::EpiMerge<1> E{MG, GG};
      pg8::gemm_phase<pg8::EpiMerge<1>, pg8::StaticOrder, true, true>(F.lds, g, S, E); }
    grid.sync();
    { pg8::Gemm g{MG, (const bf16*)(ws + WS_WO), MT, DM, DM, DM}; pg8::StaticOrder S; S.init(MT, DM, F.G, (int)blockIdx.x);
      pg8::EpiRes E{a.in[0], a.in[1], MP, out + O_Y, XN, ss1};
      pg8::gemm_phase<pg8::EpiRes, pg8::StaticOrder, true, true>(F.lds, g, S, E); }
    grid.sync();
    { pg8::Gemm g{XN, (const bf16*)(ws + WS_WUP), MT, NUP, DM, DM}; pg8::StaticOrder S; S.init(MT, NUP, F.G, (int)blockIdx.x);
      pg8::EpiUp E{AB, ss1, NUP};
      pg8::gemm_phase<pg8::EpiUp, pg8::StaticOrder, true, true>(F.lds, g, S, E); }
    grid.sync();
    p6_ffn_act(F, a, out);
    grid.sync();
    { pg8::Gemm g{AB + DFF, (const bf16*)(ws + WS_WDN), MT, DM, DFF, NUP}; pg8::StaticOrder S; S.init(MT, DM, F.G, (int)blockIdx.x);
      pg8::EpiRes E{out + O_Y, out + O_Y + (size_t)MP * DM, MP, out + O_Y, nullptr, ss2};
      pg8::gemm_phase<pg8::EpiRes, pg8::StaticOrder, true, true>(F.lds, g, S, E); }
    grid.sync();
    { const Frame F8 = phase_frame(F); const float* gf = a.in[22];
      for (int m = F8.vcu * NWAVES + F8.wave; m < MT; m += F.G * NWAVES) {
          f32x4* yr = (f32x4*)(out + O_Y + (size_t)m * DM) + F8.lane; const f32x4* gr = (const f32x4*)gf + F8.lane;
          const float rstd = 1.0f / sqrtf(ss2[m] * (1.f / DM) + EPS);
#pragma unroll
          for (int j = 0; j < 4; ++j) yr[64 * j] = yr[64 * j] * rstd * gr[64 * j]; } }
}

extern "C" void kernel_launch(void* const* d_in, const int* in_sizes, int n_in, void* d_out, int out_size, void* d_ws, size_t ws_size, hipStream_t stream) {
    static int grid = 0;
    if (grid == 0) {
        if (n_in != 23 || (size_t)out_size != O_END || ws_size < WS_END) { fprintf(stderr, "kernel_launch: unexpected shapes: n_in %d out %d ws %zu\n", n_in, out_size, ws_size); grid = -1; return; }
        int dev = 0, cus = 0, per_cu = 0;
        if (hipGetDevice(&dev) != hipSuccess || hipDeviceGetAttribute(&cus, hipDeviceAttributeMultiprocessorCount, dev) != hipSuccess) { grid = -1; return; }
        if (hipFuncSetAttribute((const void*)fwd_mega, hipFuncAttributeMaxDynamicSharedMemorySize, LDS_BYTES) != hipSuccess) { fprintf(stderr, "kernel_launch: hipFuncSetAttribute failed\n"); grid = -1; return; }
        if (hipOccupancyMaxActiveBlocksPerMultiprocessor(&per_cu, (const void*)fwd_mega, NTHR, LDS_BYTES) != hipSuccess || per_cu < 1) { fprintf(stderr, "kernel_launch: occupancy query says %d\n", per_cu); per_cu = 1; }
        (void)hipGetLastError();
        grid = cus * 1;
        fprintf(stderr, "kernel_launch: cus %d per_cu %d grid %d\n", cus, per_cu, grid);
    }
    if (grid < 0) return;
    Args a{};
    for (int i = 0; i < 23; ++i) a.in[i] = (const float*)d_in[i];
    a.out = (float*)d_out; a.ws = (unsigned char*)d_ws;
    void* args[] = {&a};
    hipError_t e = hipLaunchCooperativeKernel((const void*)fwd_mega, dim3(grid), dim3(NTHR), args, LDS_BYTES, stream);
    if (e != hipSuccess) fprintf(stderr, "kernel_launch: cooperative launch failed: %s (grid %d)\n", hipGetErrorString(e), grid);
}
```

```cpp
#include <hip/hip_runtime.h>
#include <hip/hip_cooperative_groups.h>
#include <cstdio>
#include <cstdint>
namespace cg = cooperative_groups;
namespace pg8 {
#define PG8_LAS __attribute__((address_space(3)))
typedef unsigned short bf16_t;
typedef short bf16x8 __attribute__((ext_vector_type(8)));
typedef float f32x4 __attribute__((ext_vector_type(4)));
typedef unsigned u32x4 __attribute__((ext_vector_type(4)));
constexpr int BM = 256, BK = 64, HALF = 128, HTB = HALF * BK * 2  , STAGE_BYTES = 8 * HTB, NXCD = 8, WGM = 8;

__host__ __device__ __forceinline__ int lds_byte(int r, int c) { const int st = (r >> 4) * 2 + (c >> 5), rr = r & 15, cc = c & 31, ob = rr * 64 + cc * 2; return st * 1024 + (ob ^ (((ob >> 9) & 1) << 5)); }
__host__ __device__ __forceinline__ void stage_rc(int b, int& R, int& C) { const int st = b / 1024, sb = b % 1024, swz = sb ^ (((sb >> 9) & 1) << 5); R = (st >> 1) * 16 + swz / 64; C = (st & 1) * 32 + (swz % 64) / 2; }
__host__ __device__ __forceinline__ int perm32(int rho) { const int n = rho >> 4, i = rho & 15; return 8 * (i >> 2) + 4 * n + (i & 3); }

struct Unit { int pm, pn; };
struct Gemm { const bf16_t* A; const bf16_t* Bt; int M, N, K, lda; };

struct StaticOrder {
    int nM, nN, nwg, G, c;
    __host__ __device__ void init(int M, int N, int G_, int c_) { nM = M / BM; nN = N / BM; nwg = nM * nN; G = G_; c = c_; }
    __host__ __device__ bool next(int i, Unit& u) const {
        const long L = (long)i * G + c; if (L >= nwg) return false;
        int wgid = (int)L; { const int q = nwg / NXCD, r = nwg % NXCD, xcd = wgid % NXCD, off = wgid / NXCD; wgid = (xcd < r ? xcd * (q + 1) : r * (q + 1) + (xcd - r) * q) + off; }
        const int nig = WGM * nN, gid = wgid / nig, fm = gid * WGM, gsz = (nM - fm) < WGM ? (nM - fm) : WGM;
        u.pm = fm + ((wgid % nig) % gsz); u.pn = (wgid % nig) / gsz; return true;
    }
    __device__ __forceinline__ void a_ready(const Unit&) const {}
    __device__ __forceinline__ void done(const Unit&) const {}
};

__device__ __forceinline__ unsigned cvt_pk_bf16(float lo, float hi) { unsigned r; asm volatile("v_cvt_pk_bf16_f32 %0, %1, %2" : "=v"(r) : "v"(lo), "v"(hi)); return r; }
typedef float f32x2 __attribute__((ext_vector_type(2)));
__device__ __forceinline__ f32x2 gelu_pk(f32x2 v) {
    const f32x2 av = __builtin_elementwise_abs(v), d = av * 0.2316418882f + 1.0f;
    f32x2 t; t.x = __builtin_amdgcn_rcpf(d.x); t.y = __builtin_amdgcn_rcpf(d.y);
    f32x2 q = t * 0.5307027145f + (-0.7265760135f); q = q * t + 0.7107068705f; q = q * t + (-0.142248368f); q = q * t + 0.127414796f; q = q * t;
    const f32x2 s = (v * v) * (-0.72134752044f);
    f32x2 e; e.x = __builtin_amdgcn_exp2f(s.x); e.y = __builtin_amdgcn_exp2f(s.y);
    const f32x2 m = v * (q * e), r = v - m;
    f32x2 o; o.x = v.x < 0.f ? m.x : r.x; o.y = v.y < 0.f ? m.y : r.y; return o;
}
typedef unsigned u32x2 __attribute__((ext_vector_type(2)));
__device__ __forceinline__ float sigm(float x) { return __builtin_amdgcn_rcpf(1.0f + __builtin_amdgcn_exp2f(x * -1.44269504089f)); }
__device__ __forceinline__ float bf_lo(unsigned u) { return __uint_as_float(u << 16); }
__device__ __forceinline__ float bf_hi(unsigned u) { return __uint_as_float(u & 0xffff0000u); }

struct EpiG1 {
    static constexpr bool PERM = true, AFTER_DRAIN = false;
    bf16_t* GLU; bf16_t* UV; bf16_t* GG;
    __device__ __forceinline__ void operator()(const f32x4 (&acc)[2][2][4][2], const Unit& u, int wr, int wc, int fr, int fq) const {
        const int row0 = u.pm * BM + wr * 64 + fr;
        if (u.pn < 8) {
            const int col = u.pn * 128 + wc * 32 + 8 * fq;
#pragma unroll
            for (int ai = 0; ai < 2; ++ai)
#pragma unroll
                for (int m = 0; m < 4; ++m) {
                    const f32x4 v0 = acc[ai][0][m][0], v1 = acc[ai][0][m][1], g0 = acc[ai][1][m][0], g1 = acc[ai][1][m][1];
                    u32x4 w; w.x = cvt_pk_bf16(v0[0] * sigm(g0[0]), v0[1] * sigm(g0[1])); w.y = cvt_pk_bf16(v0[2] * sigm(g0[2]), v0[3] * sigm(g0[3]));
                    w.z = cvt_pk_bf16(v1[0] * sigm(g1[0]), v1[1] * sigm(g1[1])); w.w = cvt_pk_bf16(v1[2] * sigm(g1[2]), v1[3] * sigm(g1[3]));
                    *(u32x4*)(GLU + (size_t)(row0 + ai * HALF + m * 16) * 1024 + col) = w; }
        } else {
            const bool isg = u.pn < 16;
            bf16_t* base = isg ? UV : GG;
            const int col0 = (isg ? (u.pn - 8) : (u.pn - 16)) * BM + wc * 32 + 8 * fq;
#pragma unroll
            for (int ai = 0; ai < 2; ++ai)
#pragma unroll
                for (int m = 0; m < 4; ++m) { bf16_t* rowp = base + (size_t)(row0 + ai * HALF + m * 16) * 2048 + col0;
#pragma unroll
                    for (int bj = 0; bj < 2; ++bj) { f32x4 v0 = acc[ai][bj][m][0], v1 = acc[ai][bj][m][1];
                        if (isg) { f32x2 a = gelu_pk((f32x2){v0[0], v0[1]}), b = gelu_pk((f32x2){v0[2], v0[3]}), c = gelu_pk((f32x2){v1[0], v1[1]}), d = gelu_pk((f32x2){v1[2], v1[3]});
                            v0 = (f32x4){a.x, a.y, b.x, b.y}; v1 = (f32x4){c.x, c.y, d.x, d.y}; }
                        else { v0 = (f32x4){sigm(v0[0]), sigm(v0[1]), sigm(v0[2]), sigm(v0[3])}; v1 = (f32x4){sigm(v1[0]), sigm(v1[1]), sigm(v1[2]), sigm(v1[3])}; }
                        u32x4 w; w.x = cvt_pk_bf16(v0[0], v0[1]); w.y = cvt_pk_bf16(v0[2], v0[3]); w.z = cvt_pk_bf16(v1[0], v1[1]); w.w = cvt_pk_bf16(v1[2], v1[3]);
                        *(u32x4*)(rowp + bj * HALF) = w; } }
        }
    }
};
template <int MODE> struct EpiMerge {
    static constexpr bool PERM = true, AFTER_DRAIN = false;
    bf16_t* MG; const bf16_t* GG;
    __device__ __forceinline__ void operator()(const f32x4 (&acc)[2][2][4][2], const Unit& u, int wr, int wc, int fr, int fq) const {
        const int row0 = u.pm * BM + wr * 64 + fr, col0 = u.pn * BM + wc * 32 + 8 * fq;
#pragma unroll
        for (int ai = 0; ai < 2; ++ai)
#pragma unroll
            for (int m = 0; m < 4; ++m) { const size_t row = (size_t)(row0 + ai * HALF + m * 16);
#pragma unroll
                for (int bj = 0; bj < 2; ++bj) { const int col = col0 + bj * HALF;
                    const u32x4 g = *(const u32x4*)(GG + row * 2048 + MODE * 1024 + col);
                    f32x4 v0 = acc[ai][bj][m][0], v1 = acc[ai][bj][m][1];
                    v0 = v0 * (f32x4){bf_lo(g.x), bf_hi(g.x), bf_lo(g.y), bf_hi(g.y)}; v1 = v1 * (f32x4){bf_lo(g.z), bf_hi(g.z), bf_lo(g.w), bf_hi(g.w)};
                    if (MODE == 1) { const u32x4 p = *(const u32x4*)(MG + row * 1024 + col);
                        v0 = v0 + (f32x4){bf_lo(p.x), bf_hi(p.x), bf_lo(p.y), bf_hi(p.y)}; v1 = v1 + (f32x4){bf_lo(p.z), bf_hi(p.z), bf_lo(p.w), bf_hi(p.w)}; }
                    u32x4 w; w.x = cvt_pk_bf16(v0[0], v0[1]); w.y = cvt_pk_bf16(v0[2], v0[3]); w.z = cvt_pk_bf16(v1[0], v1[1]); w.w = cvt_pk_bf16(v1[2], v1[3]);
                    *(u32x4*)(MG + row * 1024 + col) = w; }
                asm volatile("" ::: "memory"); }
    }
};
struct EpiRes {
    static constexpr bool PERM = false, AFTER_DRAIN = false;
    const float* R0; const float* R1; int msplit; float* Y; bf16_t* YB; float* ss;
    __device__ __forceinline__ void operator()(const f32x4 (&acc)[2][2][4][2], const Unit& u, int wr, int wc, int fr, int fq) const {
        const int row0 = u.pm * BM + wr * 64 + fr, col0 = u.pn * BM + wc * 32 + 4 * fq;
        const float* rb = (u.pm * BM < msplit) ? R0 : (R1 - (size_t)msplit * 1024);
#pragma unroll
        for (int ai = 0; ai < 2; ++ai)
#pragma unroll
            for (int m = 0; m < 4; ++m) { const size_t row = (size_t)(row0 + ai * HALF + m * 16); float s = 0.f;
#pragma unroll
                for (int bj = 0; bj < 2; ++bj)
#pragma unroll
                    for (int n = 0; n < 2; ++n) { const size_t off = row * 1024 + col0 + bj * HALF + n * 16;
                        const f32x4 h = *(const f32x4*)(rb + off) + acc[ai][bj][m][n];
                        *(f32x4*)(Y + off) = h; s += (h[0] * h[0] + h[1] * h[1]) + (h[2] * h[2] + h[3] * h[3]);
                        if (YB) { u32x2 w; w.x = cvt_pk_bf16(h[0], h[1]); w.y = cvt_pk_bf16(h[2], h[3]); *(u32x2*)(YB + off) = w; } }
                s += __shfl_xor(s, 16); s += __shfl_xor(s, 32);
                if (fq == 0) atomicAdd(ss + row, s);
                asm volatile("" ::: "memory"); }
    }
};
struct EpiUp {
    static constexpr bool PERM = true, AFTER_DRAIN = false;
    bf16_t* AB; const float* ss; int ldc;
    __device__ __forceinline__ void operator()(const f32x4 (&acc)[2][2][4][2], const Unit& u, int wr, int wc, int fr, int fq) const {
        const int row0 = u.pm * BM + wr * 64 + fr, col0 = u.pn * BM + wc * 32 + 8 * fq;
#pragma unroll
        for (int ai = 0; ai < 2; ++ai)
#pragma unroll
            for (int m = 0; m < 4; ++m) { const size_t row = (size_t)(row0 + ai * HALF + m * 16);
                const float rs = __builtin_amdgcn_rsqf(ss[row] * (1.0f / 1024.0f) + 1e-6f);
#pragma unroll
                for (int bj = 0; bj < 2; ++bj) { const f32x4 v0 = acc[ai][bj][m][0] * rs, v1 = acc[ai][bj][m][1] * rs;
                    u32x4 w; w.x = cvt_pk_bf16(v0[0], v0[1]); w.y = cvt_pk_bf16(v0[2], v0[3]); w.z = cvt_pk_bf16(v1[0], v1[1]); w.w = cvt_pk_bf16(v1[2], v1[3]);
                    *(u32x4*)(AB + row * ldc + col0 + bj * HALF) = w; } }
    }
};
template <class Epi, class Sched, bool ALIGN_EPI = false, bool SP2 = false>
__device__ __forceinline__ void gemm_phase(PG8_LAS unsigned char* lds, const Gemm g, const Sched& S, const Epi& E) {
    int tid_ = threadIdx.x; asm volatile("" : "+v"(tid_));
    const int tid = tid_, wid = __builtin_amdgcn_readfirstlane(tid >> 6), lane = tid & 63, wr = wid >> 2, wc = wid & 3, fr = lane & 15, fq = lane >> 4;
    const int K = g.K, nt = K / BK;
    unsigned voffA[2], voffB[2];
#pragma unroll
    for (int i = 0; i < 2; ++i) { int R, C; stage_rc(tid * 16 + i * 8192, R, C); const int Rb = Epi::PERM ? ((R & ~31) + perm32(R & 31)) : R;
        voffA[i] = (unsigned)(R * g.lda + C) * 2u; voffB[i] = (unsigned)(Rb * K + C) * 2u; }
    const size_t kstep = (size_t)(BK * 2);
    const size_t hA = (size_t)HALF * g.lda * 2, hB = (size_t)HALF * K * 2;
    const size_t tA = 2 * hA, tB = 2 * hB;
    const unsigned ldsw = (unsigned)wid * 1024u;
    const int aoff = lds_byte(wr * 64 + fr, fq * 8), boff = lds_byte(wc * 32 + fr, fq * 8);
#define PG8_SA(b, h) (((b) * 2 + (h)) * HTB)
#define PG8_SB(b, h) ((4 + (b) * 2 + (h)) * HTB)
#define PG8_STAGE(bufoff, gbase, voff) do { _Pragma("unroll") for (int _i = 0; _i < 2; ++_i) \
        __builtin_amdgcn_global_load_lds((const unsigned*)((const char*)(gbase) + (voff)[_i]), (PG8_LAS unsigned*)(lds + (bufoff) + ldsw + _i * 8192), 16, 0, 0); } while (0)
#define PG8_LDA(dst, b, h) do { _Pragma("unroll") for (int m = 0; m < 4; ++m) _Pragma("unroll") for (int k = 0; k < 2; ++k) dst[m][k] = *(const PG8_LAS bf16x8*)(lds + PG8_SA(b, h) + aoff + m * 2048 + k * 1024); } while (0)
#define PG8_LDB(dst, b, h) do { _Pragma("unroll") for (int n = 0; n < 2; ++n) _Pragma("unroll") for (int k = 0; k < 2; ++k) dst[n][k] = *(const PG8_LAS bf16x8*)(lds + PG8_SB(b, h) + boff + n * 2048 + k * 1024); } while (0)
#define PG8_MMA(ai, bj, At, Bt) do { __builtin_amdgcn_s_setprio(1); _Pragma("unroll") for (int m = 0; m < 4; ++m) _Pragma("unroll") for (int n = 0; n < 2; ++n) _Pragma("unroll") for (int k = 0; k < 2; ++k) \
        acc[ai][bj][m][n] = __builtin_amdgcn_mfma_f32_16x16x32_bf16(Bt[n][k], At[m][k], acc[ai][bj][m][n], 0, 0, 0); __builtin_amdgcn_s_setprio(0); } while (0)
#define PG8_WAIT_V(n) asm volatile("s_waitcnt vmcnt(" #n ")" ::: "memory")
#define PG8_WAIT_L(n) asm volatile("s_waitcnt lgkmcnt(" #n ")" ::: "memory")
#define PG8_BAR __builtin_amdgcn_s_barrier()
#define PG8_SCHED __builtin_amdgcn_sched_barrier(0)
    Unit cur, nxt; int ui = 0;
    if (!S.next(0, cur)) return;
    f32x4 acc[2][2][4][2];
#pragma unroll
    for (int a = 0; a < 2; ++a)
#pragma unroll
        for (int b = 0; b < 2; ++b)
#pragma unroll
            for (int m = 0; m < 4; ++m)
#pragma unroll
                for (int n = 0; n < 2; ++n) acc[a][b][m][n] = (f32x4){0.f, 0.f, 0.f, 0.f};
    bf16x8 At[4][2], B0[2][2], B1[2][2];
    const char* cA = (const char*)g.A + (size_t)cur.pm * tA; const char* cB = (const char*)g.Bt + (size_t)cur.pn * tB;
    S.a_ready(cur);
    if constexpr (SP2) {
        PG8_STAGE(PG8_SB(0, 0), cB, voffB); PG8_STAGE(PG8_SB(0, 1), cB + hB, voffB); PG8_STAGE(PG8_SA(0, 0), cA, voffA); PG8_STAGE(PG8_SA(0, 1), cA + hA, voffA);
        if (wr == 1) PG8_BAR;
        PG8_WAIT_V(2); PG8_BAR;
        PG8_STAGE(PG8_SB(1, 0), cB + kstep, voffB); PG8_STAGE(PG8_SA(1, 0), cA + kstep, voffA); PG8_STAGE(PG8_SB(1, 1), cB + hB + kstep, voffB);
        PG8_WAIT_V(6); PG8_BAR;
    } else {
        PG8_STAGE(PG8_SB(0, 0), cB, voffB); PG8_STAGE(PG8_SA(0, 0), cA, voffA); PG8_STAGE(PG8_SB(0, 1), cB + hB, voffB); PG8_STAGE(PG8_SA(0, 1), cA + hA, voffA);
        if (wr == 1) PG8_BAR;
        PG8_WAIT_V(4); PG8_BAR;
        PG8_STAGE(PG8_SB(1, 0), cB + kstep, voffB); PG8_STAGE(PG8_SA(1, 0), cA + kstep, voffA); PG8_STAGE(PG8_SB(1, 1), cB + hB + kstep, voffB);
        PG8_WAIT_V(6); PG8_BAR;
    }
    for (;;) {
        const bool has_next = S.next(ui + 1, nxt);
        const char* nA = has_next ? (const char*)g.A + (size_t)nxt.pm * tA : cA; const char* nB = has_next ? (const char*)g.Bt + (size_t)nxt.pn * tB : cB;
        for (int t = 0; t < nt; t += 2) {
            const bool last = (t == nt - 2);
            const char* a1 = cA + (size_t)(t + 1) * kstep;
            const char* a2 = last ? nA : cA + (size_t)(t + 2) * kstep; const char* b2 = last ? nB : cB + (size_t)(t + 2) * kstep;
            const char* a3 = a2 + kstep; const char* b3 = b2 + kstep;
            if (last && has_next) S.a_ready(nxt);
            if constexpr (SP2) {
            PG8_LDB(B0, 0, 0); PG8_LDB(B1, 0, 1); PG8_SCHED; PG8_LDA(At, 0, 0); PG8_STAGE(PG8_SA(1, 1), a1 + hA, voffA);
            PG8_WAIT_V(8); PG8_WAIT_L(0); PG8_BAR; PG8_MMA(0, 0, At, B0); PG8_MMA(0, 1, At, B1); PG8_BAR; PG8_SCHED;
            PG8_LDA(At, 0, 1); PG8_STAGE(PG8_SB(0, 0), b2, voffB); PG8_STAGE(PG8_SB(0, 1), b2 + hB, voffB); PG8_STAGE(PG8_SA(0, 0), a2, voffA);
            PG8_WAIT_V(8); PG8_WAIT_L(0); PG8_BAR; PG8_MMA(1, 0, At, B0); PG8_MMA(1, 1, At, B1); PG8_BAR; PG8_SCHED;
            PG8_LDB(B0, 1, 0); PG8_LDB(B1, 1, 1); PG8_SCHED; PG8_LDA(At, 1, 0); PG8_STAGE(PG8_SA(0, 1), a2 + hA, voffA);
            PG8_WAIT_V(8); PG8_WAIT_L(0); PG8_BAR; PG8_MMA(0, 0, At, B0); PG8_MMA(0, 1, At, B1); PG8_BAR; PG8_SCHED;
            PG8_LDA(At, 1, 1); PG8_STAGE(PG8_SB(1, 0), b3, voffB); PG8_STAGE(PG8_SB(1, 1), b3 + hB, voffB); PG8_STAGE(PG8_SA(1, 0), a3, voffA);
            PG8_WAIT_V(8); PG8_WAIT_L(0); PG8_BAR; PG8_MMA(1, 0, At, B0); PG8_MMA(1, 1, At, B1); PG8_BAR; PG8_SCHED;
            } else {
            PG8_LDB(B0, 0, 0); PG8_SCHED; PG8_LDA(At, 0, 0); PG8_STAGE(PG8_SA(1, 1), a1 + hA, voffA);
            PG8_WAIT_L(8); PG8_BAR; PG8_WAIT_L(0); PG8_MMA(0, 0, At, B0); PG8_BAR; PG8_SCHED;
            PG8_LDB(B1, 0, 1); PG8_STAGE(PG8_SB(0, 0), b2, voffB);
            PG8_BAR; PG8_WAIT_L(0); PG8_MMA(0, 1, At, B1); PG8_BAR;
            PG8_LDA(At, 0, 1); PG8_STAGE(PG8_SA(0, 0), a2, voffA);
            PG8_BAR; PG8_WAIT_L(0); PG8_MMA(1, 0, At, B0); PG8_BAR; PG8_SCHED;
            PG8_STAGE(PG8_SB(0, 1), b2 + hB, voffB);
            PG8_WAIT_V(6); PG8_BAR; PG8_MMA(1, 1, At, B1); PG8_BAR;
            PG8_LDB(B0, 1, 0); PG8_SCHED; PG8_LDA(At, 1, 0); PG8_STAGE(PG8_SA(0, 1), a2 + hA, voffA);
            PG8_WAIT_L(8); PG8_BAR; PG8_WAIT_L(0); PG8_MMA(0, 0, At, B0); PG8_BAR; PG8_SCHED;
            PG8_LDB(B1, 1, 1); PG8_STAGE(PG8_SB(1, 0), b3, voffB);
            PG8_BAR; PG8_WAIT_L(0); PG8_MMA(0, 1, At, B1); PG8_BAR;
            PG8_LDA(At, 1, 1); PG8_STAGE(PG8_SA(1, 0), a3, voffA);
            PG8_BAR; PG8_WAIT_L(0); PG8_MMA(1, 0, At, B0); PG8_BAR; PG8_SCHED;
            PG8_STAGE(PG8_SB(1, 1), b3 + hB, voffB);
            PG8_WAIT_V(6); PG8_BAR; PG8_MMA(1, 1, At, B1); PG8_BAR;
            }
        }
        if constexpr (ALIGN_EPI) { if (wr == 0) PG8_BAR; }
        if constexpr (!Epi::AFTER_DRAIN) { E(acc, cur, wr, wc, fr, fq); S.done(cur); }
        if (!has_next) break;
#pragma unroll
        for (int a = 0; a < 2; ++a)
#pragma unroll
            for (int b = 0; b < 2; ++b)
#pragma unroll
                for (int m = 0; m < 4; ++m)
#pragma unroll
                    for (int n = 0; n < 2; ++n) acc[a][b][m][n] = (f32x4){0.f, 0.f, 0.f, 0.f};
        cur = nxt; cA = nA; cB = nB; ++ui;
        if constexpr (ALIGN_EPI) { if (wr == 1) PG8_BAR; }
    }
    PG8_WAIT_V(0);
    if constexpr (!ALIGN_EPI) { if (wr == 0) PG8_BAR; }
    PG8_BAR;
    if constexpr (Epi::AFTER_DRAIN) { E.fused(acc, cur, wr, wc, fr, fq, lds, wid, lane); S.done(cur); }
#undef PG8_SA
#undef PG8_SB
#undef PG8_STAGE
#undef PG8_LDA
#undef PG8_LDB
#undef PG8_MMA
#undef PG8_WAIT_V
#undef PG8_WAIT_L
#undef PG8_BAR
#undef PG8_SCHED
}
}

constexpr int DM = 1024, NBP = 8, SEQ = 2048, NBS = 128, TS = 4, MP = NBP * SEQ, MS = NBS * TS, MT = MP + MS;
constexpr int NIN = 6144, DFF = 2816, NUP = 2 * DFF, CAW = 31, HB = 8;
constexpr float EPS = 1e-6f;
constexpr int NWAVES = 8, NTHR = 512;
constexpr size_t O_Y = 0, O_CAP = (size_t)MT * DM, O_CAS = O_CAP + (size_t)NBP * 30 * DM, O_VS = O_CAS + (size_t)NBS * 30 * DM, O_FP = O_VS + (size_t)MS * DM, O_FS = O_FP + (size_t)NBP * 2 * DFF, O_END = O_FS + (size_t)NBS * 2 * DFF;
constexpr size_t MiB = 1u << 20;
constexpr size_t WS_SS1 = 0, WS_SS2 = 128 * 1024, WS_BAR = 512 * 1024;
constexpr size_t WS_WUP = 1 * MiB, WS_WDN = 12 * MiB, WS_WIN = 18 * MiB, WS_WA = 30 * MiB, WS_WB = 32 * MiB, WS_WO = 34 * MiB;
constexpr size_t WS_XN = 36 * MiB;
constexpr size_t WS_GLU = 69 * MiB, WS_UV = 102 * MiB, WS_GG = 168 * MiB;
constexpr size_t WS_MG = WS_GLU;
constexpr size_t WS_AB = WS_GLU;
constexpr size_t WS_END = WS_AB + (size_t)MT * NUP * 2;
static_assert(WS_END <= 256 * MiB && WS_GG + (size_t)MT * 2048 * 2 <= 256 * MiB, "d_ws map");
constexpr int LDS_BYTES = 147456;

#define LAS __attribute__((address_space(3)))
typedef unsigned short bf16;
typedef unsigned v4u __attribute__((ext_vector_type(4)));
typedef unsigned v2u __attribute__((ext_vector_type(2)));
typedef float f32x4 __attribute__((ext_vector_type(4)));
typedef float f32x2 __attribute__((ext_vector_type(2)));
typedef short bf16x8 __attribute__((ext_vector_type(8)));
#define LDS_WAIT() asm volatile("s_waitcnt lgkmcnt(0)" ::: "memory")
__device__ __forceinline__ unsigned f2bf(float f) { unsigned u = __builtin_bit_cast(unsigned, f); return (u + 0x7fffu + ((u >> 16) & 1u)) >> 16; }
__device__ __forceinline__ unsigned pk2(float lo, float hi) { return f2bf(lo) | (f2bf(hi) << 16); }
__device__ __forceinline__ float blo(unsigned u) { return __uint_as_float(u << 16); }
__device__ __forceinline__ float bhi(unsigned u) { return __uint_as_float(u & 0xffff0000u); }
__device__ __forceinline__ float sigmf(float x) { return __builtin_amdgcn_rcpf(1.0f + __builtin_amdgcn_exp2f(x * -1.44269504089f)); }
__device__ __forceinline__ float wave_sum(float v) {
#pragma unroll
    for (int o = 1; o < 64; o <<= 1) v += __shfl_xor(v, o);
    return v;
}

struct Args { const float* in[23]; float* out; unsigned char* ws; };
struct Frame { LAS unsigned char* lds; int tid, lane, wave, vcu, G; };
__device__ __forceinline__ Frame phase_frame(const Frame& F0) { Frame F = F0; int t = F0.tid; asm volatile("" : "+v"(t)); F.tid = t; F.lane = t & 63; return F; }

#define XB_TMO      128
#define XB_XCNT(j)  (256  + 64 * (j))
#define XB_XSUB(j)  (1280 + 64 * (j))
#define XB_XGEN(j)  (2304 + 64 * (j))
#define XB_TOP      3328
#define XB_TOPGEN   3392
#define XCD_BAR_WORDS 3456
#define XB_SPIN_CAP (1u << 18)

__device__ __forceinline__ unsigned xb_ld(unsigned* p)              { return __hip_atomic_load(p, __ATOMIC_RELAXED, __HIP_MEMORY_SCOPE_AGENT); }
__device__ __forceinline__ unsigned xb_add(unsigned* p, unsigned v) { return __hip_atomic_fetch_add(p, v, __ATOMIC_RELAXED, __HIP_MEMORY_SCOPE_AGENT); }
__device__ __forceinline__ unsigned xb_xcc_id() { return (unsigned)__builtin_amdgcn_s_getreg((3 << 11) | 20) & 0xFu; }
#define XB_SPIN(cond, bar) do { unsigned _sp = 0; while (cond) { __builtin_amdgcn_s_sleep(1); \
    if ((++_sp & 255u) == 0u) { if (xb_ld(&(bar)[XB_TMO])) break; if (_sp > XB_SPIN_CAP) { atomicAdd(&(bar)[XB_TMO], 1u); break; } } } } while (0)

struct XcdBarrier {
    unsigned* bar; unsigned x;
    volatile LAS unsigned* st;
};

__device__ __forceinline__ XcdBarrier xcd_barrier_post(unsigned* bar, volatile LAS unsigned* st) {
    XcdBarrier b; b.bar = bar; b.x = xb_xcc_id(); b.st = st;
    if (threadIdx.x == 0) (void)xb_add(&bar[XB_XCNT(b.x)], 1u);
    return b;
}
__device__ __forceinline__ void xcd_barrier_complete(unsigned* bar, unsigned x, unsigned& nloc, unsigned& nx) {
    const unsigned G = gridDim.x * gridDim.y * gridDim.z;
    unsigned sum, cnt, mine, sp = 0u;
    for (;;) {
        sum = 0u; cnt = 0u; mine = 0u;
#pragma unroll
        for (unsigned j = 0; j < 16; ++j) { const unsigned c = xb_ld(&bar[XB_XCNT(j)]); sum += c; cnt += (c > 0u) ? 1u : 0u; mine = (j == x) ? c : mine; }
        if (sum == G) break;
        __builtin_amdgcn_s_sleep(1);
        if ((++sp & 255u) == 0u) { if (xb_ld(&bar[XB_TMO])) break; if (sp > XB_SPIN_CAP) { atomicAdd(&bar[XB_TMO], 1u); break; } }
    }
    nloc = mine > 0u ? mine : 1u; nx = cnt > 0u ? cnt : 1u;
}

__device__ __forceinline__ void xcd_barrier(const XcdBarrier& b) {
    asm volatile("s_waitcnt vmcnt(0)" ::: "memory");
    __syncthreads();
    if (threadIdx.x == 0) {
        unsigned* bar = b.bar;
        __builtin_amdgcn_s_waitcnt(0);
        unsigned nloc = b.st[0], nx = b.st[1];
        if (nloc == 0u) { xcd_barrier_complete(bar, b.x, nloc, nx); b.st[0] = nloc; b.st[1] = nx; }
        const unsigned old = xb_add(&bar[XB_XSUB(b.x)], 1u);
        const unsigned gen = old / nloc;
        if (old + 1u == (gen + 1u) * nloc) {
            __builtin_amdgcn_fence(__ATOMIC_RELEASE, "agent");
            asm volatile("s_waitcnt vmcnt(0)" ::: "memory");
            const unsigned og = xb_add(&bar[XB_TOP], 1u);
            const unsigned tg = og / nx;
            if (og + 1u == (tg + 1u) * nx) xb_add(&bar[XB_TOPGEN], 1u);
            else XB_SPIN(xb_ld(&bar[XB_TOPGEN]) == tg, bar);
            __builtin_amdgcn_fence(__ATOMIC_ACQUIRE, "agent");
            xb_add(&bar[XB_XGEN(b.x)], 1u);
            asm volatile("s_waitcnt vmcnt(0)" ::: "memory");
        } else {
            XB_SPIN(xb_ld(&bar[XB_XGEN(b.x)]) == gen, bar);
            __builtin_amdgcn_fence(__ATOMIC_ACQUIRE, "agent");
            asm volatile("s_waitcnt vmcnt(0)" ::: "memory");
        }
    }
    __syncthreads();
}

__device__ __forceinline__ void p0_transpose_item(const float* W, int K, int N, bf16* WT, int mode, const float* kscale, LAS float* scr, int item, int lane) {
    const int nblk = N / 32, kb = item / nblk, nb = item % nblk, k0 = 64 * kb, n0 = 32 * nb;
#pragma unroll 8
    for (int i = 0; i < 32; ++i) { const int kk = 2 * i + (lane >> 5); float v = W[(size_t)(k0 + kk) * N + n0 + (lane & 31)]; if (kscale) v *= kscale[k0 + kk]; scr[kk * 33 + (lane & 31)] = v; }
    LDS_WAIT(); asm volatile("" ::: "memory");
    int n0m = n0;
    if (mode == 1 && n0 < 2048) { const int half = n0 >= 1024 ? 1 : 0, ch = n0 - 1024 * half; n0m = 256 * (ch >> 7) + 128 * half + (ch & 127); }
    const int c = lane & 7;
#pragma unroll
    for (int j = 0; j < 4; ++j) { const int n = (lane >> 3) + 8 * j; const LAS float* s = scr + (8 * c) * 33 + n;
        v4u o; o.x = pk2(s[0 * 33], s[1 * 33]); o.y = pk2(s[2 * 33], s[3 * 33]); o.z = pk2(s[4 * 33], s[5 * 33]); o.w = pk2(s[6 * 33], s[7 * 33]);
        *(v4u*)(WT + (size_t)(n0m + n) * K + k0 + 8 * c) = o; }
    LDS_WAIT(); asm volatile("" ::: "memory");
}
__device__ __forceinline__ void rms_row_to_bf16(const float* xrow, const float* g, bf16* orow, int lane) {
    const f32x4* xr = (const f32x4*)xrow + lane; const f32x4* gr = (const f32x4*)g + lane;
    f32x4 v[4]; float s = 0.f;
#pragma unroll
    for (int j = 0; j < 4; ++j) { v[j] = xr[64 * j]; s += (v[j].x * v[j].x + v[j].y * v[j].y) + (v[j].z * v[j].z + v[j].w * v[j].w); }
    const float rstd = 1.0f / sqrtf(wave_sum(s) * (1.f / DM) + EPS);
    unsigned long long* o8 = (unsigned long long*)orow + lane;
#pragma unroll
    for (int j = 0; j < 4; ++j) { const f32x4 gg = gr[64 * j]; o8[64 * j] = (unsigned long long)pk2(v[j].x * rstd * gg.x, v[j].y * rstd * gg.y) | ((unsigned long long)pk2(v[j].z * rstd * gg.z, v[j].w * rstd * gg.w) << 32); }
}
__device__ __forceinline__ void p0_prologue(const Frame& F0, const Args& a) {
    const Frame F = phase_frame(F0);
    unsigned char* ws = a.ws;
    LAS float* scr = (LAS float*)(F.lds + F.wave * 16384);
    const int gw = F.vcu * NWAVES + F.wave, NGW = F.G * NWAVES;
    constexpr int I_IN = (DM / 64) * (NIN / 32), I_SQ = (DM / 64) * (DM / 32), I_UP = (DM / 64) * (NUP / 32), I_DN = (DFF / 64) * (DM / 32);
    constexpr int NITEMS = I_IN + 3 * I_SQ + I_UP + I_DN;
    for (int it = gw; it < NITEMS; it += NGW) {
        int r = it;
        if (r < I_IN) { p0_transpose_item(a.in[5], DM, NIN, (bf16*)(ws + WS_WIN), 1, nullptr, scr, r, F.lane); continue; } r -= I_IN;
        if (r < I_SQ) { p0_transpose_item(a.in[10], DM, DM, (bf16*)(ws + WS_WA), 0, nullptr, scr, r, F.lane); continue; } r -= I_SQ;
        if (r < I_SQ) { p0_transpose_item(a.in[15], DM, DM, (bf16*)(ws + WS_WB), 0, nullptr, scr, r, F.lane); continue; } r -= I_SQ;
        if (r < I_SQ) { p0_transpose_item(a.in[16], DM, DM, (bf16*)(ws + WS_WO), 0, nullptr, scr, r, F.lane); continue; } r -= I_SQ;
        if (r < I_UP) { p0_transpose_item(a.in[18], DM, NUP, (bf16*)(ws + WS_WUP), 0, a.in[17], scr, r, F.lane); continue; } r -= I_UP;
        p0_transpose_item(a.in[21], DFF, DM, (bf16*)(ws + WS_WDN), 0, nullptr, scr, r, F.lane);
    }
    bf16* XN = (bf16*)(ws + WS_XN);
    for (int m = gw; m < MT; m += NGW) {
        const float* xr = m < MP ? a.in[0] + (size_t)m * DM : a.in[1] + (size_t)(m - MP) * DM;
        rms_row_to_bf16(xr, a.in[4], XN + (size_t)m * DM, F.lane);
    }
    float* ss = (float*)(ws + WS_SS1);
    for (int i = F.vcu * NTHR + F.tid; i < (int)(2 * WS_SS2 / 4); i += F.G * NTHR) ss[i] = 0.f;
    if (blockIdx.x == 0) { unsigned* bw = (unsigned*)(ws + WS_BAR); for (int i = F.tid; i < XCD_BAR_WORDS; i += NTHR) bw[i] = 0u; }
}

__device__ __forceinline__ void ln_silu_row(const LAS float* src, bf16* dst, const float* g, const float* bt, int lane) {
    f32x4 v[4]; float s = 0.f;
#pragma unroll
    for (int j = 0; j < 4; ++j) { v[j] = *(const LAS f32x4*)(src + 4 * lane + 256 * j); s += (v[j].x + v[j].y) + (v[j].z + v[j].w); }
    const float mean = wave_sum(s) * (1.f / DM); float s2 = 0.f;
#pragma unroll
    for (int j = 0; j < 4; ++j) { v[j] = v[j] - mean; s2 += (v[j].x * v[j].x + v[j].y * v[j].y) + (v[j].z * v[j].z + v[j].w * v[j].w); }
    const float rstd = 1.0f / sqrtf(wave_sum(s2) * (1.f / DM) + EPS);
#pragma unroll
    for (int j = 0; j < 4; ++j) { const f32x4 gg = *(const f32x4*)(g + 4 * lane + 256 * j), bb = *(const f32x4*)(bt + 4 * lane + 256 * j);
        f32x4 y = v[j] * rstd * gg + bb; y = (f32x4){y.x * sigmf(y.x), y.y * sigmf(y.y), y.z * sigmf(y.z), y.w * sigmf(y.w)};
        v2u w; w.x = pk2(y.x, y.y); w.y = pk2(y.z, y.w); *(v2u*)(dst + 4 * lane + 256 * j) = w; }
}
__device__ __forceinline__ void convA_prompt(const Frame& F0, const Args& a, const unsigned* G32, bf16* ACTA, size_t grow0, bool has_hist, float* capout) {
    const Frame F = phase_frame(F0);
    const int c0 = 2 * F.tid;
    LAS float* CB = (LAS float*)F.lds;
    const float* dw = a.in[6];
    f32x2 w[CAW];
#pragma unroll
    for (int k = 0; k < CAW; ++k) w[k] = *(const f32x2*)(dw + k * DM + c0);
    const f32x2 bias = *(const f32x2*)(a.in[7] + c0);
    f32x2 ring[32];
#pragma unroll
    for (int j = 0; j < 32; ++j) ring[j] = (f32x2){0.f, 0.f};
    if (has_hist) {
        const unsigned* hp = G32 + (grow0 - 30) * 512 + F.tid;
#pragma unroll
        for (int j = 0; j < 30; ++j) { const unsigned u = hp[(size_t)j * 512]; ring[2 + j] = (f32x2){blo(u), bhi(u)}; }
    }
    for (int base = 0; base < 64; base += 32) {
        const unsigned* gp = G32 + (grow0 + base) * 512 + F.tid;
#pragma unroll
        for (int jg = 0; jg < 32; jg += 8) {
            unsigned tmp[8];
#pragma unroll
            for (int jj = 0; jj < 8; ++jj) tmp[jj] = gp[(size_t)(jg + jj) * 512];
#pragma unroll
            for (int jj = 0; jj < 8; ++jj) {
                const int j = jg + jj;
                const f32x2 nv = (f32x2){blo(tmp[jj]), bhi(tmp[jj])};
                ring[j] = nv;
                f32x2 o = bias;
#pragma unroll
                for (int k = 0; k < CAW; ++k) o += ring[(j + k + 2) & 31] * w[k];
                *(LAS f32x2*)(CB + j * DM + c0) = o;
            }
            __builtin_amdgcn_sched_barrier(0);
        }
        if (capout && base == 32) {
#pragma unroll
            for (int j = 2; j < 32; ++j) *(f32x2*)(capout + (size_t)(j - 2) * DM + c0) = ring[j];
        }
        __syncthreads();
#pragma unroll 1
        for (int r = F.wave; r < 32; r += NWAVES) ln_silu_row(CB + r * DM, ACTA + (grow0 + base + r) * DM, a.in[8], a.in[9], F.lane);
        __syncthreads();
    }
}
__device__ __forceinline__ void convA_sample(const Frame& F0, const Args& a, const unsigned* G32, bf16* ACTA, int s, const float* hst, float* casout) {
    const Frame F = phase_frame(F0);
    const int c0 = 2 * F.tid;
    LAS float* CB = (LAS float*)F.lds;
    const float* dw = a.in[6];
    f32x2 w[CAW];
#pragma unroll
    for (int k = 0; k < CAW; ++k) w[k] = *(const f32x2*)(dw + k * DM + c0);
    const f32x2 bias = *(const f32x2*)(a.in[7] + c0);
    f32x2 o[4] = {bias, bias, bias, bias};
    const size_t grow0 = (size_t)MP + 4 * s;
#pragma unroll
    for (int i = 0; i < 34; ++i) {
        f32x2 x;
        if (i < 30) x = *(const f32x2*)(hst + i * DM + c0);
        else { const unsigned u = G32[(grow0 + (i - 30)) * 512 + F.tid]; x = (f32x2){blo(u), bhi(u)}; }
        if (i >= 4) *(f32x2*)(casout + (i - 4) * DM + c0) = x;
#pragma unroll
        for (int t = 0; t < 4; ++t) { const int k = i - t; if (k >= 0 && k < CAW) o[t] += x * w[k]; }
    }
#pragma unroll
    for (int t = 0; t < 4; ++t) *(LAS f32x2*)(CB + t * DM + c0) = o[t];
    __syncthreads();
    if (F.wave < 4) ln_silu_row(CB + F.wave * DM, ACTA + (grow0 + F.wave) * DM, a.in[8], a.in[9], F.lane);
    __syncthreads();
}

__device__ __forceinline__ void ln_stats16(const bf16* vrow, int lane, float (&x)[16], float& mean, float& rstd) {
    const v4u p = *(const v4u*)(vrow + 8 * lane), q = *(const v4u*)(vrow + 512 + 8 * lane);
    x[0] = blo(p.x); x[1] = bhi(p.x); x[2] = blo(p.y); x[3] = bhi(p.y); x[4] = blo(p.z); x[5] = bhi(p.z); x[6] = blo(p.w); x[7] = bhi(p.w);
    x[8] = blo(q.x); x[9] = bhi(q.x); x[10] = blo(q.y); x[11] = bhi(q.y); x[12] = blo(q.z); x[13] = bhi(q.z); x[14] = blo(q.w); x[15] = bhi(q.w);
    float s = 0.f;
#pragma unroll
    for (int i = 0; i < 16; ++i) s += x[i];
    mean = wave_sum(s) * (1.f / DM); float s2 = 0.f;
#pragma unroll
    for (int i = 0; i < 16; ++i) { const float d = x[i] - mean; s2 += d * d; }
    rstd = 1.0f / sqrtf(wave_sum(s2) * (1.f / DM) + EPS);
}
constexpr int VT_LD = 130, WT_LD = 136;
constexpr int MB_STAT = 0, MB_VT = 1024, MB_WT = MB_VT + 128 * VT_LD * 2 + 64;
static_assert(MB_WT % 16 == 0 && MB_WT + 128 * WT_LD * 2 <= 131072, "mixer-B LDS map");
__device__ __forceinline__ void mixB_prompt(const Frame& F0, const Args& a, bf16* UV, int ch, int hh) {
    const Frame F = phase_frame(F0);
    const size_t R0 = (size_t)ch * 128;
    LAS f32x2* STAT = (LAS f32x2*)(F.lds + MB_STAT);
    LAS unsigned char* VT = F.lds + MB_VT; LAS unsigned char* WT = F.lds + MB_WT;
    const float* lng = a.in[11]; const float* lnb = a.in[12]; const float* w_s = a.in[13]; const float* b_s = a.in[14];
    for (int i = 0; i < 16; ++i) { const int r = F.wave * 16 + i; float x[16], mean, rstd; ln_stats16(UV + (R0 + r) * 2048 + 1024, F.lane, x, mean, rstd); if (F.lane == 0) STAT[r] = (f32x2){mean, rstd}; }
    __syncthreads();
    const int lr = F.lane & 15, lq = F.lane >> 4;
    for (int hq = 0; hq < 4; ++hq) {
        const int h = hh * 4 + hq;
#pragma unroll
        for (int i = 0; i < 4; ++i) { const int idx = F.tid + NTHR * i, r = idx >> 4, cgp = idx & 15, c = h * 128 + cgp * 8;
            const v4u p = *(const v4u*)(UV + (R0 + r) * 2048 + 1024 + c); const f32x2 st = STAT[r];
            const f32x4 g0 = *(const f32x4*)(lng + c), g1 = *(const f32x4*)(lng + c + 4), b0 = *(const f32x4*)(lnb + c), b1 = *(const f32x4*)(lnb + c + 4);
            LAS unsigned* dst = (LAS unsigned*)(VT + (r * VT_LD + cgp * 8) * 2);
            dst[0] = pk2((blo(p.x) - st.x) * st.y * g0.x + b0.x, (bhi(p.x) - st.x) * st.y * g0.y + b0.y);
            dst[1] = pk2((blo(p.y) - st.x) * st.y * g0.z + b0.z, (bhi(p.y) - st.x) * st.y * g0.w + b0.w);
            dst[2] = pk2((blo(p.z) - st.x) * st.y * g1.x + b1.x, (bhi(p.z) - st.x) * st.y * g1.y + b1.y);
            dst[3] = pk2((blo(p.w) - st.x) * st.y * g1.z + b1.z, (bhi(p.w) - st.x) * st.y * g1.w + b1.w); }
#pragma unroll
        for (int i = 0; i < 8; ++i) { const int idx = F.tid + NTHR * i, t = idx >> 5, sg = idx & 31;
            const f32x4 wv = *(const f32x4*)(w_s + ((size_t)h * 128 + t) * 128 + sg * 4); const int s0 = sg * 4;
            v2u o; o.x = pk2(s0 <= t ? wv.x : 0.f, s0 + 1 <= t ? wv.y : 0.f); o.y = pk2(s0 + 2 <= t ? wv.z : 0.f, s0 + 3 <= t ? wv.w : 0.f);
            *(LAS v2u*)(WT + (t * WT_LD + s0) * 2) = o; }
        __syncthreads();
        bf16x8 af[4];
#pragma unroll
        for (int ks = 0; ks < 4; ++ks) {
#pragma unroll
            for (int kk = 0; kk < 8; ++kk) af[ks][kk] = (short)*(const LAS unsigned short*)(VT + ((32 * ks + 8 * lq + kk) * VT_LD + 16 * F.wave + lr) * 2);
        }
#pragma unroll
        for (int tb = 0; tb < 8; ++tb) {
            f32x4 acc = (f32x4){0.f, 0.f, 0.f, 0.f};
#pragma unroll
            for (int ks = 0; ks < 4; ++ks) {
                if (32 * ks <= 16 * tb + 15) {
                    const bf16x8 bfr = *(const LAS bf16x8*)(WT + ((16 * tb + lr) * WT_LD + 32 * ks + 8 * lq) * 2);
                    acc = __builtin_amdgcn_mfma_f32_16x16x32_bf16(af[ks], bfr, acc, 0, 0, 0);
                }
            }
            const int t = 16 * tb + lr, c = h * 128 + 16 * F.wave + 4 * lq;
            bf16* up = UV + (R0 + t) * 2048 + c;
            const v2u uu = *(const v2u*)up; const float bsv = b_s[h * 128 + t];
            v2u o; o.x = pk2(blo(uu.x) * (acc[0] + bsv), bhi(uu.x) * (acc[1] + bsv)); o.y = pk2(blo(uu.y) * (acc[2] + bsv), bhi(uu.y) * (acc[3] + bsv));
            *(v2u*)up = o;
        }
        __syncthreads();
    }
}
__device__ __forceinline__ void mixB_sample(const Frame& F0, const Args& a, bf16* UV, int s, float* out_vs) {
    const Frame F = phase_frame(F0);
    LAS float* SV = (LAS float*)F.lds;
    const float* lng = a.in[11]; const float* lnb = a.in[12]; const float* w_s = a.in[13]; const float* b_s = a.in[14];
    const size_t R0 = (size_t)MP + 4 * s;
    if (F.wave < 4) {
        const int t = F.wave; float x[16], mean, rstd; ln_stats16(UV + (R0 + t) * 2048 + 1024, F.lane, x, mean, rstd);
#pragma unroll
        for (int hf = 0; hf < 2; ++hf) { const int c = 512 * hf + 8 * F.lane;
#pragma unroll
            for (int q = 0; q < 2; ++q) { const f32x4 g = *(const f32x4*)(lng + c + 4 * q), b = *(const f32x4*)(lnb + c + 4 * q);
                const f32x4 xv = (f32x4){x[8 * hf + 4 * q], x[8 * hf + 4 * q + 1], x[8 * hf + 4 * q + 2], x[8 * hf + 4 * q + 3]};
                const f32x4 y = (xv - mean) * rstd * g + b;
                *(f32x4*)(out_vs + ((size_t)4 * s + t) * DM + c + 4 * q) = y; *(LAS f32x4*)(SV + t * DM + c + 4 * q) = y; } }
    }
    __syncthreads();
    const int c0 = 2 * F.tid, h = c0 >> 7;
#pragma unroll
    for (int t = 0; t < 4; ++t) {
        const float bsv = b_s[h * 128 + t]; float s0 = bsv, s1 = bsv;
#pragma unroll
        for (int sp = 0; sp <= t; ++sp) { const float wv = w_s[((size_t)h * 128 + t) * 128 + sp]; const f32x2 vv = *(const LAS f32x2*)(SV + sp * DM + c0); s0 += wv * vv.x; s1 += wv * vv.y; }
        unsigned* up = (unsigned*)(UV + (R0 + t) * 2048 + c0); const unsigned uu = *up;
        *up = pk2(blo(uu) * s0, bhi(uu) * s1);
    }
    __syncthreads();
}

__device__ __forceinline__ void unpack8(const v4u p, float (&x)[8]) { x[0] = blo(p.x); x[1] = bhi(p.x); x[2] = blo(p.y); x[3] = bhi(p.y); x[4] = blo(p.z); x[5] = bhi(p.z); x[6] = blo(p.w); x[7] = bhi(p.w); }
__device__ __forceinline__ void ld8f(const float* p, float (&x)[8]) { const f32x4 a = *(const f32x4*)p, b = *(const f32x4*)(p + 4); x[0] = a.x; x[1] = a.y; x[2] = a.z; x[3] = a.w; x[4] = b.x; x[5] = b.y; x[6] = b.z; x[7] = b.w; }
__device__ __forceinline__ void st8f(float* p, const float (&x)[8]) { *(f32x4*)p = (f32x4){x[0], x[1], x[2], x[3]}; *(f32x4*)(p + 4) = (f32x4){x[4], x[5], x[6], x[7]}; }
__device__ __forceinline__ void p6_ffn_act(const Frame& F0, const Args& a, float* out) {
    const Frame F = phase_frame(F0);
    bf16* AB = (bf16*)(a.ws + WS_AB);
    constexpr int NG = DFF / 8, RUN = 16, NPI = (MP / RUN) * NG, NSI = NBS * NG;
    const float* dwf = a.in[19]; const float* bdw = a.in[20]; const float* stf = a.in[3];
    for (int it = F.vcu * NTHR + F.tid; it < NPI + NSI; it += F.G * NTHR) {
        float a2[8], a1[8]; size_t row0; int nrows, c; float* fo = nullptr; int fofrom = 0;
        if (it < NPI) { const int run = it / NG, cgp = it - run * NG; c = cgp * 8; row0 = (size_t)run * RUN; nrows = RUN; const int t0 = (int)(row0 & (SEQ - 1));
            if (t0 > 0) { unpack8(*(const v4u*)(AB + (row0 - 2) * NUP + c), a2); unpack8(*(const v4u*)(AB + (row0 - 1) * NUP + c), a1); }
            else {
#pragma unroll
                for (int j = 0; j < 8; ++j) { a2[j] = 0.f; a1[j] = 0.f; } }
            if (t0 == SEQ - RUN) { fo = out + O_FP + (size_t)(row0 >> 11) * 2 * DFF + c; fofrom = RUN - 2; }
        } else { const int i2 = it - NPI, s = i2 / NG, cgp = i2 - s * NG; c = cgp * 8; row0 = (size_t)MP + 4 * s; nrows = 4;
            ld8f(stf + ((size_t)s * 2 + 0) * DFF + c, a2); ld8f(stf + ((size_t)s * 2 + 1) * DFF + c, a1);
            fo = out + O_FS + (size_t)s * 2 * DFF + c; fofrom = 2; }
        float w0[8], w1[8], w2[8], bs[8]; ld8f(dwf + c, w0); ld8f(dwf + DFF + c, w1); ld8f(dwf + 2 * DFF + c, w2); ld8f(bdw + c, bs);
        for (int i = 0; i < nrows; ++i) {
            bf16* ap = AB + (row0 + i) * NUP + c; float a0[8], bb[8]; unpack8(*(const v4u*)ap, a0); unpack8(*(const v4u*)(ap + DFF), bb);
            float o[8];
#pragma unroll
            for (int j = 0; j < 8; j += 2) { f32x2 cv = (f32x2){a2[j] * w0[j] + a1[j] * w1[j] + a0[j] * w2[j] + bs[j], a2[j + 1] * w0[j + 1] + a1[j + 1] * w1[j + 1] + a0[j + 1] * w2[j + 1] + bs[j + 1]};
                cv = pg8::gelu_pk(cv); o[j] = cv.x * bb[j]; o[j + 1] = cv.y * bb[j + 1]; }
            v4u w; w.x = pk2(o[0], o[1]); w.y = pk2(o[2], o[3]); w.z = pk2(o[4], o[5]); w.w = pk2(o[6], o[7]);
            *(v4u*)(ap + DFF) = w;
            if (fo && i >= fofrom) st8f(fo + (size_t)(i - fofrom) * DFF, a0);
#pragma unroll
            for (int j = 0; j < 8; ++j) { a2[j] = a1[j]; a1[j] = a0[j]; }
        }
    }
}

__global__ void __launch_bounds__(NTHR, 2) fwd_mega(Args a) {
    extern __shared__ __attribute__((aligned(16))) unsigned char lds_raw[];
    cg::grid_group grid = cg::this_grid();
    Frame F; F.lds = (LAS unsigned char*)lds_raw; F.tid = threadIdx.x; F.lane = F.tid & 63; F.wave = __builtin_amdgcn_readfirstlane(F.tid >> 6);
    F.G = gridDim.x; { const int bx = blockIdx.x; F.vcu = (F.G % 8 == 0) ? (bx % 8) * (F.G / 8) + bx / 8 : bx; }
    unsigned char* ws = a.ws; float* out = a.out;
    volatile LAS unsigned* bst = (volatile LAS unsigned*)(F.lds + 131072 + 64);
    if (F.tid < 2) bst[F.tid] = 0u;
    __syncthreads();
    bf16* XN = (bf16*)(ws + WS_XN); bf16* GLU = (bf16*)(ws + WS_GLU); bf16* UV = (bf16*)(ws + WS_UV); bf16* GG = (bf16*)(ws + WS_GG);
    bf16* MG = (bf16*)(ws + WS_MG); bf16* AB = (bf16*)(ws + WS_AB); bf16* ACTA = (bf16*)(out + O_Y);
    float* ss1 = (float*)(ws + WS_SS1); float* ss2 = (float*)(ws + WS_SS2);

    p0_prologue(F, a);
    grid.sync();
    const XcdBarrier bar = xcd_barrier_post((unsigned*)(ws + WS_BAR), bst);
    { pg8::Gemm g{XN, (const bf16*)(ws + WS_WIN), MT, NIN, DM, DM}; pg8::StaticOrder S; S.init(MT, NIN, F.G, (int)blockIdx.x);
      pg8::EpiG1 E{GLU, UV, GG};
      pg8::gemm_phase<pg8::EpiG1, pg8::StaticOrder, true, true>(F.lds, g, S, E); }
    xcd_barrier(bar);
    for (int u = F.vcu; u < 256; u += F.G) {
        mixB_prompt(F, a, UV, u >> 1, u & 1);
        { const int b = u >> 5, t0 = (u & 31) * 64; const bool last = (u & 31) == 31;
          convA_prompt(F, a, (const unsigned*)GLU, ACTA, (size_t)b * SEQ + t0, t0 > 0, last ? out + O_CAP + (size_t)b * 30 * DM : nullptr); }
        if (u < 128) convA_sample(F, a, (const unsigned*)GLU, ACTA, u, a.in[2] + (size_t)u * 30 * DM, out + O_CAS + (size_t)u * 30 * DM);
        else mixB_sample(F, a, UV, u - 128, out + O_VS);
    }
    xcd_barrier(bar);
    { pg8::Gemm g{ACTA, (const bf16*)(ws + WS_WA), MT, DM, DM, DM}; pg8::StaticOrder S; S.init(MT, DM, F.G, (int)blockIdx.x);
      pg8::EpiMerge<0> E{MG, GG};
      pg8::gemm_phase<pg8::EpiMerge<0>, pg8::StaticOrder, true, true>(F.lds, g, S, E); }
    { pg8::Gemm g{UV, (const bf16*)(ws + WS_WB), MT, DM, DM, 2048}; pg8::StaticOrder S; S.init(MT, DM, F.G, (int)blockIdx.x);
      pg8::EpiMerge<1> E{MG, GG};
      pg8::gemm_phase<pg8::EpiMerge<1>, pg8::StaticOrder, true, true>(F.lds, g, S, E); }
    xcd_barrier(bar);
    { pg8::Gemm g{MG, (const bf16*)(ws + WS_WO), MT, DM, DM, DM}; pg8::StaticOrder S; S.init(MT, DM, F.G, (int)blockIdx.x);
      pg8::EpiRes E{a.in[0], a.in[1], MP, out + O_Y, XN, ss1};
      pg8::gemm_phase<pg8::EpiRes, pg8::StaticOrder, true, true>(F.lds, g, S, E); }
    xcd_barrier(bar);
    { pg8::Gemm g{XN, (const bf16*)(ws + WS_WUP), MT, NUP, DM, DM}; pg8::StaticOrder S; S.init(MT, NUP, F.G, (int)blockIdx.x);
      pg8::EpiUp E{AB, ss1, NUP};
      pg8::gemm_phase<pg8::EpiUp, pg8::StaticOrder, true, true>(F.lds, g, S, E); }
    xcd_barrier(bar);
    p6_ffn_act(F, a, out);
    xcd_barrier(bar);
    { pg8::Gemm g{AB + DFF, (const bf16*)(ws + WS_WDN), MT, DM, DFF, NUP}; pg8::StaticOrder S; S.init(MT, DM, F.G, (int)blockIdx.x);
      pg8::EpiRes E{out + O_Y, out + O_Y + (size_t)MP * DM, MP, out + O_Y, nullptr, ss2};
      pg8::gemm_phase<pg8::EpiRes, pg8::StaticOrder, true, true>(F.lds, g, S, E); }
    xcd_barrier(bar);
    { const Frame F8 = phase_frame(F); const float* gf = a.in[22];
      for (int m = F8.vcu * NWAVES + F8.wave; m < MT; m += F.G * NWAVES) {
          f32x4* yr = (f32x4*)(out + O_Y + (size_t)m * DM) + F8.lane; const f32x4* gr = (const f32x4*)gf + F8.lane;
          const float rstd = 1.0f / sqrtf(ss2[m] * (1.f / DM) + EPS);
#pragma unroll
          for (int j = 0; j < 4; ++j) yr[64 * j] = yr[64 * j] * rstd * gr[64 * j]; } }
}

extern "C" void kernel_launch(void* const* d_in, const int* in_sizes, int n_in, void* d_out, int out_size, void* d_ws, size_t ws_size, hipStream_t stream) {
    static int grid = 0;
    if (grid == 0) {
        if (n_in != 23 || (size_t)out_size != O_END || ws_size < WS_END) { fprintf(stderr, "kernel_launch: unexpected shapes: n_in %d out %d ws %zu\n", n_in, out_size, ws_size); grid = -1; return; }
        int dev = 0, cus = 0, per_cu = 0;
        if (hipGetDevice(&dev) != hipSuccess || hipDeviceGetAttribute(&cus, hipDeviceAttributeMultiprocessorCount, dev) != hipSuccess) { grid = -1; return; }
        if (hipFuncSetAttribute((const void*)fwd_mega, hipFuncAttributeMaxDynamicSharedMemorySize, LDS_BYTES) != hipSuccess) { fprintf(stderr, "kernel_launch: hipFuncSetAttribute failed\n"); grid = -1; return; }
        if (hipOccupancyMaxActiveBlocksPerMultiprocessor(&per_cu, (const void*)fwd_mega, NTHR, LDS_BYTES) != hipSuccess || per_cu < 1) { fprintf(stderr, "kernel_launch: occupancy query says %d\n", per_cu); per_cu = 1; }
        (void)hipGetLastError();
        grid = cus * 1;
        fprintf(stderr, "kernel_launch: cus %d per_cu %d grid %d\n", cus, per_cu, grid);
    }
    if (grid < 0) return;
    Args a{};
    for (int i = 0; i < 23; ++i) a.in[i] = (const float*)d_in[i];
    a.out = (float*)d_out; a.ws = (unsigned char*)d_ws;
    void* args[] = {&a};
    hipError_t e = hipLaunchCooperativeKernel((const void*)fwd_mega, dim3(grid), dim3(NTHR), args, LDS_BYTES, stream);
    if (e != hipSuccess) fprintf(stderr, "kernel_launch: cooperative launch failed: %s (grid %d)\n", hipGetErrorString(e), grid);
}
```

```cpp
#include <hip/hip_runtime.h>
#include <hip/hip_cooperative_groups.h>
#include <cstdio>
#include <cstdint>
namespace cg = cooperative_groups;
namespace pg8 {
#define PG8_LAS __attribute__((address_space(3)))
typedef unsigned short bf16_t;
typedef short bf16x8 __attribute__((ext_vector_type(8)));
typedef float f32x4 __attribute__((ext_vector_type(4)));
typedef unsigned u32x4 __attribute__((ext_vector_type(4)));
constexpr int BM = 256, BK = 64, HALF = 128, HTB = HALF * BK * 2  , STAGE_BYTES = 8 * HTB, NXCD = 8, WGM = 8;

__host__ __device__ __forceinline__ int lds_byte(int r, int c) { const int st = (r >> 4) * 2 + (c >> 5), rr = r & 15, cc = c & 31, ob = rr * 64 + cc * 2; return st * 1024 + (ob ^ (((ob >> 9) & 1) << 5)); }
__host__ __device__ __forceinline__ void stage_rc(int b, int& R, int& C) { const int st = b / 1024, sb = b % 1024, swz = sb ^ (((sb >> 9) & 1) << 5); R = (st >> 1) * 16 + swz / 64; C = (st & 1) * 32 + (swz % 64) / 2; }
__host__ __device__ __forceinline__ int perm32(int rho) { const int n = rho >> 4, i = rho & 15; return 8 * (i >> 2) + 4 * n + (i & 3); }

struct Unit { int pm, pn; };
struct Gemm { const bf16_t* A; const bf16_t* Bt; int M, N, K, lda; };

struct StaticOrder {
    int nM, nN, nwg, G, c;
    __host__ __device__ void init(int M, int N, int G_, int c_) { nM = M / BM; nN = N / BM; nwg = nM * nN; G = G_; c = c_; }
    __host__ __device__ bool next(int i, Unit& u) const {
        const long L = (long)i * G + c; if (L >= nwg) return false;
        int wgid = (int)L; { const int q = nwg / NXCD, r = nwg % NXCD, xcd = wgid % NXCD, off = wgid / NXCD; wgid = (xcd < r ? xcd * (q + 1) : r * (q + 1) + (xcd - r) * q) + off; }
        const int nig = WGM * nN, gid = wgid / nig, fm = gid * WGM, gsz = (nM - fm) < WGM ? (nM - fm) : WGM;
        u.pm = fm + ((wgid % nig) % gsz); u.pn = (wgid % nig) / gsz; return true;
    }
    __device__ __forceinline__ void a_ready(const Unit&) const {}
    __device__ __forceinline__ void done(const Unit&) const {}
};

__device__ __forceinline__ unsigned cvt_pk_bf16(float lo, float hi) { unsigned r; asm volatile("v_cvt_pk_bf16_f32 %0, %1, %2" : "=v"(r) : "v"(lo), "v"(hi)); return r; }
typedef float f32x2 __attribute__((ext_vector_type(2)));
__device__ __forceinline__ f32x2 gelu_pk(f32x2 v) {
    const f32x2 av = __builtin_elementwise_abs(v), d = av * 0.2316418882f + 1.0f;
    f32x2 t; t.x = __builtin_amdgcn_rcpf(d.x); t.y = __builtin_amdgcn_rcpf(d.y);
    f32x2 q = t * 0.5307027145f + (-0.7265760135f); q = q * t + 0.7107068705f; q = q * t + (-0.142248368f); q = q * t + 0.127414796f; q = q * t;
    const f32x2 s = (v * v) * (-0.72134752044f);
    f32x2 e; e.x = __builtin_amdgcn_exp2f(s.x); e.y = __builtin_amdgcn_exp2f(s.y);
    const f32x2 m = v * (q * e), r = v - m;
    f32x2 o; o.x = v.x < 0.f ? m.x : r.x; o.y = v.y < 0.f ? m.y : r.y; return o;
}
typedef unsigned u32x2 __attribute__((ext_vector_type(2)));
__device__ __forceinline__ float sigm(float x) { return __builtin_amdgcn_rcpf(1.0f + __builtin_amdgcn_exp2f(x * -1.44269504089f)); }
__device__ __forceinline__ float bf_lo(unsigned u) { return __uint_as_float(u << 16); }
__device__ __forceinline__ float bf_hi(unsigned u) { return __uint_as_float(u & 0xffff0000u); }

struct EpiG1 {
    static constexpr bool PERM = true, AFTER_DRAIN = false;
    bf16_t* GLU; bf16_t* UV; bf16_t* GG;
    __device__ __forceinline__ void operator()(const f32x4 (&acc)[2][2][4][2], const Unit& u, int wr, int wc, int fr, int fq) const {
        const int row0 = u.pm * BM + wr * 64 + fr;
        if (u.pn < 8) {
            const int col = u.pn * 128 + wc * 32 + 8 * fq;
#pragma unroll
            for (int ai = 0; ai < 2; ++ai)
#pragma unroll
                for (int m = 0; m < 4; ++m) {
                    const f32x4 v0 = acc[ai][0][m][0], v1 = acc[ai][0][m][1], g0 = acc[ai][1][m][0], g1 = acc[ai][1][m][1];
                    u32x4 w; w.x = cvt_pk_bf16(v0[0] * sigm(g0[0]), v0[1] * sigm(g0[1])); w.y = cvt_pk_bf16(v0[2] * sigm(g0[2]), v0[3] * sigm(g0[3]));
                    w.z = cvt_pk_bf16(v1[0] * sigm(g1[0]), v1[1] * sigm(g1[1])); w.w = cvt_pk_bf16(v1[2] * sigm(g1[2]), v1[3] * sigm(g1[3]));
                    *(u32x4*)(GLU + (size_t)(row0 + ai * HALF + m * 16) * 1024 + col) = w; }
        } else {
            const bool isg = u.pn < 16;
            bf16_t* base = isg ? UV : GG;
            const int col0 = (isg ? (u.pn - 8) : (u.pn - 16)) * BM + wc * 32 + 8 * fq;
#pragma unroll
            for (int ai = 0; ai < 2; ++ai)
#pragma unroll
                for (int m = 0; m < 4; ++m) { bf16_t* rowp = base + (size_t)(row0 + ai * HALF + m * 16) * 2048 + col0;
#pragma unroll
                    for (int bj = 0; bj < 2; ++bj) { f32x4 v0 = acc[ai][bj][m][0], v1 = acc[ai][bj][m][1];
                        if (isg) { f32x2 a = gelu_pk((f32x2){v0[0], v0[1]}), b = gelu_pk((f32x2){v0[2], v0[3]}), c = gelu_pk((f32x2){v1[0], v1[1]}), d = gelu_pk((f32x2){v1[2], v1[3]});
                            v0 = (f32x4){a.x, a.y, b.x, b.y}; v1 = (f32x4){c.x, c.y, d.x, d.y}; }
                        else { v0 = (f32x4){sigm(v0[0]), sigm(v0[1]), sigm(v0[2]), sigm(v0[3])}; v1 = (f32x4){sigm(v1[0]), sigm(v1[1]), sigm(v1[2]), sigm(v1[3])}; }
                        u32x4 w; w.x = cvt_pk_bf16(v0[0], v0[1]); w.y = cvt_pk_bf16(v0[2], v0[3]); w.z = cvt_pk_bf16(v1[0], v1[1]); w.w = cvt_pk_bf16(v1[2], v1[3]);
                        *(u32x4*)(rowp + bj * HALF) = w; } }
        }
    }
};
template <int MODE> struct EpiMerge {
    static constexpr bool PERM = true, AFTER_DRAIN = false;
    bf16_t* MG; const bf16_t* GG;
    __device__ __forceinline__ void operator()(const f32x4 (&acc)[2][2][4][2], const Unit& u, int wr, int wc, int fr, int fq) const {
        const int row0 = u.pm * BM + wr * 64 + fr, col0 = u.pn * BM + wc * 32 + 8 * fq;
#pragma unroll
        for (int ai = 0; ai < 2; ++ai)
#pragma unroll
            for (int m = 0; m < 4; ++m) { const size_t row = (size_t)(row0 + ai * HALF + m * 16);
#pragma unroll
                for (int bj = 0; bj < 2; ++bj) { const int col = col0 + bj * HALF;
                    const u32x4 g = *(const u32x4*)(GG + row * 2048 + MODE * 1024 + col);
                    f32x4 v0 = acc[ai][bj][m][0], v1 = acc[ai][bj][m][1];
                    v0 = v0 * (f32x4){bf_lo(g.x), bf_hi(g.x), bf_lo(g.y), bf_hi(g.y)}; v1 = v1 * (f32x4){bf_lo(g.z), bf_hi(g.z), bf_lo(g.w), bf_hi(g.w)};
                    if (MODE == 1) { const u32x4 p = *(const u32x4*)(MG + row * 1024 + col);
                        v0 = v0 + (f32x4){bf_lo(p.x), bf_hi(p.x), bf_lo(p.y), bf_hi(p.y)}; v1 = v1 + (f32x4){bf_lo(p.z), bf_hi(p.z), bf_lo(p.w), bf_hi(p.w)}; }
                    u32x4 w; w.x = cvt_pk_bf16(v0[0], v0[1]); w.y = cvt_pk_bf16(v0[2], v0[3]); w.z = cvt_pk_bf16(v1[0], v1[1]); w.w = cvt_pk_bf16(v1[2], v1[3]);
                    *(u32x4*)(MG + row * 1024 + col) = w; }
                asm volatile("" ::: "memory"); }
    }
};
struct EpiRes {
    static constexpr bool PERM = false, AFTER_DRAIN = false;
    const float* R0; const float* R1; int msplit; float* Y; bf16_t* YB; float* ss;
    __device__ __forceinline__ void operator()(const f32x4 (&acc)[2][2][4][2], const Unit& u, int wr, int wc, int fr, int fq) const {
        const int row0 = u.pm * BM + wr * 64 + fr, col0 = u.pn * BM + wc * 32 + 4 * fq;
        const float* rb = (u.pm * BM < msplit) ? R0 : (R1 - (size_t)msplit * 1024);
#pragma unroll
        for (int ai = 0; ai < 2; ++ai)
#pragma unroll
            for (int m = 0; m < 4; ++m) { const size_t row = (size_t)(row0 + ai * HALF + m * 16); float s = 0.f;
#pragma unroll
                for (int bj = 0; bj < 2; ++bj)
#pragma unroll
                    for (int n = 0; n < 2; ++n) { const size_t off = row * 1024 + col0 + bj * HALF + n * 16;
                        const f32x4 h = *(const f32x4*)(rb + off) + acc[ai][bj][m][n];
                        *(f32x4*)(Y + off) = h; s += (h[0] * h[0] + h[1] * h[1]) + (h[2] * h[2] + h[3] * h[3]);
                        if (YB) { u32x2 w; w.x = cvt_pk_bf16(h[0], h[1]); w.y = cvt_pk_bf16(h[2], h[3]); *(u32x2*)(YB + off) = w; } }
                s += __shfl_xor(s, 16); s += __shfl_xor(s, 32);
                if (fq == 0) atomicAdd(ss + row, s);
                asm volatile("" ::: "memory"); }
    }
};
struct EpiUp {
    static constexpr bool PERM = true, AFTER_DRAIN = false;
    bf16_t* AB; const float* ss; int ldc;
    __device__ __forceinline__ void operator()(const f32x4 (&acc)[2][2][4][2], const Unit& u, int wr, int wc, int fr, int fq) const {
        const int row0 = u.pm * BM + wr * 64 + fr, col0 = u.pn * BM + wc * 32 + 8 * fq;
#pragma unroll
        for (int ai = 0; ai < 2; ++ai)
#pragma unroll
            for (int m = 0; m < 4; ++m) { const size_t row = (size_t)(row0 + ai * HALF + m * 16);
                const float rs = __builtin_amdgcn_rsqf(ss[row] * (1.0f / 1024.0f) + 1e-6f);
#pragma unroll
                for (int bj = 0; bj < 2; ++bj) { const f32x4 v0 = acc[ai][bj][m][0] * rs, v1 = acc[ai][bj][m][1] * rs;
                    u32x4 w; w.x = cvt_pk_bf16(v0[0], v0[1]); w.y = cvt_pk_bf16(v0[2], v0[3]); w.z = cvt_pk_bf16(v1[0], v1[1]); w.w = cvt_pk_bf16(v1[2], v1[3]);
                    *(u32x4*)(AB + row * ldc + col0 + bj * HALF) = w; } }
    }
};
template <class Epi, class Sched, bool ALIGN_EPI = false, bool SP2 = false>
__device__ __forceinline__ void gemm_phase(PG8_LAS unsigned char* lds, const Gemm g, const Sched& S, const Epi& E) {
    int tid_ = threadIdx.x; asm volatile("" : "+v"(tid_));
    const int tid = tid_, wid = __builtin_amdgcn_readfirstlane(tid >> 6), lane = tid & 63, wr = wid >> 2, wc = wid & 3, fr = lane & 15, fq = lane >> 4;
    const int K = g.K, nt = K / BK;
    unsigned voffA[2], voffB[2];
#pragma unroll
    for (int i = 0; i < 2; ++i) { int R, C; stage_rc(tid * 16 + i * 8192, R, C); const int Rb = Epi::PERM ? ((R & ~31) + perm32(R & 31)) : R;
        voffA[i] = (unsigned)(R * g.lda + C) * 2u; voffB[i] = (unsigned)(Rb * K + C) * 2u; }
    const size_t kstep = (size_t)(BK * 2);
    const size_t hA = (size_t)HALF * g.lda * 2, hB = (size_t)HALF * K * 2;
    const size_t tA = 2 * hA, tB = 2 * hB;
    const unsigned ldsw = (unsigned)wid * 1024u;
    const int aoff = lds_byte(wr * 64 + fr, fq * 8), boff = lds_byte(wc * 32 + fr, fq * 8);
#define PG8_SA(b, h) (((b) * 2 + (h)) * HTB)
#define PG8_SB(b, h) ((4 + (b) * 2 + (h)) * HTB)
#define PG8_STAGE(bufoff, gbase, voff) do { _Pragma("unroll") for (int _i = 0; _i < 2; ++_i) \
        __builtin_amdgcn_global_load_lds((const unsigned*)((const char*)(gbase) + (voff)[_i]), (PG8_LAS unsigned*)(lds + (bufoff) + ldsw + _i * 8192), 16, 0, 0); } while (0)
#define PG8_LDA(dst, b, h) do { _Pragma("unroll") for (int m = 0; m < 4; ++m) _Pragma("unroll") for (int k = 0; k < 2; ++k) dst[m][k] = *(const PG8_LAS bf16x8*)(lds + PG8_SA(b, h) + aoff + m * 2048 + k * 1024); } while (0)
#define PG8_LDB(dst, b, h) do { _Pragma("unroll") for (int n = 0; n < 2; ++n) _Pragma("unroll") for (int k = 0; k < 2; ++k) dst[n][k] = *(const PG8_LAS bf16x8*)(lds + PG8_SB(b, h) + boff + n * 2048 + k * 1024); } while (0)
#define PG8_MMA(ai, bj, At, Bt) do { __builtin_amdgcn_s_setprio(1); _Pragma("unroll") for (int m = 0; m < 4; ++m) _Pragma("unroll") for (int n = 0; n < 2; ++n) _Pragma("unroll") for (int k = 0; k < 2; ++k) \
        acc[ai][bj][m][n] = __builtin_amdgcn_mfma_f32_16x16x32_bf16(Bt[n][k], At[m][k], acc[ai][bj][m][n], 0, 0, 0); __builtin_amdgcn_s_setprio(0); } while (0)
#define PG8_WAIT_V(n) asm volatile("s_waitcnt vmcnt(" #n ")" ::: "memory")
#define PG8_WAIT_L(n) asm volatile("s_waitcnt lgkmcnt(" #n ")" ::: "memory")
#define PG8_BAR __builtin_amdgcn_s_barrier()
#define PG8_SCHED __builtin_amdgcn_sched_barrier(0)
    Unit cur, nxt; int ui = 0;
    if (!S.next(0, cur)) return;
    f32x4 acc[2][2][4][2];
#pragma unroll
    for (int a = 0; a < 2; ++a)
#pragma unroll
        for (int b = 0; b < 2; ++b)
#pragma unroll
            for (int m = 0; m < 4; ++m)
#pragma unroll
                for (int n = 0; n < 2; ++n) acc[a][b][m][n] = (f32x4){0.f, 0.f, 0.f, 0.f};
    bf16x8 At[4][2], B0[2][2], B1[2][2];
    const char* cA = (const char*)g.A + (size_t)cur.pm * tA; const char* cB = (const char*)g.Bt + (size_t)cur.pn * tB;
    S.a_ready(cur);
    if constexpr (SP2) {
        PG8_STAGE(PG8_SB(0, 0), cB, voffB); PG8_STAGE(PG8_SB(0, 1), cB + hB, voffB); PG8_STAGE(PG8_SA(0, 0), cA, voffA); PG8_STAGE(PG8_SA(0, 1), cA + hA, voffA);
        if (wr == 1) PG8_BAR;
        PG8_WAIT_V(2); PG8_BAR;
        PG8_STAGE(PG8_SB(1, 0), cB + kstep, voffB); PG8_STAGE(PG8_SA(1, 0), cA + kstep, voffA); PG8_STAGE(PG8_SB(1, 1), cB + hB + kstep, voffB);
        PG8_WAIT_V(6); PG8_BAR;
    } else {
        PG8_STAGE(PG8_SB(0, 0), cB, voffB); PG8_STAGE(PG8_SA(0, 0), cA, voffA); PG8_STAGE(PG8_SB(0, 1), cB + hB, voffB); PG8_STAGE(PG8_SA(0, 1), cA + hA, voffA);
        if (wr == 1) PG8_BAR;
        PG8_WAIT_V(4); PG8_BAR;
        PG8_STAGE(PG8_SB(1, 0), cB + kstep, voffB); PG8_STAGE(PG8_SA(1, 0), cA + kstep, voffA); PG8_STAGE(PG8_SB(1, 1), cB + hB + kstep, voffB);
        PG8_WAIT_V(6); PG8_BAR;
    }
    for (;;) {
        const bool has_next = S.next(ui + 1, nxt);
        const char* nA = has_next ? (const char*)g.A + (size_t)nxt.pm * tA : cA; const char* nB = has_next ? (const char*)g.Bt + (size_t)nxt.pn * tB : cB;
        for (int t = 0; t < nt; t += 2) {
            const bool last = (t == nt - 2);
            const char* a1 = cA + (size_t)(t + 1) * kstep;
            const char* a2 = last ? nA : cA + (size_t)(t + 2) * kstep; const char* b2 = last ? nB : cB + (size_t)(t + 2) * kstep;
            const char* a3 = a2 + kstep; const char* b3 = b2 + kstep;
            if (last && has_next) S.a_ready(nxt);
            if constexpr (SP2) {
            PG8_LDB(B0, 0, 0); PG8_LDB(B1, 0, 1); PG8_SCHED; PG8_LDA(At, 0, 0); PG8_STAGE(PG8_SA(1, 1), a1 + hA, voffA);
            PG8_WAIT_V(8); PG8_WAIT_L(0); PG8_BAR; PG8_MMA(0, 0, At, B0); PG8_MMA(0, 1, At, B1); PG8_BAR; PG8_SCHED;
            PG8_LDA(At, 0, 1); PG8_STAGE(PG8_SB(0, 0), b2, voffB); PG8_STAGE(PG8_SB(0, 1), b2 + hB, voffB); PG8_STAGE(PG8_SA(0, 0), a2, voffA);
            PG8_WAIT_V(8); PG8_WAIT_L(0); PG8_BAR; PG8_MMA(1, 0, At, B0); PG8_MMA(1, 1, At, B1); PG8_BAR; PG8_SCHED;
            PG8_LDB(B0, 1, 0); PG8_LDB(B1, 1, 1); PG8_SCHED; PG8_LDA(At, 1, 0); PG8_STAGE(PG8_SA(0, 1), a2 + hA, voffA);
            PG8_WAIT_V(8); PG8_WAIT_L(0); PG8_BAR; PG8_MMA(0, 0, At, B0); PG8_MMA(0, 1, At, B1); PG8_BAR; PG8_SCHED;
            PG8_LDA(At, 1, 1); PG8_STAGE(PG8_SB(1, 0), b3, voffB); PG8_STAGE(PG8_SB(1, 1), b3 + hB, voffB); PG8_STAGE(PG8_SA(1, 0), a3, voffA);
            PG8_WAIT_V(8); PG8_WAIT_L(0); PG8_BAR; PG8_MMA(1, 0, At, B0); PG8_MMA(1, 1, At, B1); PG8_BAR; PG8_SCHED;
            } else {
            PG8_LDB(B0, 0, 0); PG8_SCHED; PG8_LDA(At, 0, 0); PG8_STAGE(PG8_SA(1, 1), a1 + hA, voffA);
            PG8_WAIT_L(8); PG8_BAR; PG8_WAIT_L(0); PG8_MMA(0, 0, At, B0); PG8_BAR; PG8_SCHED;
            PG8_LDB(B1, 0, 1); PG8_STAGE(PG8_SB(0, 0), b2, voffB);
            PG8_BAR; PG8_WAIT_L(0); PG8_MMA(0, 1, At, B1); PG8_BAR;
            PG8_LDA(At, 0, 1); PG8_STAGE(PG8_SA(0, 0), a2, voffA);
            PG8_BAR; PG8_WAIT_L(0); PG8_MMA(1, 0, At, B0); PG8_BAR; PG8_SCHED;
            PG8_STAGE(PG8_SB(0, 1), b2 + hB, voffB);
            PG8_WAIT_V(6); PG8_BAR; PG8_MMA(1, 1, At, B1); PG8_BAR;
            PG8_LDB(B0, 1, 0); PG8_SCHED; PG8_LDA(At, 1, 0); PG8_STAGE(PG8_SA(0, 1), a2 + hA, voffA);
            PG8_WAIT_L(8); PG8_BAR; PG8_WAIT_L(0); PG8_MMA(0, 0, At, B0); PG8_BAR; PG8_SCHED;
            PG8_LDB(B1, 1, 1); PG8_STAGE(PG8_SB(1, 0), b3, voffB);
            PG8_BAR; PG8_WAIT_L(0); PG8_MMA(0, 1, At, B1); PG8_BAR;
            PG8_LDA(At, 1, 1); PG8_STAGE(PG8_SA(1, 0), a3, voffA);
            PG8_BAR; PG8_WAIT_L(0); PG8_MMA(1, 0, At, B0); PG8_BAR; PG8_SCHED;
            PG8_STAGE(PG8_SB(1, 1), b3 + hB, voffB);
            PG8_WAIT_V(6); PG8_BAR; PG8_MMA(1, 1, At, B1); PG8_BAR;
            }
        }
        if constexpr (ALIGN_EPI) { if (wr == 0) PG8_BAR; }
        if constexpr (!Epi::AFTER_DRAIN) { E(acc, cur, wr, wc, fr, fq); S.done(cur); }
        if (!has_next) break;
#pragma unroll
        for (int a = 0; a < 2; ++a)
#pragma unroll
            for (int b = 0; b < 2; ++b)
#pragma unroll
                for (int m = 0; m < 4; ++m)
#pragma unroll
                    for (int n = 0; n < 2; ++n) acc[a][b][m][n] = (f32x4){0.f, 0.f, 0.f, 0.f};
        cur = nxt; cA = nA; cB = nB; ++ui;
        if constexpr (ALIGN_EPI) { if (wr == 1) PG8_BAR; }
    }
    PG8_WAIT_V(0);
    if constexpr (!ALIGN_EPI) { if (wr == 0) PG8_BAR; }
    PG8_BAR;
    if constexpr (Epi::AFTER_DRAIN) { E.fused(acc, cur, wr, wc, fr, fq, lds, wid, lane); S.done(cur); }
#undef PG8_SA
#undef PG8_SB
#undef PG8_STAGE
#undef PG8_LDA
#undef PG8_LDB
#undef PG8_MMA
#undef PG8_WAIT_V
#undef PG8_WAIT_L
#undef PG8_BAR
#undef PG8_SCHED
}
}

constexpr int DM = 1024, NBP = 8, SEQ = 2048, NBS = 128, TS = 4, MP = NBP * SEQ, MS = NBS * TS, MT = MP + MS;
constexpr int NIN = 6144, DFF = 2816, NUP = 2 * DFF, CAW = 31, HB = 8;
constexpr float EPS = 1e-6f;
constexpr int NWAVES = 8, NTHR = 512;
constexpr size_t O_Y = 0, O_CAP = (size_t)MT * DM, O_CAS = O_CAP + (size_t)NBP * 30 * DM, O_VS = O_CAS + (size_t)NBS * 30 * DM, O_FP = O_VS + (size_t)MS * DM, O_FS = O_FP + (size_t)NBP * 2 * DFF, O_END = O_FS + (size_t)NBS * 2 * DFF;
constexpr size_t MiB = 1u << 20;
constexpr size_t WS_SS1 = 0, WS_SS2 = 128 * 1024, WS_BAR = 512 * 1024;
constexpr size_t WS_WUP = 1 * MiB, WS_WDN = 12 * MiB, WS_WIN = 18 * MiB, WS_WA = 30 * MiB, WS_WB = 32 * MiB, WS_WO = 34 * MiB;
constexpr size_t WS_XN = 36 * MiB;
constexpr size_t WS_GLU = 69 * MiB, WS_UV = 102 * MiB, WS_GG = 168 * MiB;
constexpr size_t WS_MG = WS_GLU;
constexpr size_t WS_AB = WS_GLU;
constexpr size_t WS_END = WS_AB + (size_t)MT * NUP * 2;
static_assert(WS_END <= 256 * MiB && WS_GG + (size_t)MT * 2048 * 2 <= 256 * MiB, "d_ws map");
constexpr int LDS_BYTES = 147456;

#define LAS __attribute__((address_space(3)))
typedef unsigned short bf16;
typedef unsigned v4u __attribute__((ext_vector_type(4)));
typedef unsigned v2u __attribute__((ext_vector_type(2)));
typedef float f32x4 __attribute__((ext_vector_type(4)));
typedef float f32x2 __attribute__((ext_vector_type(2)));
typedef short bf16x8 __attribute__((ext_vector_type(8)));
#define LDS_WAIT() asm volatile("s_waitcnt lgkmcnt(0)" ::: "memory")
__device__ __forceinline__ unsigned f2bf(float f) { unsigned u = __builtin_bit_cast(unsigned, f); return (u + 0x7fffu + ((u >> 16) & 1u)) >> 16; }
__device__ __forceinline__ unsigned pk2(float lo, float hi) { return f2bf(lo) | (f2bf(hi) << 16); }
__device__ __forceinline__ float blo(unsigned u) { return __uint_as_float(u << 16); }
__device__ __forceinline__ float bhi(unsigned u) { return __uint_as_float(u & 0xffff0000u); }
__device__ __forceinline__ float sigmf(float x) { return __builtin_amdgcn_rcpf(1.0f + __builtin_amdgcn_exp2f(x * -1.44269504089f)); }
__device__ __forceinline__ float wave_sum(float v) {
#pragma unroll
    for (int o = 1; o < 64; o <<= 1) v += __shfl_xor(v, o);
    return v;
}

struct Args { const float* in[23]; float* out; unsigned char* ws; };
struct Frame { LAS unsigned char* lds; int tid, lane, wave, vcu, G; };
__device__ __forceinline__ Frame phase_frame(const Frame& F0) { Frame F = F0; int t = F0.tid; asm volatile("" : "+v"(t)); F.tid = t; F.lane = t & 63; return F; }

#define XB_TMO      128
#define XB_XCNT(j)  (256  + 64 * (j))
#define XB_XSUB(j)  (1280 + 64 * (j))
#define XB_XGEN(j)  (2304 + 64 * (j))
#define XB_TOP      3328
#define XB_TOPGEN   3392
#define XCD_BAR_WORDS 3456
#define XB_SPIN_CAP (1u << 18)

__device__ __forceinline__ unsigned xb_ld(unsigned* p)              { return __hip_atomic_load(p, __ATOMIC_RELAXED, __HIP_MEMORY_SCOPE_AGENT); }
__device__ __forceinline__ unsigned xb_add(unsigned* p, unsigned v) { return __hip_atomic_fetch_add(p, v, __ATOMIC_RELAXED, __HIP_MEMORY_SCOPE_AGENT); }
__device__ __forceinline__ unsigned xb_xcc_id() { return (unsigned)__builtin_amdgcn_s_getreg((3 << 11) | 20) & 0xFu; }
#define XB_SPIN(cond, bar) do { unsigned _sp = 0; while (cond) { __builtin_amdgcn_s_sleep(1); \
    if ((++_sp & 255u) == 0u) { if (xb_ld(&(bar)[XB_TMO])) break; if (_sp > XB_SPIN_CAP) { atomicAdd(&(bar)[XB_TMO], 1u); break; } } } } while (0)

struct XcdBarrier {
    unsigned* bar; unsigned x;
    volatile LAS unsigned* st;
};

__device__ __forceinline__ XcdBarrier xcd_barrier_post(unsigned* bar, volatile LAS unsigned* st) {
    XcdBarrier b; b.bar = bar; b.x = xb_xcc_id(); b.st = st;
    if (threadIdx.x == 0) (void)xb_add(&bar[XB_XCNT(b.x)], 1u);
    return b;
}
__device__ __forceinline__ void xcd_barrier_complete(unsigned* bar, unsigned x, unsigned& nloc, unsigned& nx) {
    const unsigned G = gridDim.x * gridDim.y * gridDim.z;
    unsigned sum, cnt, mine, sp = 0u;
    for (;;) {
        sum = 0u; cnt = 0u; mine = 0u;
#pragma unroll
        for (unsigned j = 0; j < 16; ++j) { const unsigned c = xb_ld(&bar[XB_XCNT(j)]); sum += c; cnt += (c > 0u) ? 1u : 0u; mine = (j == x) ? c : mine; }
        if (sum == G) break;
        __builtin_amdgcn_s_sleep(1);
        if ((++sp & 255u) == 0u) { if (xb_ld(&bar[XB_TMO])) break; if (sp > XB_SPIN_CAP) { atomicAdd(&bar[XB_TMO], 1u); break; } }
    }
    nloc = mine > 0u ? mine : 1u; nx = cnt > 0u ? cnt : 1u;
}

__device__ __forceinline__ void xcd_barrier(const XcdBarrier& b) {
    asm volatile("s_waitcnt vmcnt(0)" ::: "memory");
    __syncthreads();
    if (threadIdx.x == 0) {
        unsigned* bar = b.bar;
        __builtin_amdgcn_s_waitcnt(0);
        unsigned nloc = b.st[0], nx = b.st[1];
        if (nloc == 0u) { xcd_barrier_complete(bar, b.x, nloc, nx); b.st[0] = nloc; b.st[1] = nx; }
        const unsigned old = xb_add(&bar[XB_XSUB(b.x)], 1u);
        const unsigned gen = old / nloc;
        if (old + 1u == (gen + 1u) * nloc) {
            __builtin_amdgcn_fence(__ATOMIC_RELEASE, "agent");
            asm volatile("s_waitcnt vmcnt(0)" ::: "memory");
            const unsigned og = xb_add(&bar[XB_TOP], 1u);
            const unsigned tg = og / nx;
            if (og + 1u == (tg + 1u) * nx) xb_add(&bar[XB_TOPGEN], 1u);
            else XB_SPIN(xb_ld(&bar[XB_TOPGEN]) == tg, bar);
            __builtin_amdgcn_fence(__ATOMIC_ACQUIRE, "agent");
            xb_add(&bar[XB_XGEN(b.x)], 1u);
            asm volatile("s_waitcnt vmcnt(0)" ::: "memory");
        } else {
            XB_SPIN(xb_ld(&bar[XB_XGEN(b.x)]) == gen, bar);
            __builtin_amdgcn_fence(__ATOMIC_ACQUIRE, "agent");
            asm volatile("s_waitcnt vmcnt(0)" ::: "memory");
        }
    }
    __syncthreads();
}

__device__ __forceinline__ void p0_transpose_item(const float* W, int K, int N, bf16* WT, int mode, const float* kscale, LAS float* scr, int item, int lane) {
    const int nblk = N / 32, kb = item / nblk, nb = item % nblk, k0 = 64 * kb, n0 = 32 * nb;
#pragma unroll 8
    for (int i = 0; i < 32; ++i) { const int kk = 2 * i + (lane >> 5); float v = W[(size_t)(k0 + kk) * N + n0 + (lane & 31)]; if (kscale) v *= kscale[k0 + kk]; scr[kk * 33 + (lane & 31)] = v; }
    LDS_WAIT(); asm volatile("" ::: "memory");
    int n0m = n0;
    if (mode == 1 && n0 < 2048) { const int half = n0 >= 1024 ? 1 : 0, ch = n0 - 1024 * half; n0m = 256 * (ch >> 7) + 128 * half + (ch & 127); }
    const int c = lane & 7;
#pragma unroll
    for (int j = 0; j < 4; ++j) { const int n = (lane >> 3) + 8 * j; const LAS float* s = scr + (8 * c) * 33 + n;
        v4u o; o.x = pk2(s[0 * 33], s[1 * 33]); o.y = pk2(s[2 * 33], s[3 * 33]); o.z = pk2(s[4 * 33], s[5 * 33]); o.w = pk2(s[6 * 33], s[7 * 33]);
        *(v4u*)(WT + (size_t)(n0m + n) * K + k0 + 8 * c) = o; }
    LDS_WAIT(); asm volatile("" ::: "memory");
}
__device__ __forceinline__ void rms_row_to_bf16(const float* xrow, const float* g, bf16* orow, int lane) {
    const f32x4* xr = (const f32x4*)xrow + lane; const f32x4* gr = (const f32x4*)g + lane;
    f32x4 v[4]; float s = 0.f;
#pragma unroll
    for (int j = 0; j < 4; ++j) { v[j] = xr[64 * j]; s += (v[j].x * v[j].x + v[j].y * v[j].y) + (v[j].z * v[j].z + v[j].w * v[j].w); }
    const float rstd = 1.0f / sqrtf(wave_sum(s) * (1.f / DM) + EPS);
    unsigned long long* o8 = (unsigned long long*)orow + lane;
#pragma unroll
    for (int j = 0; j < 4; ++j) { const f32x4 gg = gr[64 * j]; o8[64 * j] = (unsigned long long)pk2(v[j].x * rstd * gg.x, v[j].y * rstd * gg.y) | ((unsigned long long)pk2(v[j].z * rstd * gg.z, v[j].w * rstd * gg.w) << 32); }
}
__device__ __forceinline__ void p0_prologue(const Frame& F0, const Args& a) {
    const Frame F = phase_frame(F0);
    unsigned char* ws = a.ws;
    LAS float* scr = (LAS float*)(F.lds + F.wave * 16384);
    const int gw = F.vcu * NWAVES + F.wave, NGW = F.G * NWAVES;
    constexpr int I_IN = (DM / 64) * (NIN / 32), I_SQ = (DM / 64) * (DM / 32), I_UP = (DM / 64) * (NUP / 32), I_DN = (DFF / 64) * (DM / 32);
    constexpr int NITEMS = I_IN + 3 * I_SQ + I_UP + I_DN;
    for (int it = gw; it < NITEMS; it += NGW) {
        int r = it;
        if (r < I_IN) { p0_transpose_item(a.in[5], DM, NIN, (bf16*)(ws + WS_WIN), 1, nullptr, scr, r, F.lane); continue; } r -= I_IN;
        if (r < I_SQ) { p0_transpose_item(a.in[10], DM, DM, (bf16*)(ws + WS_WA), 0, nullptr, scr, r, F.lane); continue; } r -= I_SQ;
        if (r < I_SQ) { p0_transpose_item(a.in[15], DM, DM, (bf16*)(ws + WS_WB), 0, nullptr, scr, r, F.lane); continue; } r -= I_SQ;
        if (r < I_SQ) { p0_transpose_item(a.in[16], DM, DM, (bf16*)(ws + WS_WO), 0, nullptr, scr, r, F.lane); continue; } r -= I_SQ;
        if (r < I_UP) { p0_transpose_item(a.in[18], DM, NUP, (bf16*)(ws + WS_WUP), 0, a.in[17], scr, r, F.lane); continue; } r -= I_UP;
        p0_transpose_item(a.in[21], DFF, DM, (bf16*)(ws + WS_WDN), 0, nullptr, scr, r, F.lane);
    }
    bf16* XN = (bf16*)(ws + WS_XN);
    for (int m = gw; m < MT; m += NGW) {
        const float* xr = m < MP ? a.in[0] + (size_t)m * DM : a.in[1] + (size_t)(m - MP) * DM;
        rms_row_to_bf16(xr, a.in[4], XN + (size_t)m * DM, F.lane);
    }
    float* ss = (float*)(ws + WS_SS1);
    for (int i = F.vcu * NTHR + F.tid; i < (int)(2 * WS_SS2 / 4); i += F.G * NTHR) ss[i] = 0.f;
    if (blockIdx.x == 0) { unsigned* bw = (unsigned*)(ws + WS_BAR); for (int i = F.tid; i < XCD_BAR_WORDS; i += NTHR) bw[i] = 0u; }
}

__device__ __forceinline__ void ln_silu_row(const LAS float* src, bf16* dst, const float* g, const float* bt, int lane) {
    f32x4 v[4]; float s = 0.f;
#pragma unroll
    for (int j = 0; j < 4; ++j) { v[j] = *(const LAS f32x4*)(src + 4 * lane + 256 * j); s += (v[j].x + v[j].y) + (v[j].z + v[j].w); }
    const float mean = wave_sum(s) * (1.f / DM); float s2 = 0.f;
#pragma unroll
    for (int j = 0; j < 4; ++j) { v[j] = v[j] - mean; s2 += (v[j].x * v[j].x + v[j].y * v[j].y) + (v[j].z * v[j].z + v[j].w * v[j].w); }
    const float rstd = 1.0f / sqrtf(wave_sum(s2) * (1.f / DM) + EPS);
#pragma unroll
    for (int j = 0; j < 4; ++j) { const f32x4 gg = *(const f32x4*)(g + 4 * lane + 256 * j), bb = *(const f32x4*)(bt + 4 * lane + 256 * j);
        f32x4 y = v[j] * rstd * gg + bb; y = (f32x4){y.x * sigmf(y.x), y.y * sigmf(y.y), y.z * sigmf(y.z), y.w * sigmf(y.w)};
        v2u w; w.x = pk2(y.x, y.y); w.y = pk2(y.z, y.w); *(v2u*)(dst + 4 * lane + 256 * j) = w; }
}
__device__ __forceinline__ void convA_prompt(const Frame& F0, const Args& a, const unsigned* G32, bf16* ACTA, size_t grow0, bool has_hist, float* capout) {
    const Frame F = phase_frame(F0);
    const int c0 = 2 * F.tid;
    LAS float* CB = (LAS float*)F.lds;
    const float* dw = a.in[6];
    f32x2 w[CAW];
#pragma unroll
    for (int k = 0; k < CAW; ++k) w[k] = *(const f32x2*)(dw + k * DM + c0);
    const f32x2 bias = *(const f32x2*)(a.in[7] + c0);
    f32x2 ring[32];
#pragma unroll
    for (int j = 0; j < 32; ++j) ring[j] = (f32x2){0.f, 0.f};
    if (has_hist) {
        const unsigned* hp = G32 + (grow0 - 30) * 512 + F.tid;
#pragma unroll
        for (int j = 0; j < 30; ++j) { const unsigned u = hp[(size_t)j * 512]; ring[2 + j] = (f32x2){blo(u), bhi(u)}; }
    }
    for (int base = 0; base < 64; base += 32) {
        const unsigned* gp = G32 + (grow0 + base) * 512 + F.tid;
#pragma unroll
        for (int jg = 0; jg < 32; jg += 8) {
            unsigned tmp[8];
#pragma unroll
            for (int jj = 0; jj < 8; ++jj) tmp[jj] = gp[(size_t)(jg + jj) * 512];
#pragma unroll
            for (int jj = 0; jj < 8; ++jj) {
                const int j = jg + jj;
                const f32x2 nv = (f32x2){blo(tmp[jj]), bhi(tmp[jj])};
                ring[j] = nv;
                f32x2 o = bias;
#pragma unroll
                for (int k = 0; k < CAW; ++k) o += ring[(j + k + 2) & 31] * w[k];
                *(LAS f32x2*)(CB + j * DM + c0) = o;
            }
            __builtin_amdgcn_sched_barrier(0);
        }
        if (capout && base == 32) {
#pragma unroll
            for (int j = 2; j < 32; ++j) *(f32x2*)(capout + (size_t)(j - 2) * DM + c0) = ring[j];
        }
        __syncthreads();
#pragma unroll 1
        for (int r = F.wave; r < 32; r += NWAVES) ln_silu_row(CB + r * DM, ACTA + (grow0 + base + r) * DM, a.in[8], a.in[9], F.lane);
        __syncthreads();
    }
}
__device__ __forceinline__ void convA_sample(const Frame& F0, const Args& a, const unsigned* G32, bf16* ACTA, int s, const float* hst, float* casout) {
    const Frame F = phase_frame(F0);
    const int c0 = 2 * F.tid;
    LAS float* CB = (LAS float*)F.lds;
    const float* dw = a.in[6];
    f32x2 w[CAW];
#pragma unroll
    for (int k = 0; k < CAW; ++k) w[k] = *(const f32x2*)(dw + k * DM + c0);
    const f32x2 bias = *(const f32x2*)(a.in[7] + c0);
    f32x2 o[4] = {bias, bias, bias, bias};
    const size_t grow0 = (size_t)MP + 4 * s;
#pragma unroll
    for (int i = 0; i < 34; ++i) {
        f32x2 x;
        if (i < 30) x = *(const f32x2*)(hst + i * DM + c0);
        else { const unsigned u = G32[(grow0 + (i - 30)) * 512 + F.tid]; x = (f32x2){blo(u), bhi(u)}; }
        if (i >= 4) *(f32x2*)(casout + (i - 4) * DM + c0) = x;
#pragma unroll
        for (int t = 0; t < 4; ++t) { const int k = i - t; if (k >= 0 && k < CAW) o[t] += x * w[k]; }
    }
#pragma unroll
    for (int t = 0; t < 4; ++t) *(LAS f32x2*)(CB + t * DM + c0) = o[t];
    __syncthreads();
    if (F.wave < 4) ln_silu_row(CB + F.wave * DM, ACTA + (grow0 + F.wave) * DM, a.in[8], a.in[9], F.lane);
    __syncthreads();
}

__device__ __forceinline__ void ln_stats16(const bf16* vrow, int lane, float (&x)[16], float& mean, float& rstd) {
    const v4u p = *(const v4u*)(vrow + 8 * lane), q = *(const v4u*)(vrow + 512 + 8 * lane);
    x[0] = blo(p.x); x[1] = bhi(p.x); x[2] = blo(p.y); x[3] = bhi(p.y); x[4] = blo(p.z); x[5] = bhi(p.z); x[6] = blo(p.w); x[7] = bhi(p.w);
    x[8] = blo(q.x); x[9] = bhi(q.x); x[10] = blo(q.y); x[11] = bhi(q.y); x[12] = blo(q.z); x[13] = bhi(q.z); x[14] = blo(q.w); x[15] = bhi(q.w);
    float s = 0.f;
#pragma unroll
    for (int i = 0; i < 16; ++i) s += x[i];
    mean = wave_sum(s) * (1.f / DM); float s2 = 0.f;
#pragma unroll
    for (int i = 0; i < 16; ++i) { const float d = x[i] - mean; s2 += d * d; }
    rstd = 1.0f / sqrtf(wave_sum(s2) * (1.f / DM) + EPS);
}
constexpr int VT_LD = 130, WT_LD = 136;
constexpr int MB_STAT = 0, MB_VT = 1024, MB_WT = MB_VT + 128 * VT_LD * 2 + 64;
static_assert(MB_WT % 16 == 0 && MB_WT + 128 * WT_LD * 2 <= 131072, "mixer-B LDS map");
__device__ __forceinline__ void mixB_prompt(const Frame& F0, const Args& a, bf16* UV, int ch, int hh) {
    const Frame F = phase_frame(F0);
    const size_t R0 = (size_t)ch * 128;
    LAS f32x2* STAT = (LAS f32x2*)(F.lds + MB_STAT);
    LAS unsigned char* VT = F.lds + MB_VT; LAS unsigned char* WT = F.lds + MB_WT;
    const float* lng = a.in[11]; const float* lnb = a.in[12]; const float* w_s = a.in[13]; const float* b_s = a.in[14];
    for (int i = 0; i < 16; ++i) { const int r = F.wave * 16 + i; float x[16], mean, rstd; ln_stats16(UV + (R0 + r) * 2048 + 1024, F.lane, x, mean, rstd); if (F.lane == 0) STAT[r] = (f32x2){mean, rstd}; }
    __syncthreads();
    const int lr = F.lane & 15, lq = F.lane >> 4;
    for (int hq = 0; hq < 4; ++hq) {
        const int h = hh * 4 + hq;
#pragma unroll
        for (int i = 0; i < 4; ++i) { const int idx = F.tid + NTHR * i, r = idx >> 4, cgp = idx & 15, c = h * 128 + cgp * 8;
            const v4u p = *(const v4u*)(UV + (R0 + r) * 2048 + 1024 + c); const f32x2 st = STAT[r];
            const f32x4 g0 = *(const f32x4*)(lng + c), g1 = *(const f32x4*)(lng + c + 4), b0 = *(const f32x4*)(lnb + c), b1 = *(const f32x4*)(lnb + c + 4);
            LAS unsigned* dst = (LAS unsigned*)(VT + (r * VT_LD + cgp * 8) * 2);
            dst[0] = pk2((blo(p.x) - st.x) * st.y * g0.x + b0.x, (bhi(p.x) - st.x) * st.y * g0.y + b0.y);
            dst[1] = pk2((blo(p.y) - st.x) * st.y * g0.z + b0.z, (bhi(p.y) - st.x) * st.y * g0.w + b0.w);
            dst[2] = pk2((blo(p.z) - st.x) * st.y * g1.x + b1.x, (bhi(p.z) - st.x) * st.y * g1.y + b1.y);
            dst[3] = pk2((blo(p.w) - st.x) * st.y * g1.z + b1.z, (bhi(p.w) - st.x) * st.y * g1.w + b1.w); }
#pragma unroll
        for (int i = 0; i < 8; ++i) { const int idx = F.tid + NTHR * i, t = idx >> 5, sg = idx & 31;
            const f32x4 wv = *(const f32x4*)(w_s + ((size_t)h * 128 + t) * 128 + sg * 4); const int s0 = sg * 4;
            v2u o; o.x = pk2(s0 <= t ? wv.x : 0.f, s0 + 1 <= t ? wv.y : 0.f); o.y = pk2(s0 + 2 <= t ? wv.z : 0.f, s0 + 3 <= t ? wv.w : 0.f);
            *(LAS v2u*)(WT + (t * WT_LD + s0) * 2) = o; }
        __syncthreads();
        bf16x8 af[4];
#pragma unroll
        for (int ks = 0; ks < 4; ++ks) {
#pragma unroll
            for (int kk = 0; kk < 8; ++kk) af[ks][kk] = (short)*(const LAS unsigned short*)(VT + ((32 * ks + 8 * lq + kk) * VT_LD + 16 * F.wave + lr) * 2);
        }
#pragma unroll
        for (int tb = 0; tb < 8; ++tb) {
            f32x4 acc = (f32x4){0.f, 0.f, 0.f, 0.f};
#pragma unroll
            for (int ks = 0; ks < 4; ++ks) {
                if (32 * ks <= 16 * tb + 15) {
                    const bf16x8 bfr = *(const LAS bf16x8*)(WT + ((16 * tb + lr) * WT_LD + 32 * ks + 8 * lq) * 2);
                    acc = __builtin_amdgcn_mfma_f32_16x16x32_bf16(af[ks], bfr, acc, 0, 0, 0);
                }
            }
            const int t = 16 * tb + lr, c = h * 128 + 16 * F.wave + 4 * lq;
            bf16* up = UV + (R0 + t) * 2048 + c;
            const v2u uu = *(const v2u*)up; const float bsv = b_s[h * 128 + t];
            v2u o; o.x = pk2(blo(uu.x) * (acc[0] + bsv), bhi(uu.x) * (acc[1] + bsv)); o.y = pk2(blo(uu.y) * (acc[2] + bsv), bhi(uu.y) * (acc[3] + bsv));
            *(v2u*)up = o;
        }
        __syncthreads();
    }
}
__device__ __forceinline__ void mixB_sample(const Frame& F0, const Args& a, bf16* UV, int s, float* out_vs) {
    const Frame F = phase_frame(F0);
    LAS float* SV = (LAS float*)F.lds;
    const float* lng = a.in[11]; const float* lnb = a.in[12]; const float* w_s = a.in[13]; const float* b_s = a.in[14];
    const size_t R0 = (size_t)MP + 4 * s;
    if (F.wave < 4) {
        const int t = F.wave; float x[16], mean, rstd; ln_stats16(UV + (R0 + t) * 2048 + 1024, F.lane, x, mean, rstd);
#pragma unroll
        for (int hf = 0; hf < 2; ++hf) { const int c = 512 * hf + 8 * F.lane;
#pragma unroll
            for (int q = 0; q < 2; ++q) { const f32x4 g = *(const f32x4*)(lng + c + 4 * q), b = *(const f32x4*)(lnb + c + 4 * q);
                const f32x4 xv = (f32x4){x[8 * hf + 4 * q], x[8 * hf + 4 * q + 1], x[8 * hf + 4 * q + 2], x[8 * hf + 4 * q + 3]};
                const f32x4 y = (xv - mean) * rstd * g + b;
                *(f32x4*)(out_vs + ((size_t)4 * s + t) * DM + c + 4 * q) = y; *(LAS f32x4*)(SV + t * DM + c + 4 * q) = y; } }
    }
    __syncthreads();
    const int c0 = 2 * F.tid, h = c0 >> 7;
#pragma unroll
    for (int t = 0; t < 4; ++t) {
        const float bsv = b_s[h * 128 + t]; float s0 = bsv, s1 = bsv;
#pragma unroll
        for (int sp = 0; sp <= t; ++sp) { const float wv = w_s[((size_t)h * 128 + t) * 128 + sp]; const f32x2 vv = *(const LAS f32x2*)(SV + sp * DM + c0); s0 += wv * vv.x; s1 += wv * vv.y; }
        unsigned* up = (unsigned*)(UV + (R0 + t) * 2048 + c0); const unsigned uu = *up;
        *up = pk2(blo(uu) * s0, bhi(uu) * s1);
    }
    __syncthreads();
}

__device__ __forceinline__ void unpack8(const v4u p, float (&x)[8]) { x[0] = blo(p.x); x[1] = bhi(p.x); x[2] = blo(p.y); x[3] = bhi(p.y); x[4] = blo(p.z); x[5] = bhi(p.z); x[6] = blo(p.w); x[7] = bhi(p.w); }
__device__ __forceinline__ void ld8f(const float* p, float (&x)[8]) { const f32x4 a = *(const f32x4*)p, b = *(const f32x4*)(p + 4); x[0] = a.x; x[1] = a.y; x[2] = a.z; x[3] = a.w; x[4] = b.x; x[5] = b.y; x[6] = b.z; x[7] = b.w; }
__device__ __forceinline__ void st8f(float* p, const float (&x)[8]) { *(f32x4*)p = (f32x4){x[0], x[1], x[2], x[3]}; *(f32x4*)(p + 4) = (f32x4){x[4], x[5], x[6], x[7]}; }
__device__ __forceinline__ void p6_ffn_act(const Frame& F0, const Args& a, float* out) {
    const Frame F = phase_frame(F0);
    bf16* AB = (bf16*)(a.ws + WS_AB);
    constexpr int NG = DFF / 8, RUN = 16, NPI = (MP / RUN) * NG, NSI = NBS * NG;
    const float* dwf = a.in[19]; const float* bdw = a.in[20]; const float* stf = a.in[3];
    for (int it = F.vcu * NTHR + F.tid; it < NPI + NSI; it += F.G * NTHR) {
        float a2[8], a1[8]; size_t row0; int nrows, c; float* fo = nullptr; int fofrom = 0;
        if (it < NPI) { const int run = it / NG, cgp = it - run * NG; c = cgp * 8; row0 = (size_t)run * RUN; nrows = RUN; const int t0 = (int)(row0 & (SEQ - 1));
            if (t0 > 0) { unpack8(*(const v4u*)(AB + (row0 - 2) * NUP + c), a2); unpack8(*(const v4u*)(AB + (row0 - 1) * NUP + c), a1); }
            else {
#pragma unroll
                for (int j = 0; j < 8; ++j) { a2[j] = 0.f; a1[j] = 0.f; } }
            if (t0 == SEQ - RUN) { fo = out + O_FP + (size_t)(row0 >> 11) * 2 * DFF + c; fofrom = RUN - 2; }
        } else { const int i2 = it - NPI, s = i2 / NG, cgp = i2 - s * NG; c = cgp * 8; row0 = (size_t)MP + 4 * s; nrows = 4;
            ld8f(stf + ((size_t)s * 2 + 0) * DFF + c, a2); ld8f(stf + ((size_t)s * 2 + 1) * DFF + c, a1);
            fo = out + O_FS + (size_t)s * 2 * DFF + c; fofrom = 2; }
        float w0[8], w1[8], w2[8], bs[8]; ld8f(dwf + c, w0); ld8f(dwf + DFF + c, w1); ld8f(dwf + 2 * DFF + c, w2); ld8f(bdw + c, bs);
        for (int i = 0; i < nrows; ++i) {
            bf16* ap = AB + (row0 + i) * NUP + c; float a0[8], bb[8]; unpack8(*(const v4u*)ap, a0); unpack8(*(const v4u*)(ap + DFF), bb);
            float o[8];
#pragma unroll
            for (int j = 0; j < 8; j += 2) { f32x2 cv = (f32x2){a2[j] * w0[j] + a1[j] * w1[j] + a0[j] * w2[j] + bs[j], a2[j + 1] * w0[j + 1] + a1[j + 1] * w1[j + 1] + a0[j + 1] * w2[j + 1] + bs[j + 1]};
                cv = pg8::gelu_pk(cv); o[j] = cv.x * bb[j]; o[j + 1] = cv.y * bb[j + 1]; }
            v4u w; w.x = pk2(o[0], o[1]); w.y = pk2(o[2], o[3]); w.z = pk2(o[4], o[5]); w.w = pk2(o[6], o[7]);
            *(v4u*)(ap + DFF) = w;
            if (fo && i >= fofrom) st8f(fo + (size_t)(i - fofrom) * DFF, a0);
#pragma unroll
            for (int j = 0; j < 8; ++j) { a2[j] = a1[j]; a1[j] = a0[j]; }
        }
    }
}


struct SmallSrc { const bf16* A; int lda; const bf16* Bt; };
template <int NSRC, class Epi>
__device__ __forceinline__ void small_gemm(const Frame& F0, const SmallSrc (&src)[NSRC], int K, int N, const Epi& E) {
    const Frame F = phase_frame(F0);
    const int fr = F.lane & 15, fq = F.lane >> 4;
    const int ntn = N / 16, ntiles = (MS / 16) * ntn;
    for (int tile = F.vcu * NWAVES + F.wave; tile < ntiles; tile += F.G * NWAVES) {
        const int tm = tile / ntn, tn = tile - tm * ntn;
        f32x4 acc[NSRC];
#pragma unroll
        for (int sidx = 0; sidx < NSRC; ++sidx) {
            const bf16* ap = src[sidx].A + (size_t)(16 * tm + fr) * src[sidx].lda + 8 * fq;
            const bf16* bp = src[sidx].Bt + (size_t)(16 * tn + fr) * K + 8 * fq;
            f32x4 c = (f32x4){0.f, 0.f, 0.f, 0.f};
#pragma unroll 1
            for (int k = 0; k < K; k += 256) {
                bf16x8 af[8], bfm[8];
#pragma unroll
                for (int i = 0; i < 8; ++i) { af[i] = *(const bf16x8*)(ap + k + 32 * i); bfm[i] = *(const bf16x8*)(bp + k + 32 * i); }
#pragma unroll
                for (int i = 0; i < 8; ++i) c = __builtin_amdgcn_mfma_f32_16x16x32_bf16(bfm[i], af[i], c, 0, 0, 0);
            }
            acc[sidx] = c;
        }
        E(acc, 16 * tm + fr, 16 * tn + 4 * fq, fq);
    }
}
struct SEpiMerge {
    bf16* MG; const bf16* GG;
    __device__ __forceinline__ void operator()(const f32x4 (&acc)[2], int r, int c, int fq) const {
        const size_t row = (size_t)MP + r;
        const v2u ga = *(const v2u*)(GG + row * 2048 + c), gb = *(const v2u*)(GG + row * 2048 + 1024 + c);
        v2u o; o.x = pk2(blo(ga.x) * acc[0][0] + blo(gb.x) * acc[1][0], bhi(ga.x) * acc[0][1] + bhi(gb.x) * acc[1][1]);
        o.y = pk2(blo(ga.y) * acc[0][2] + blo(gb.y) * acc[1][2], bhi(ga.y) * acc[0][3] + bhi(gb.y) * acc[1][3]);
        *(v2u*)(MG + row * DM + c) = o;
    }
};
struct SEpiRes {
    const float* R; float* Y; bf16* YB; float* ss;
    __device__ __forceinline__ void operator()(const f32x4 (&acc)[1], int r, int c, int fq) const {
        const size_t off = (size_t)r * DM + c;
        const f32x4 h = *(const f32x4*)(R + off) + acc[0];
        *(f32x4*)(Y + off) = h;
        if (YB) { v2u w; w.x = pk2(h[0], h[1]); w.y = pk2(h[2], h[3]); *(v2u*)(YB + off) = w; }
        float sq = (h[0] * h[0] + h[1] * h[1]) + (h[2] * h[2] + h[3] * h[3]);
        sq += __shfl_xor(sq, 16); sq += __shfl_xor(sq, 32);
        if (fq == 0) atomicAdd(ss + r, sq);
    }
};

__global__ void __launch_bounds__(NTHR, 2) fwd_mega(Args a) {
    extern __shared__ __attribute__((aligned(16))) unsigned char lds_raw[];
    cg::grid_group grid = cg::this_grid();
    Frame F; F.lds = (LAS unsigned char*)lds_raw; F.tid = threadIdx.x; F.lane = F.tid & 63; F.wave = __builtin_amdgcn_readfirstlane(F.tid >> 6);
    F.G = gridDim.x; { const int bx = blockIdx.x; F.vcu = (F.G % 8 == 0) ? (bx % 8) * (F.G / 8) + bx / 8 : bx; }
    unsigned char* ws = a.ws; float* out = a.out;
    volatile LAS unsigned* bst = (volatile LAS unsigned*)(F.lds + 131072 + 64);
    if (F.tid < 2) bst[F.tid] = 0u;
    __syncthreads();
    bf16* XN = (bf16*)(ws + WS_XN); bf16* GLU = (bf16*)(ws + WS_GLU); bf16* UV = (bf16*)(ws + WS_UV); bf16* GG = (bf16*)(ws + WS_GG);
    bf16* MG = (bf16*)(ws + WS_MG); bf16* AB = (bf16*)(ws + WS_AB); bf16* ACTA = (bf16*)(out + O_Y);
    float* ss1 = (float*)(ws + WS_SS1); float* ss2 = (float*)(ws + WS_SS2);

    p0_prologue(F, a);
    grid.sync();
    const XcdBarrier bar = xcd_barrier_post((unsigned*)(ws + WS_BAR), bst);
    { pg8::Gemm g{XN, (const bf16*)(ws + WS_WIN), MT, NIN, DM, DM}; pg8::StaticOrder S; S.init(MT, NIN, F.G, (int)blockIdx.x);
      pg8::EpiG1 E{GLU, UV, GG};
      pg8::gemm_phase<pg8::EpiG1, pg8::StaticOrder, true, true>(F.lds, g, S, E); }
    xcd_barrier(bar);
    for (int u = F.vcu; u < 256; u += F.G) {
        mixB_prompt(F, a, UV, u >> 1, u & 1);
        { const int b = u >> 5, t0 = (u & 31) * 64; const bool last = (u & 31) == 31;
          convA_prompt(F, a, (const unsigned*)GLU, ACTA, (size_t)b * SEQ + t0, t0 > 0, last ? out + O_CAP + (size_t)b * 30 * DM : nullptr); }
        if (u < 128) convA_sample(F, a, (const unsigned*)GLU, ACTA, u, a.in[2] + (size_t)u * 30 * DM, out + O_CAS + (size_t)u * 30 * DM);
        else mixB_sample(F, a, UV, u - 128, out + O_VS);
    }
    xcd_barrier(bar);
    { const SmallSrc src[2] = {{ACTA + (size_t)MP * DM, DM, (const bf16*)(ws + WS_WA)}, {UV + (size_t)MP * 2048, 2048, (const bf16*)(ws + WS_WB)}};
      SEpiMerge E{MG, GG}; small_gemm<2, SEpiMerge>(F, src, DM, DM, E); }
    { pg8::Gemm g{ACTA, (const bf16*)(ws + WS_WA), MP, DM, DM, DM}; pg8::StaticOrder S; S.init(MP, DM, F.G, (int)blockIdx.x);
      pg8::EpiMerge<0> E{MG, GG};
      pg8::gemm_phase<pg8::EpiMerge<0>, pg8::StaticOrder, true, true>(F.lds, g, S, E); }
    { pg8::Gemm g{UV, (const bf16*)(ws + WS_WB), MP, DM, DM, 2048}; pg8::StaticOrder S; S.init(MP, DM, F.G, (int)blockIdx.x);
      pg8::EpiMerge<1> E{MG, GG};
      pg8::gemm_phase<pg8::EpiMerge<1>, pg8::StaticOrder, true, true>(F.lds, g, S, E); }
    xcd_barrier(bar);
    { const SmallSrc src[1] = {{MG + (size_t)MP * DM, DM, (const bf16*)(ws + WS_WO)}};
      SEpiRes E{a.in[1], out + O_Y + (size_t)MP * DM, XN + (size_t)MP * DM, ss1 + MP}; small_gemm<1, SEpiRes>(F, src, DM, DM, E); }
    { pg8::Gemm g{MG, (const bf16*)(ws + WS_WO), MP, DM, DM, DM}; pg8::StaticOrder S; S.init(MP, DM, F.G, (int)blockIdx.x);
      pg8::EpiRes E{a.in[0], a.in[1], MP, out + O_Y, XN, ss1};
      pg8::gemm_phase<pg8::EpiRes, pg8::StaticOrder, true, true>(F.lds, g, S, E); }
    xcd_barrier(bar);
    { pg8::Gemm g{XN, (const bf16*)(ws + WS_WUP), MT, NUP, DM, DM}; pg8::StaticOrder S; S.init(MT, NUP, F.G, (int)blockIdx.x);
      pg8::EpiUp E{AB, ss1, NUP};
      pg8::gemm_phase<pg8::EpiUp, pg8::StaticOrder, true, true>(F.lds, g, S, E); }
    xcd_barrier(bar);
    p6_ffn_act(F, a, out);
    xcd_barrier(bar);
    { const SmallSrc src[1] = {{AB + (size_t)MP * NUP + DFF, NUP, (const bf16*)(ws + WS_WDN)}};
      SEpiRes E{out + O_Y + (size_t)MP * DM, out + O_Y + (size_t)MP * DM, nullptr, ss2 + MP}; small_gemm<1, SEpiRes>(F, src, DFF, DM, E); }
    { pg8::Gemm g{AB + DFF, (const bf16*)(ws + WS_WDN), MP, DM, DFF, NUP}; pg8::StaticOrder S; S.init(MP, DM, F.G, (int)blockIdx.x);
      pg8::EpiRes E{out + O_Y, out + O_Y + (size_t)MP * DM, MP, out + O_Y, nullptr, ss2};
      pg8::gemm_phase<pg8::EpiRes, pg8::StaticOrder, true, true>(F.lds, g, S, E); }
    xcd_barrier(bar);
    { const Frame F8 = phase_frame(F); const float* gf = a.in[22];
      for (int m = F8.vcu * NWAVES + F8.wave; m < MT; m += F.G * NWAVES) {
          f32x4* yr = (f32x4*)(out + O_Y + (size_t)m * DM) + F8.lane; const f32x4* gr = (const f32x4*)gf + F8.lane;
          const float rstd = 1.0f / sqrtf(ss2[m] * (1.f / DM) + EPS);
#pragma unroll
          for (int j = 0; j < 4; ++j) yr[64 * j] = yr[64 * j] * rstd * gr[64 * j]; } }
}

extern "C" void kernel_launch(void* const* d_in, const int* in_sizes, int n_in, void* d_out, int out_size, void* d_ws, size_t ws_size, hipStream_t stream) {
    static int grid = 0;
    if (grid == 0) {
        if (n_in != 23 || (size_t)out_size != O_END || ws_size < WS_END) { fprintf(stderr, "kernel_launch: unexpected shapes: n_in %d out %d ws %zu\n", n_in, out_size, ws_size); grid = -1; return; }
        int dev = 0, cus = 0, per_cu = 0;
        if (hipGetDevice(&dev) != hipSuccess || hipDeviceGetAttribute(&cus, hipDeviceAttributeMultiprocessorCount, dev) != hipSuccess) { grid = -1; return; }
        if (hipFuncSetAttribute((const void*)fwd_mega, hipFuncAttributeMaxDynamicSharedMemorySize, LDS_BYTES) != hipSuccess) { fprintf(stderr, "kernel_launch: hipFuncSetAttribute failed\n"); grid = -1; return; }
        if (hipOccupancyMaxActiveBlocksPerMultiprocessor(&per_cu, (const void*)fwd_mega, NTHR, LDS_BYTES) != hipSuccess || per_cu < 1) { fprintf(stderr, "kernel_launch: occupancy query says %d\n", per_cu); per_cu = 1; }
        (void)hipGetLastError();
        grid = cus * 1;
        fprintf(stderr, "kernel_launch: cus %d per_cu %d grid %d\n", cus, per_cu, grid);
    }
    if (grid < 0) return;
    Args a{};
    for (int i = 0; i < 23; ++i) a.in[i] = (const float*)d_in[i];
    a.out = (float*)d_out; a.ws = (unsigned char*)d_ws;
    void* args[] = {&a};
    hipError_t e = hipLaunchCooperativeKernel((const void*)fwd_mega, dim3(grid), dim3(NTHR), args, LDS_BYTES, stream);
    if (e != hipSuccess) fprintf(stderr, "kernel_launch: cooperative launch failed: %s (grid %d)\n", hipGetErrorString(e), grid);
}
```

```cpp
#include <hip/hip_runtime.h>
#include <hip/hip_cooperative_groups.h>
#include <cstdio>
#include <cstdint>
namespace cg = cooperative_groups;
namespace pg8 {
#define PG8_LAS __attribute__((address_space(3)))
typedef unsigned short bf16_t;
typedef short bf16x8 __attribute__((ext_vector_type(8)));
typedef float f32x4 __attribute__((ext_vector_type(4)));
typedef unsigned u32x4 __attribute__((ext_vector_type(4)));
constexpr int BM = 256, BK = 64, HALF = 128, HTB = HALF * BK * 2  , STAGE_BYTES = 8 * HTB, NXCD = 8, WGM = 8;

__host__ __device__ __forceinline__ int lds_byte(int r, int c) { const int st = (r >> 4) * 2 + (c >> 5), rr = r & 15, cc = c & 31, ob = rr * 64 + cc * 2; return st * 1024 + (ob ^ (((ob >> 9) & 1) << 5)); }
__host__ __device__ __forceinline__ void stage_rc(int b, int& R, int& C) { const int st = b / 1024, sb = b % 1024, swz = sb ^ (((sb >> 9) & 1) << 5); R = (st >> 1) * 16 + swz / 64; C = (st & 1) * 32 + (swz % 64) / 2; }
__host__ __device__ __forceinline__ int perm32(int rho) { const int n = rho >> 4, i = rho & 15; return 8 * (i >> 2) + 4 * n + (i & 3); }

struct Unit { int pm, pn; };
struct Gemm { const bf16_t* A; const bf16_t* Bt; int M, N, K, lda; };

struct StaticOrder {
    int nM, nN, nwg, G, c;
    __host__ __device__ void init(int M, int N, int G_, int c_) { nM = M / BM; nN = N / BM; nwg = nM * nN; G = G_; c = c_; }
    __host__ __device__ bool next(int i, Unit& u) const {
        const long L = (long)i * G + c; if (L >= nwg) return false;
        int wgid = (int)L; { const int q = nwg / NXCD, r = nwg % NXCD, xcd = wgid % NXCD, off = wgid / NXCD; wgid = (xcd < r ? xcd * (q + 1) : r * (q + 1) + (xcd - r) * q) + off; }
        const int nig = WGM * nN, gid = wgid / nig, fm = gid * WGM, gsz = (nM - fm) < WGM ? (nM - fm) : WGM;
        u.pm = fm + ((wgid % nig) % gsz); u.pn = (wgid % nig) / gsz; return true;
    }
    __device__ __forceinline__ void a_ready(const Unit&) const {}
    __device__ __forceinline__ void done(const Unit&) const {}
};

__device__ __forceinline__ unsigned cvt_pk_bf16(float lo, float hi) { unsigned r; asm volatile("v_cvt_pk_bf16_f32 %0, %1, %2" : "=v"(r) : "v"(lo), "v"(hi)); return r; }
typedef float f32x2 __attribute__((ext_vector_type(2)));
__device__ __forceinline__ f32x2 gelu_pk(f32x2 v) {
    const f32x2 av = __builtin_elementwise_abs(v), d = av * 0.2316418882f + 1.0f;
    f32x2 t; t.x = __builtin_amdgcn_rcpf(d.x); t.y = __builtin_amdgcn_rcpf(d.y);
    f32x2 q = t * 0.5307027145f + (-0.7265760135f); q = q * t + 0.7107068705f; q = q * t + (-0.142248368f); q = q * t + 0.127414796f; q = q * t;
    const f32x2 s = (v * v) * (-0.72134752044f);
    f32x2 e; e.x = __builtin_amdgcn_exp2f(s.x); e.y = __builtin_amdgcn_exp2f(s.y);
    const f32x2 m = v * (q * e), r = v - m;
    f32x2 o; o.x = v.x < 0.f ? m.x : r.x; o.y = v.y < 0.f ? m.y : r.y; return o;
}
typedef unsigned u32x2 __attribute__((ext_vector_type(2)));
__device__ __forceinline__ float sigm(float x) { return __builtin_amdgcn_rcpf(1.0f + __builtin_amdgcn_exp2f(x * -1.44269504089f)); }
__device__ __forceinline__ float bf_lo(unsigned u) { return __uint_as_float(u << 16); }
__device__ __forceinline__ float bf_hi(unsigned u) { return __uint_as_float(u & 0xffff0000u); }

struct EpiG1 {
    static constexpr bool PERM = true, AFTER_DRAIN = false;
    bf16_t* GLU; bf16_t* UV; bf16_t* GG;
    __device__ __forceinline__ void operator()(const f32x4 (&acc)[2][2][4][2], const Unit& u, int wr, int wc, int fr, int fq) const {
        const int row0 = u.pm * BM + wr * 64 + fr;
        if (u.pn < 8) {
            const int col = u.pn * 128 + wc * 32 + 8 * fq;
#pragma unroll
            for (int ai = 0; ai < 2; ++ai)
#pragma unroll
                for (int m = 0; m < 4; ++m) {
                    const f32x4 v0 = acc[ai][0][m][0], v1 = acc[ai][0][m][1], g0 = acc[ai][1][m][0], g1 = acc[ai][1][m][1];
                    u32x4 w; w.x = cvt_pk_bf16(v0[0] * sigm(g0[0]), v0[1] * sigm(g0[1])); w.y = cvt_pk_bf16(v0[2] * sigm(g0[2]), v0[3] * sigm(g0[3]));
                    w.z = cvt_pk_bf16(v1[0] * sigm(g1[0]), v1[1] * sigm(g1[1])); w.w = cvt_pk_bf16(v1[2] * sigm(g1[2]), v1[3] * sigm(g1[3]));
                    *(u32x4*)(GLU + (size_t)(row0 + ai * HALF + m * 16) * 1024 + col) = w; }
        } else {
            const bool isg = u.pn < 16;
            bf16_t* base = isg ? UV : GG;
            const int col0 = (isg ? (u.pn - 8) : (u.pn - 16)) * BM + wc * 32 + 8 * fq;
#pragma unroll
            for (int ai = 0; ai < 2; ++ai)
#pragma unroll
                for (int m = 0; m < 4; ++m) { bf16_t* rowp = base + (size_t)(row0 + ai * HALF + m * 16) * 2048 + col0;
#pragma unroll
                    for (int bj = 0; bj < 2; ++bj) { f32x4 v0 = acc[ai][bj][m][0], v1 = acc[ai][bj][m][1];
                        if (isg) { f32x2 a = gelu_pk((f32x2){v0[0], v0[1]}), b = gelu_pk((f32x2){v0[2], v0[3]}), c = gelu_pk((f32x2){v1[0], v1[1]}), d = gelu_pk((f32x2){v1[2], v1[3]});
                            v0 = (f32x4){a.x, a.y, b.x, b.y}; v1 = (f32x4){c.x, c.y, d.x, d.y}; }
                        else { v0 = (f32x4){sigm(v0[0]), sigm(v0[1]), sigm(v0[2]), sigm(v0[3])}; v1 = (f32x4){sigm(v1[0]), sigm(v1[1]), sigm(v1[2]), sigm(v1[3])}; }
                        u32x4 w; w.x = cvt_pk_bf16(v0[0], v0[1]); w.y = cvt_pk_bf16(v0[2], v0[3]); w.z = cvt_pk_bf16(v1[0], v1[1]); w.w = cvt_pk_bf16(v1[2], v1[3]);
                        *(u32x4*)(rowp + bj * HALF) = w; } }
        }
    }
};
template <int MODE> struct EpiMerge {
    static constexpr bool PERM = true, AFTER_DRAIN = false;
    bf16_t* MG; const bf16_t* GG;
    __device__ __forceinline__ void operator()(const f32x4 (&acc)[2][2][4][2], const Unit& u, int wr, int wc, int fr, int fq) const {
        const int row0 = u.pm * BM + wr * 64 + fr, col0 = u.pn * BM + wc * 32 + 8 * fq;
#pragma unroll
        for (int ai = 0; ai < 2; ++ai)
#pragma unroll
            for (int m = 0; m < 4; ++m) { const size_t row = (size_t)(row0 + ai * HALF + m * 16);
#pragma unroll
                for (int bj = 0; bj < 2; ++bj) { const int col = col0 + bj * HALF;
                    const u32x4 g = *(const u32x4*)(GG + row * 2048 + MODE * 1024 + col);
                    f32x4 v0 = acc[ai][bj][m][0], v1 = acc[ai][bj][m][1];
                    v0 = v0 * (f32x4){bf_lo(g.x), bf_hi(g.x), bf_lo(g.y), bf_hi(g.y)}; v1 = v1 * (f32x4){bf_lo(g.z), bf_hi(g.z), bf_lo(g.w), bf_hi(g.w)};
                    if (MODE == 1) { const u32x4 p = *(const u32x4*)(MG + row * 1024 + col);
                        v0 = v0 + (f32x4){bf_lo(p.x), bf_hi(p.x), bf_lo(p.y), bf_hi(p.y)}; v1 = v1 + (f32x4){bf_lo(p.z), bf_hi(p.z), bf_lo(p.w), bf_hi(p.w)}; }
                    u32x4 w; w.x = cvt_pk_bf16(v0[0], v0[1]); w.y = cvt_pk_bf16(v0[2], v0[3]); w.z = cvt_pk_bf16(v1[0], v1[1]); w.w = cvt_pk_bf16(v1[2], v1[3]);
                    *(u32x4*)(MG + row * 1024 + col) = w; }
                asm volatile("" ::: "memory"); }
    }
};
template <bool RB16> struct EpiRes {
    static constexpr bool PERM = false, AFTER_DRAIN = false;
    const float* R; const bf16_t* RB; float* Y; bf16_t* YB; float* ss;
    __device__ __forceinline__ void operator()(const f32x4 (&acc)[2][2][4][2], const Unit& u, int wr, int wc, int fr, int fq) const {
        const int row0 = u.pm * BM + wr * 64 + fr, col0 = u.pn * BM + wc * 32 + 4 * fq;
#pragma unroll
        for (int ai = 0; ai < 2; ++ai)
#pragma unroll
            for (int m = 0; m < 4; ++m) { const size_t row = (size_t)(row0 + ai * HALF + m * 16); float s = 0.f;
#pragma unroll
                for (int bj = 0; bj < 2; ++bj)
#pragma unroll
                    for (int n = 0; n < 2; ++n) { const size_t off = row * 1024 + col0 + bj * HALF + n * 16;
                        f32x4 h;
                        if (RB16) { const u32x2 p = *(const u32x2*)(RB + off); h = (f32x4){bf_lo(p.x), bf_hi(p.x), bf_lo(p.y), bf_hi(p.y)} + acc[ai][bj][m][n]; *(f32x4*)(Y + off) = h; }
                        else { h = *(const f32x4*)(R + off) + acc[ai][bj][m][n]; u32x2 w; w.x = cvt_pk_bf16(h[0], h[1]); w.y = cvt_pk_bf16(h[2], h[3]); *(u32x2*)(YB + off) = w; }
                        s += (h[0] * h[0] + h[1] * h[1]) + (h[2] * h[2] + h[3] * h[3]); }
                s += __shfl_xor(s, 16); s += __shfl_xor(s, 32);
                if (fq == 0) atomicAdd(ss + row, s);
                asm volatile("" ::: "memory"); }
    }
};
struct EpiUp {
    static constexpr bool PERM = true, AFTER_DRAIN = false;
    bf16_t* AB; const float* ss; int ldc;
    __device__ __forceinline__ void operator()(const f32x4 (&acc)[2][2][4][2], const Unit& u, int wr, int wc, int fr, int fq) const {
        const int row0 = u.pm * BM + wr * 64 + fr, col0 = u.pn * BM + wc * 32 + 8 * fq;
#pragma unroll
        for (int ai = 0; ai < 2; ++ai)
#pragma unroll
            for (int m = 0; m < 4; ++m) { const size_t row = (size_t)(row0 + ai * HALF + m * 16);
                const float rs = __builtin_amdgcn_rsqf(ss[row] * (1.0f / 1024.0f) + 1e-6f);
#pragma unroll
                for (int bj = 0; bj < 2; ++bj) { const f32x4 v0 = acc[ai][bj][m][0] * rs, v1 = acc[ai][bj][m][1] * rs;
                    u32x4 w; w.x = cvt_pk_bf16(v0[0], v0[1]); w.y = cvt_pk_bf16(v0[2], v0[3]); w.z = cvt_pk_bf16(v1[0], v1[1]); w.w = cvt_pk_bf16(v1[2], v1[3]);
                    *(u32x4*)(AB + row * ldc + col0 + bj * HALF) = w; } }
    }
};
template <class Epi, class Sched, bool ALIGN_EPI = false, bool SP2 = false>
__device__ __forceinline__ void gemm_phase(PG8_LAS unsigned char* lds, const Gemm g, const Sched& S, const Epi& E) {
    int tid_ = threadIdx.x; asm volatile("" : "+v"(tid_));
    const int tid = tid_, wid = __builtin_amdgcn_readfirstlane(tid >> 6), lane = tid & 63, wr = wid >> 2, wc = wid & 3, fr = lane & 15, fq = lane >> 4;
    const int K = g.K, nt = K / BK;
    unsigned voffA[2], voffB[2];
#pragma unroll
    for (int i = 0; i < 2; ++i) { int R, C; stage_rc(tid * 16 + i * 8192, R, C); const int Rb = Epi::PERM ? ((R & ~31) + perm32(R & 31)) : R;
        voffA[i] = (unsigned)(R * g.lda + C) * 2u; voffB[i] = (unsigned)(Rb * K + C) * 2u; }
    const size_t kstep = (size_t)(BK * 2);
    const size_t hA = (size_t)HALF * g.lda * 2, hB = (size_t)HALF * K * 2;
    const size_t tA = 2 * hA, tB = 2 * hB;
    const unsigned ldsw = (unsigned)wid * 1024u;
    const int aoff = lds_byte(wr * 64 + fr, fq * 8), boff = lds_byte(wc * 32 + fr, fq * 8);
#define PG8_SA(b, h) (((b) * 2 + (h)) * HTB)
#define PG8_SB(b, h) ((4 + (b) * 2 + (h)) * HTB)
#define PG8_STAGE(bufoff, gbase, voff) do { _Pragma("unroll") for (int _i = 0; _i < 2; ++_i) \
        __builtin_amdgcn_global_load_lds((const unsigned*)((const char*)(gbase) + (voff)[_i]), (PG8_LAS unsigned*)(lds + (bufoff) + ldsw + _i * 8192), 16, 0, 0); } while (0)
#define PG8_LDA(dst, b, h) do { _Pragma("unroll") for (int m = 0; m < 4; ++m) _Pragma("unroll") for (int k = 0; k < 2; ++k) dst[m][k] = *(const PG8_LAS bf16x8*)(lds + PG8_SA(b, h) + aoff + m * 2048 + k * 1024); } while (0)
#define PG8_LDB(dst, b, h) do { _Pragma("unroll") for (int n = 0; n < 2; ++n) _Pragma("unroll") for (int k = 0; k < 2; ++k) dst[n][k] = *(const PG8_LAS bf16x8*)(lds + PG8_SB(b, h) + boff + n * 2048 + k * 1024); } while (0)
#define PG8_MMA(ai, bj, At, Bt) do { __builtin_amdgcn_s_setprio(1); _Pragma("unroll") for (int m = 0; m < 4; ++m) _Pragma("unroll") for (int n = 0; n < 2; ++n) _Pragma("unroll") for (int k = 0; k < 2; ++k) \
        acc[ai][bj][m][n] = __builtin_amdgcn_mfma_f32_16x16x32_bf16(Bt[n][k], At[m][k], acc[ai][bj][m][n], 0, 0, 0); __builtin_amdgcn_s_setprio(0); } while (0)
#define PG8_WAIT_V(n) asm volatile("s_waitcnt vmcnt(" #n ")" ::: "memory")
#define PG8_WAIT_L(n) asm volatile("s_waitcnt lgkmcnt(" #n ")" ::: "memory")
#define PG8_BAR __builtin_amdgcn_s_barrier()
#define PG8_SCHED __builtin_amdgcn_sched_barrier(0)
    Unit cur, nxt; int ui = 0;
    if (!S.next(0, cur)) return;
    f32x4 acc[2][2][4][2];
#pragma unroll
    for (int a = 0; a < 2; ++a)
#pragma unroll
        for (int b = 0; b < 2; ++b)
#pragma unroll
            for (int m = 0; m < 4; ++m)
#pragma unroll
                for (int n = 0; n < 2; ++n) acc[a][b][m][n] = (f32x4){0.f, 0.f, 0.f, 0.f};
    bf16x8 At[4][2], B0[2][2], B1[2][2];
    const char* cA = (const char*)g.A + (size_t)cur.pm * tA; const char* cB = (const char*)g.Bt + (size_t)cur.pn * tB;
    S.a_ready(cur);
    if constexpr (SP2) {
        PG8_STAGE(PG8_SB(0, 0), cB, voffB); PG8_STAGE(PG8_SB(0, 1), cB + hB, voffB); PG8_STAGE(PG8_SA(0, 0), cA, voffA); PG8_STAGE(PG8_SA(0, 1), cA + hA, voffA);
        if (wr == 1) PG8_BAR;
        PG8_WAIT_V(2); PG8_BAR;
        PG8_STAGE(PG8_SB(1, 0), cB + kstep, voffB); PG8_STAGE(PG8_SA(1, 0), cA + kstep, voffA); PG8_STAGE(PG8_SB(1, 1), cB + hB + kstep, voffB);
        PG8_WAIT_V(6); PG8_BAR;
    } else {
        PG8_STAGE(PG8_SB(0, 0), cB, voffB); PG8_STAGE(PG8_SA(0, 0), cA, voffA); PG8_STAGE(PG8_SB(0, 1), cB + hB, voffB); PG8_STAGE(PG8_SA(0, 1), cA + hA, voffA);
        if (wr == 1) PG8_BAR;
        PG8_WAIT_V(4); PG8_BAR;
        PG8_STAGE(PG8_SB(1, 0), cB + kstep, voffB); PG8_STAGE(PG8_SA(1, 0), cA + kstep, voffA); PG8_STAGE(PG8_SB(1, 1), cB + hB + kstep, voffB);
        PG8_WAIT_V(6); PG8_BAR;
    }
    for (;;) {
        const bool has_next = S.next(ui + 1, nxt);
        const char* nA = has_next ? (const char*)g.A + (size_t)nxt.pm * tA : cA; const char* nB = has_next ? (const char*)g.Bt + (size_t)nxt.pn * tB : cB;
        for (int t = 0; t < nt; t += 2) {
            const bool last = (t == nt - 2);
            const char* a1 = cA + (size_t)(t + 1) * kstep;
            const char* a2 = last ? nA : cA + (size_t)(t + 2) * kstep; const char* b2 = last ? nB : cB + (size_t)(t + 2) * kstep;
            const char* a3 = a2 + kstep; const char* b3 = b2 + kstep;
            if (last && has_next) S.a_ready(nxt);
            if constexpr (SP2) {
            PG8_LDB(B0, 0, 0); PG8_LDB(B1, 0, 1); PG8_SCHED; PG8_LDA(At, 0, 0); PG8_STAGE(PG8_SA(1, 1), a1 + hA, voffA);
            PG8_WAIT_V(8); PG8_WAIT_L(0); PG8_BAR; PG8_MMA(0, 0, At, B0); PG8_MMA(0, 1, At, B1); PG8_BAR; PG8_SCHED;
            PG8_LDA(At, 0, 1); PG8_STAGE(PG8_SB(0, 0), b2, voffB); PG8_STAGE(PG8_SB(0, 1), b2 + hB, voffB); PG8_STAGE(PG8_SA(0, 0), a2, voffA);
            PG8_WAIT_V(8); PG8_WAIT_L(0); PG8_BAR; PG8_MMA(1, 0, At, B0); PG8_MMA(1, 1, At, B1); PG8_BAR; PG8_SCHED;
            PG8_LDB(B0, 1, 0); PG8_LDB(B1, 1, 1); PG8_SCHED; PG8_LDA(At, 1, 0); PG8_STAGE(PG8_SA(0, 1), a2 + hA, voffA);
            PG8_WAIT_V(8); PG8_WAIT_L(0); PG8_BAR; PG8_MMA(0, 0, At, B0); PG8_MMA(0, 1, At, B1); PG8_BAR; PG8_SCHED;
            PG8_LDA(At, 1, 1); PG8_STAGE(PG8_SB(1, 0), b3, voffB); PG8_STAGE(PG8_SB(1, 1), b3 + hB, voffB); PG8_STAGE(PG8_SA(1, 0), a3, voffA);
            PG8_WAIT_V(8); PG8_WAIT_L(0); PG8_BAR; PG8_MMA(1, 0, At, B0); PG8_MMA(1, 1, At, B1); PG8_BAR; PG8_SCHED;
            } else {
            PG8_LDB(B0, 0, 0); PG8_SCHED; PG8_LDA(At, 0, 0); PG8_STAGE(PG8_SA(1, 1), a1 + hA, voffA);
            PG8_WAIT_L(8); PG8_BAR; PG8_WAIT_L(0); PG8_MMA(0, 0, At, B0); PG8_BAR; PG8_SCHED;
            PG8_LDB(B1, 0, 1); PG8_STAGE(PG8_SB(0, 0), b2, voffB);
            PG8_BAR; PG8_WAIT_L(0); PG8_MMA(0, 1, At, B1); PG8_BAR;
            PG8_LDA(At, 0, 1); PG8_STAGE(PG8_SA(0, 0), a2, voffA);
            PG8_BAR; PG8_WAIT_L(0); PG8_MMA(1, 0, At, B0); PG8_BAR; PG8_SCHED;
            PG8_STAGE(PG8_SB(0, 1), b2 + hB, voffB);
            PG8_WAIT_V(6); PG8_BAR; PG8_MMA(1, 1, At, B1); PG8_BAR;
            PG8_LDB(B0, 1, 0); PG8_SCHED; PG8_LDA(At, 1, 0); PG8_STAGE(PG8_SA(0, 1), a2 + hA, voffA);
            PG8_WAIT_L(8); PG8_BAR; PG8_WAIT_L(0); PG8_MMA(0, 0, At, B0); PG8_BAR; PG8_SCHED;
            PG8_LDB(B1, 1, 1); PG8_STAGE(PG8_SB(1, 0), b3, voffB);
            PG8_BAR; PG8_WAIT_L(0); PG8_MMA(0, 1, At, B1); PG8_BAR;
            PG8_LDA(At, 1, 1); PG8_STAGE(PG8_SA(1, 0), a3, voffA);
            PG8_BAR; PG8_WAIT_L(0); PG8_MMA(1, 0, At, B0); PG8_BAR; PG8_SCHED;
            PG8_STAGE(PG8_SB(1, 1), b3 + hB, voffB);
            PG8_WAIT_V(6); PG8_BAR; PG8_MMA(1, 1, At, B1); PG8_BAR;
            }
        }
        if constexpr (ALIGN_EPI) { if (wr == 0) PG8_BAR; }
        if constexpr (!Epi::AFTER_DRAIN) { E(acc, cur, wr, wc, fr, fq); S.done(cur); }
        if (!has_next) break;
#pragma unroll
        for (int a = 0; a < 2; ++a)
#pragma unroll
            for (int b = 0; b < 2; ++b)
#pragma unroll
                for (int m = 0; m < 4; ++m)
#pragma unroll
                    for (int n = 0; n < 2; ++n) acc[a][b][m][n] = (f32x4){0.f, 0.f, 0.f, 0.f};
        cur = nxt; cA = nA; cB = nB; ++ui;
        if constexpr (ALIGN_EPI) { if (wr == 1) PG8_BAR; }
    }
    PG8_WAIT_V(0);
    if constexpr (!ALIGN_EPI) { if (wr == 0) PG8_BAR; }
    PG8_BAR;
    if constexpr (Epi::AFTER_DRAIN) { E.fused(acc, cur, wr, wc, fr, fq, lds, wid, lane); S.done(cur); }
#undef PG8_SA
#undef PG8_SB
#undef PG8_STAGE
#undef PG8_LDA
#undef PG8_LDB
#undef PG8_MMA
#undef PG8_WAIT_V
#undef PG8_WAIT_L
#undef PG8_BAR
#undef PG8_SCHED
}
}

constexpr int DM = 1024, NBP = 8, SEQ = 2048, NBS = 128, TS = 4, MP = NBP * SEQ, MS = NBS * TS, MT = MP + MS;
constexpr int NIN = 6144, DFF = 2816, NUP = 2 * DFF, CAW = 31, HB = 8;
constexpr float EPS = 1e-6f;
constexpr int NWAVES = 8, NTHR = 512;
constexpr size_t O_Y = 0, O_CAP = (size_t)MT * DM, O_CAS = O_CAP + (size_t)NBP * 30 * DM, O_VS = O_CAS + (size_t)NBS * 30 * DM, O_FP = O_VS + (size_t)MS * DM, O_FS = O_FP + (size_t)NBP * 2 * DFF, O_END = O_FS + (size_t)NBS * 2 * DFF;
constexpr size_t MiB = 1u << 20;
constexpr size_t WS_SS1 = 0, WS_SS2 = 128 * 1024, WS_BAR = 512 * 1024;
constexpr size_t WS_WUP = 1 * MiB, WS_WDN = 12 * MiB, WS_WIN = 18 * MiB, WS_WA = 30 * MiB, WS_WB = 32 * MiB, WS_WO = 34 * MiB;
constexpr size_t WS_XN = 36 * MiB;
constexpr size_t WS_GLU = 69 * MiB, WS_UV = 102 * MiB, WS_GG = 168 * MiB;
constexpr size_t WS_MG = WS_GLU;
constexpr size_t WS_AB = WS_GLU;
constexpr size_t WS_END = WS_AB + (size_t)MT * NUP * 2;
static_assert(WS_END <= 256 * MiB && WS_GG + (size_t)MT * 2048 * 2 <= 256 * MiB, "d_ws map");
constexpr int LDS_BYTES = 147456;

#define LAS __attribute__((address_space(3)))
typedef unsigned short bf16;
typedef unsigned v4u __attribute__((ext_vector_type(4)));
typedef unsigned v2u __attribute__((ext_vector_type(2)));
typedef float f32x4 __attribute__((ext_vector_type(4)));
typedef float f32x2 __attribute__((ext_vector_type(2)));
typedef short bf16x8 __attribute__((ext_vector_type(8)));
#define LDS_WAIT() asm volatile("s_waitcnt lgkmcnt(0)" ::: "memory")
__device__ __forceinline__ unsigned f2bf(float f) { unsigned u = __builtin_bit_cast(unsigned, f); return (u + 0x7fffu + ((u >> 16) & 1u)) >> 16; }
__device__ __forceinline__ unsigned pk2(float lo, float hi) { return f2bf(lo) | (f2bf(hi) << 16); }
__device__ __forceinline__ float blo(unsigned u) { return __uint_as_float(u << 16); }
__device__ __forceinline__ float bhi(unsigned u) { return __uint_as_float(u & 0xffff0000u); }
__device__ __forceinline__ float sigmf(float x) { return __builtin_amdgcn_rcpf(1.0f + __builtin_amdgcn_exp2f(x * -1.44269504089f)); }
__device__ __forceinline__ float wave_sum(float v) {
#pragma unroll
    for (int o = 1; o < 64; o <<= 1) v += __shfl_xor(v, o);
    return v;
}

struct Args { const float* in[23]; float* out; unsigned char* ws; };
struct Frame { LAS unsigned char* lds; int tid, lane, wave, vcu, G; };
__device__ __forceinline__ Frame phase_frame(const Frame& F0) { Frame F = F0; int t = F0.tid; asm volatile("" : "+v"(t)); F.tid = t; F.lane = t & 63; return F; }

#define XB_TMO      128
#define XB_XCNT(j)  (256  + 64 * (j))
#define XB_XSUB(j)  (1280 + 64 * (j))
#define XB_XGEN(j)  (2304 + 64 * (j))
#define XB_TOP      3328
#define XB_TOPGEN   3392
#define XCD_BAR_WORDS 3456
#define XB_SPIN_CAP (1u << 18)

__device__ __forceinline__ unsigned xb_ld(unsigned* p)              { return __hip_atomic_load(p, __ATOMIC_RELAXED, __HIP_MEMORY_SCOPE_AGENT); }
__device__ __forceinline__ unsigned xb_add(unsigned* p, unsigned v) { return __hip_atomic_fetch_add(p, v, __ATOMIC_RELAXED, __HIP_MEMORY_SCOPE_AGENT); }
__device__ __forceinline__ unsigned xb_xcc_id() { return (unsigned)__builtin_amdgcn_s_getreg((3 << 11) | 20) & 0xFu; }
#define XB_SPIN(cond, bar) do { unsigned _sp = 0; while (cond) { __builtin_amdgcn_s_sleep(1); \
    if ((++_sp & 255u) == 0u) { if (xb_ld(&(bar)[XB_TMO])) break; if (_sp > XB_SPIN_CAP) { atomicAdd(&(bar)[XB_TMO], 1u); break; } } } } while (0)

struct XcdBarrier {
    unsigned* bar; unsigned x;
    volatile LAS unsigned* st;
};

__device__ __forceinline__ XcdBarrier xcd_barrier_post(unsigned* bar, volatile LAS unsigned* st) {
    XcdBarrier b; b.bar = bar; b.x = xb_xcc_id(); b.st = st;
    if (threadIdx.x == 0) (void)xb_add(&bar[XB_XCNT(b.x)], 1u);
    return b;
}
__device__ __forceinline__ void xcd_barrier_complete(unsigned* bar, unsigned x, unsigned& nloc, unsigned& nx) {
    const unsigned G = gridDim.x * gridDim.y * gridDim.z;
    unsigned sum, cnt, mine, sp = 0u;
    for (;;) {
        sum = 0u; cnt = 0u; mine = 0u;
#pragma unroll
        for (unsigned j = 0; j < 16; ++j) { const unsigned c = xb_ld(&bar[XB_XCNT(j)]); sum += c; cnt += (c > 0u) ? 1u : 0u; mine = (j == x) ? c : mine; }
        if (sum == G) break;
        __builtin_amdgcn_s_sleep(1);
        if ((++sp & 255u) == 0u) { if (xb_ld(&bar[XB_TMO])) break; if (sp > XB_SPIN_CAP) { atomicAdd(&bar[XB_TMO], 1u); break; } }
    }
    nloc = mine > 0u ? mine : 1u; nx = cnt > 0u ? cnt : 1u;
}

__device__ __forceinline__ void xcd_barrier(const XcdBarrier& b) {
    asm volatile("s_waitcnt vmcnt(0)" ::: "memory");
    __syncthreads();
    if (threadIdx.x == 0) {
        unsigned* bar = b.bar;
        __builtin_amdgcn_s_waitcnt(0);
        unsigned nloc = b.st[0], nx = b.st[1];
        if (nloc == 0u) { xcd_barrier_complete(bar, b.x, nloc, nx); b.st[0] = nloc; b.st[1] = nx; }
        const unsigned old = xb_add(&bar[XB_XSUB(b.x)], 1u);
        const unsigned gen = old / nloc;
        if (old + 1u == (gen + 1u) * nloc) {
            __builtin_amdgcn_fence(__ATOMIC_RELEASE, "agent");
            asm volatile("s_waitcnt vmcnt(0)" ::: "memory");
            const unsigned og = xb_add(&bar[XB_TOP], 1u);
            const unsigned tg = og / nx;
            if (og + 1u == (tg + 1u) * nx) xb_add(&bar[XB_TOPGEN], 1u);
            else XB_SPIN(xb_ld(&bar[XB_TOPGEN]) == tg, bar);
            __builtin_amdgcn_fence(__ATOMIC_ACQUIRE, "agent");
            xb_add(&bar[XB_XGEN(b.x)], 1u);
            asm volatile("s_waitcnt vmcnt(0)" ::: "memory");
        } else {
            XB_SPIN(xb_ld(&bar[XB_XGEN(b.x)]) == gen, bar);
            __builtin_amdgcn_fence(__ATOMIC_ACQUIRE, "agent");
            asm volatile("s_waitcnt vmcnt(0)" ::: "memory");
        }
    }
    __syncthreads();
}

__device__ __forceinline__ void p0_transpose_item(const float* W, int K, int N, bf16* WT, int mode, const float* kscale, LAS float* scr, int item, int lane) {
    const int nblk = N / 32, kb = item / nblk, nb = item % nblk, k0 = 64 * kb, n0 = 32 * nb;
#pragma unroll 8
    for (int i = 0; i < 32; ++i) { const int kk = 2 * i + (lane >> 5); float v = W[(size_t)(k0 + kk) * N + n0 + (lane & 31)]; if (kscale) v *= kscale[k0 + kk]; scr[kk * 33 + (lane & 31)] = v; }
    LDS_WAIT(); asm volatile("" ::: "memory");
    int n0m = n0;
    if (mode == 1 && n0 < 2048) { const int half = n0 >= 1024 ? 1 : 0, ch = n0 - 1024 * half; n0m = 256 * (ch >> 7) + 128 * half + (ch & 127); }
    const int c = lane & 7;
#pragma unroll
    for (int j = 0; j < 4; ++j) { const int n = (lane >> 3) + 8 * j; const LAS float* s = scr + (8 * c) * 33 + n;
        v4u o; o.x = pk2(s[0 * 33], s[1 * 33]); o.y = pk2(s[2 * 33], s[3 * 33]); o.z = pk2(s[4 * 33], s[5 * 33]); o.w = pk2(s[6 * 33], s[7 * 33]);
        *(v4u*)(WT + (size_t)(n0m + n) * K + k0 + 8 * c) = o; }
    LDS_WAIT(); asm volatile("" ::: "memory");
}
__device__ __forceinline__ void rms_row_to_bf16(const float* xrow, const float* g, bf16* orow, int lane) {
    const f32x4* xr = (const f32x4*)xrow + lane; const f32x4* gr = (const f32x4*)g + lane;
    f32x4 v[4]; float s = 0.f;
#pragma unroll
    for (int j = 0; j < 4; ++j) { v[j] = xr[64 * j]; s += (v[j].x * v[j].x + v[j].y * v[j].y) + (v[j].z * v[j].z + v[j].w * v[j].w); }
    const float rstd = 1.0f / sqrtf(wave_sum(s) * (1.f / DM) + EPS);
    unsigned long long* o8 = (unsigned long long*)orow + lane;
#pragma unroll
    for (int j = 0; j < 4; ++j) { const f32x4 gg = gr[64 * j]; o8[64 * j] = (unsigned long long)pk2(v[j].x * rstd * gg.x, v[j].y * rstd * gg.y) | ((unsigned long long)pk2(v[j].z * rstd * gg.z, v[j].w * rstd * gg.w) << 32); }
}
__device__ __forceinline__ void p0_prologue(const Frame& F0, const Args& a) {
    const Frame F = phase_frame(F0);
    unsigned char* ws = a.ws;
    LAS float* scr = (LAS float*)(F.lds + F.wave * 16384);
    const int gw = F.vcu * NWAVES + F.wave, NGW = F.G * NWAVES;
    constexpr int I_IN = (DM / 64) * (NIN / 32), I_SQ = (DM / 64) * (DM / 32), I_UP = (DM / 64) * (NUP / 32), I_DN = (DFF / 64) * (DM / 32);
    constexpr int NITEMS = I_IN + 3 * I_SQ + I_UP + I_DN;
    for (int it = gw; it < NITEMS; it += NGW) {
        int r = it;
        if (r < I_IN) { p0_transpose_item(a.in[5], DM, NIN, (bf16*)(ws + WS_WIN), 1, nullptr, scr, r, F.lane); continue; } r -= I_IN;
        if (r < I_SQ) { p0_transpose_item(a.in[10], DM, DM, (bf16*)(ws + WS_WA), 0, nullptr, scr, r, F.lane); continue; } r -= I_SQ;
        if (r < I_SQ) { p0_transpose_item(a.in[15], DM, DM, (bf16*)(ws + WS_WB), 0, nullptr, scr, r, F.lane); continue; } r -= I_SQ;
        if (r < I_SQ) { p0_transpose_item(a.in[16], DM, DM, (bf16*)(ws + WS_WO), 0, nullptr, scr, r, F.lane); continue; } r -= I_SQ;
        if (r < I_UP) { p0_transpose_item(a.in[18], DM, NUP, (bf16*)(ws + WS_WUP), 0, a.in[17], scr, r, F.lane); continue; } r -= I_UP;
        p0_transpose_item(a.in[21], DFF, DM, (bf16*)(ws + WS_WDN), 0, nullptr, scr, r, F.lane);
    }
    bf16* XN = (bf16*)(ws + WS_XN);
    for (int m = gw; m < MT; m += NGW) {
        const float* xr = m < MP ? a.in[0] + (size_t)m * DM : a.in[1] + (size_t)(m - MP) * DM;
        rms_row_to_bf16(xr, a.in[4], XN + (size_t)m * DM, F.lane);
    }
    float* ss = (float*)(ws + WS_SS1);
    for (int i = F.vcu * NTHR + F.tid; i < (int)(2 * WS_SS2 / 4); i += F.G * NTHR) ss[i] = 0.f;

}

__device__ __forceinline__ void ln_silu_row(const LAS float* src, bf16* dst, const float* g, const float* bt, int lane) {
    f32x4 v[4]; float s = 0.f;
#pragma unroll
    for (int j = 0; j < 4; ++j) { v[j] = *(const LAS f32x4*)(src + 4 * lane + 256 * j); s += (v[j].x + v[j].y) + (v[j].z + v[j].w); }
    const float mean = wave_sum(s) * (1.f / DM); float s2 = 0.f;
#pragma unroll
    for (int j = 0; j < 4; ++j) { v[j] = v[j] - mean; s2 += (v[j].x * v[j].x + v[j].y * v[j].y) + (v[j].z * v[j].z + v[j].w * v[j].w); }
    const float rstd = 1.0f / sqrtf(wave_sum(s2) * (1.f / DM) + EPS);
#pragma unroll
    for (int j = 0; j < 4; ++j) { const f32x4 gg = *(const f32x4*)(g + 4 * lane + 256 * j), bb = *(const f32x4*)(bt + 4 * lane + 256 * j);
        f32x4 y = v[j] * rstd * gg + bb; y = (f32x4){y.x * sigmf(y.x), y.y * sigmf(y.y), y.z * sigmf(y.z), y.w * sigmf(y.w)};
        v2u w; w.x = pk2(y.x, y.y); w.y = pk2(y.z, y.w); *(v2u*)(dst + 4 * lane + 256 * j) = w; }
}
__device__ __forceinline__ void convA_prompt(const Frame& F0, const Args& a, const unsigned* G32, bf16* ACTA, size_t grow0, bool has_hist, float* capout) {
    const Frame F = phase_frame(F0);
    const int c0 = 2 * F.tid;
    LAS float* CB = (LAS float*)F.lds;
    const float* dw = a.in[6];
    f32x2 w[CAW];
#pragma unroll
    for (int k = 0; k < CAW; ++k) w[k] = *(const f32x2*)(dw + k * DM + c0);
    const f32x2 bias = *(const f32x2*)(a.in[7] + c0);
    f32x2 ring[32];
#pragma unroll
    for (int j = 0; j < 32; ++j) ring[j] = (f32x2){0.f, 0.f};
    if (has_hist) {
        const unsigned* hp = G32 + (grow0 - 30) * 512 + F.tid;
#pragma unroll
        for (int j = 0; j < 30; ++j) { const unsigned u = hp[(size_t)j * 512]; ring[2 + j] = (f32x2){blo(u), bhi(u)}; }
    }
    for (int base = 0; base < 64; base += 32) {
        const unsigned* gp = G32 + (grow0 + base) * 512 + F.tid;
#pragma unroll
        for (int jg = 0; jg < 32; jg += 8) {
            unsigned tmp[8];
#pragma unroll
            for (int jj = 0; jj < 8; ++jj) tmp[jj] = gp[(size_t)(jg + jj) * 512];
#pragma unroll
            for (int jj = 0; jj < 8; ++jj) {
                const int j = jg + jj;
                const f32x2 nv = (f32x2){blo(tmp[jj]), bhi(tmp[jj])};
                ring[j] = nv;
                f32x2 o = bias;
#pragma unroll
                for (int k = 0; k < CAW; ++k) o += ring[(j + k + 2) & 31] * w[k];
                *(LAS f32x2*)(CB + j * DM + c0) = o;
            }
            __builtin_amdgcn_sched_barrier(0);
        }
        if (capout && base == 32) {
#pragma unroll
            for (int j = 2; j < 32; ++j) *(f32x2*)(capout + (size_t)(j - 2) * DM + c0) = ring[j];
        }
        __syncthreads();
#pragma unroll 1
        for (int r = F.wave; r < 32; r += NWAVES) ln_silu_row(CB + r * DM, ACTA + (grow0 + base + r) * DM, a.in[8], a.in[9], F.lane);
        __syncthreads();
    }
}
__device__ __forceinline__ void convA_sample(const Frame& F0, const Args& a, const unsigned* G32, bf16* ACTA, int s, const float* hst, float* casout) {
    const Frame F = phase_frame(F0);
    const int c0 = 2 * F.tid;
    LAS float* CB = (LAS float*)F.lds;
    const float* dw = a.in[6];
    f32x2 w[CAW];
#pragma unroll
    for (int k = 0; k < CAW; ++k) w[k] = *(const f32x2*)(dw + k * DM + c0);
    const f32x2 bias = *(const f32x2*)(a.in[7] + c0);
    f32x2 o[4] = {bias, bias, bias, bias};
    const size_t grow0 = (size_t)MP + 4 * s;
#pragma unroll
    for (int i = 0; i < 34; ++i) {
        f32x2 x;
        if (i < 30) x = *(const f32x2*)(hst + i * DM + c0);
        else { const unsigned u = G32[(grow0 + (i - 30)) * 512 + F.tid]; x = (f32x2){blo(u), bhi(u)}; }
        if (i >= 4) *(f32x2*)(casout + (i - 4) * DM + c0) = x;
#pragma unroll
        for (int t = 0; t < 4; ++t) { const int k = i - t; if (k >= 0 && k < CAW) o[t] += x * w[k]; }
    }
#pragma unroll
    for (int t = 0; t < 4; ++t) *(LAS f32x2*)(CB + t * DM + c0) = o[t];
    __syncthreads();
    if (F.wave < 4) ln_silu_row(CB + F.wave * DM, ACTA + (grow0 + F.wave) * DM, a.in[8], a.in[9], F.lane);
    __syncthreads();
}

__device__ __forceinline__ void ln_stats16(const bf16* vrow, int lane, float (&x)[16], float& mean, float& rstd) {
    const v4u p = *(const v4u*)(vrow + 8 * lane), q = *(const v4u*)(vrow + 512 + 8 * lane);
    x[0] = blo(p.x); x[1] = bhi(p.x); x[2] = blo(p.y); x[3] = bhi(p.y); x[4] = blo(p.z); x[5] = bhi(p.z); x[6] = blo(p.w); x[7] = bhi(p.w);
    x[8] = blo(q.x); x[9] = bhi(q.x); x[10] = blo(q.y); x[11] = bhi(q.y); x[12] = blo(q.z); x[13] = bhi(q.z); x[14] = blo(q.w); x[15] = bhi(q.w);
    float s = 0.f;
#pragma unroll
    for (int i = 0; i < 16; ++i) s += x[i];
    mean = wave_sum(s) * (1.f / DM); float s2 = 0.f;
#pragma unroll
    for (int i = 0; i < 16; ++i) { const float d = x[i] - mean; s2 += d * d; }
    rstd = 1.0f / sqrtf(wave_sum(s2) * (1.f / DM) + EPS);
}
constexpr int VT_LD = 130, WT_LD = 136;
constexpr int MB_STAT = 0, MB_VT = 1024, MB_WT = MB_VT + 128 * VT_LD * 2 + 64;
static_assert(MB_WT % 16 == 0 && MB_WT + 128 * WT_LD * 2 <= 131072, "mixer-B LDS map");
__device__ __forceinline__ void mixB_prompt(const Frame& F0, const Args& a, bf16* UV, int ch, int hh) {
    const Frame F = phase_frame(F0);
    const size_t R0 = (size_t)ch * 128;
    LAS f32x2* STAT = (LAS f32x2*)(F.lds + MB_STAT);
    LAS unsigned char* VT = F.lds + MB_VT; LAS unsigned char* WT = F.lds + MB_WT;
    const float* lng = a.in[11]; const float* lnb = a.in[12]; const float* w_s = a.in[13]; const float* b_s = a.in[14];
    for (int i = 0; i < 16; ++i) { const int r = F.wave * 16 + i; float x[16], mean, rstd; ln_stats16(UV + (R0 + r) * 2048 + 1024, F.lane, x, mean, rstd); if (F.lane == 0) STAT[r] = (f32x2){mean, rstd}; }
    __syncthreads();
    const int lr = F.lane & 15, lq = F.lane >> 4;
    for (int hq = 0; hq < 4; ++hq) {
        const int h = hh * 4 + hq;
#pragma unroll
        for (int i = 0; i < 4; ++i) { const int idx = F.tid + NTHR * i, r = idx >> 4, cgp = idx & 15, c = h * 128 + cgp * 8;
            const v4u p = *(const v4u*)(UV + (R0 + r) * 2048 + 1024 + c); const f32x2 st = STAT[r];
            const f32x4 g0 = *(const f32x4*)(lng + c), g1 = *(const f32x4*)(lng + c + 4), b0 = *(const f32x4*)(lnb + c), b1 = *(const f32x4*)(lnb + c + 4);
            LAS unsigned* dst = (LAS unsigned*)(VT + (r * VT_LD + cgp * 8) * 2);
            dst[0] = pk2((blo(p.x) - st.x) * st.y * g0.x + b0.x, (bhi(p.x) - st.x) * st.y * g0.y + b0.y);
            dst[1] = pk2((blo(p.y) - st.x) * st.y * g0.z + b0.z, (bhi(p.y) - st.x) * st.y * g0.w + b0.w);
            dst[2] = pk2((blo(p.z) - st.x) * st.y * g1.x + b1.x, (bhi(p.z) - st.x) * st.y * g1.y + b1.y);
            dst[3] = pk2((blo(p.w) - st.x) * st.y * g1.z + b1.z, (bhi(p.w) - st.x) * st.y * g1.w + b1.w); }
#pragma unroll
        for (int i = 0; i < 8; ++i) { const int idx = F.tid + NTHR * i, t = idx >> 5, sg = idx & 31;
            const f32x4 wv = *(const f32x4*)(w_s + ((size_t)h * 128 + t) * 128 + sg * 4); const int s0 = sg * 4;
            v2u o; o.x = pk2(s0 <= t ? wv.x : 0.f, s0 + 1 <= t ? wv.y : 0.f); o.y = pk2(s0 + 2 <= t ? wv.z : 0.f, s0 + 3 <= t ? wv.w : 0.f);
            *(LAS v2u*)(WT + (t * WT_LD + s0) * 2) = o; }
        __syncthreads();
        bf16x8 af[4];
#pragma unroll
        for (int ks = 0; ks < 4; ++ks) {
#pragma unroll
            for (int kk = 0; kk < 8; ++kk) af[ks][kk] = (short)*(const LAS unsigned short*)(VT + ((32 * ks + 8 * lq + kk) * VT_LD + 16 * F.wave + lr) * 2);
        }
#pragma unroll
        for (int tb = 0; tb < 8; ++tb) {
            f32x4 acc = (f32x4){0.f, 0.f, 0.f, 0.f};
#pragma unroll
            for (int ks = 0; ks < 4; ++ks) {
                if (32 * ks <= 16 * tb + 15) {
                    const bf16x8 bfr = *(const LAS bf16x8*)(WT + ((16 * tb + lr) * WT_LD + 32 * ks + 8 * lq) * 2);
                    acc = __builtin_amdgcn_mfma_f32_16x16x32_bf16(af[ks], bfr, acc, 0, 0, 0);
                }
            }
            const int t = 16 * tb + lr, c = h * 128 + 16 * F.wave + 4 * lq;
            bf16* up = UV + (R0 + t) * 2048 + c;
            const v2u uu = *(const v2u*)up; const float bsv = b_s[h * 128 + t];
            v2u o; o.x = pk2(blo(uu.x) * (acc[0] + bsv), bhi(uu.x) * (acc[1] + bsv)); o.y = pk2(blo(uu.y) * (acc[2] + bsv), bhi(uu.y) * (acc[3] + bsv));
            *(v2u*)up = o;
        }
        __syncthreads();
    }
}
__device__ __forceinline__ void mixB_sample(const Frame& F0, const Args& a, bf16* UV, int s, float* out_vs) {
    const Frame F = phase_frame(F0);
    LAS float* SV = (LAS float*)F.lds;
    const float* lng = a.in[11]; const float* lnb = a.in[12]; const float* w_s = a.in[13]; const float* b_s = a.in[14];
    const size_t R0 = (size_t)MP + 4 * s;
    if (F.wave < 4) {
        const int t = F.wave; float x[16], mean, rstd; ln_stats16(UV + (R0 + t) * 2048 + 1024, F.lane, x, mean, rstd);
#pragma unroll
        for (int hf = 0; hf < 2; ++hf) { const int c = 512 * hf + 8 * F.lane;
#pragma unroll
            for (int q = 0; q < 2; ++q) { const f32x4 g = *(const f32x4*)(lng + c + 4 * q), b = *(const f32x4*)(lnb + c + 4 * q);
                const f32x4 xv = (f32x4){x[8 * hf + 4 * q], x[8 * hf + 4 * q + 1], x[8 * hf + 4 * q + 2], x[8 * hf + 4 * q + 3]};
                const f32x4 y = (xv - mean) * rstd * g + b;
                *(f32x4*)(out_vs + ((size_t)4 * s + t) * DM + c + 4 * q) = y; *(LAS f32x4*)(SV + t * DM + c + 4 * q) = y; } }
    }
    __syncthreads();
    const int c0 = 2 * F.tid, h = c0 >> 7;
#pragma unroll
    for (int t = 0; t < 4; ++t) {
        const float bsv = b_s[h * 128 + t]; float s0 = bsv, s1 = bsv;
#pragma unroll
        for (int sp = 0; sp <= t; ++sp) { const float wv = w_s[((size_t)h * 128 + t) * 128 + sp]; const f32x2 vv = *(const LAS f32x2*)(SV + sp * DM + c0); s0 += wv * vv.x; s1 += wv * vv.y; }
        unsigned* up = (unsigned*)(UV + (R0 + t) * 2048 + c0); const unsigned uu = *up;
        *up = pk2(blo(uu) * s0, bhi(uu) * s1);
    }
    __syncthreads();
}

__device__ __forceinline__ void unpack8(const v4u p, float (&x)[8]) { x[0] = blo(p.x); x[1] = bhi(p.x); x[2] = blo(p.y); x[3] = bhi(p.y); x[4] = blo(p.z); x[5] = bhi(p.z); x[6] = blo(p.w); x[7] = bhi(p.w); }
__device__ __forceinline__ void ld8f(const float* p, float (&x)[8]) { const f32x4 a = *(const f32x4*)p, b = *(const f32x4*)(p + 4); x[0] = a.x; x[1] = a.y; x[2] = a.z; x[3] = a.w; x[4] = b.x; x[5] = b.y; x[6] = b.z; x[7] = b.w; }
__device__ __forceinline__ void st8f(float* p, const float (&x)[8]) { *(f32x4*)p = (f32x4){x[0], x[1], x[2], x[3]}; *(f32x4*)(p + 4) = (f32x4){x[4], x[5], x[6], x[7]}; }
__device__ __forceinline__ void p6_ffn_act(const Frame& F0, const Args& a, float* out) {
    const Frame F = phase_frame(F0);
    bf16* AB = (bf16*)(a.ws + WS_AB);
    constexpr int NG = DFF / 8, RUN = 16, NPI = (MP / RUN) * NG, NSI = NBS * NG;
    const float* dwf = a.in[19]; const float* bdw = a.in[20]; const float* stf = a.in[3];
    for (int it = F.vcu * NTHR + F.tid; it < NPI + NSI; it += F.G * NTHR) {
        float a2[8], a1[8]; size_t row0; int nrows, c; float* fo = nullptr; int fofrom = 0;
        if (it < NPI) { const int run = it / NG, cgp = it - run * NG; c = cgp * 8; row0 = (size_t)run * RUN; nrows = RUN; const int t0 = (int)(row0 & (SEQ - 1));
            if (t0 > 0) { unpack8(*(const v4u*)(AB + (row0 - 2) * NUP + c), a2); unpack8(*(const v4u*)(AB + (row0 - 1) * NUP + c), a1); }
            else {
#pragma unroll
                for (int j = 0; j < 8; ++j) { a2[j] = 0.f; a1[j] = 0.f; } }
            if (t0 == SEQ - RUN) { fo = out + O_FP + (size_t)(row0 >> 11) * 2 * DFF + c; fofrom = RUN - 2; }
        } else { const int i2 = it - NPI, s = i2 / NG, cgp = i2 - s * NG; c = cgp * 8; row0 = (size_t)MP + 4 * s; nrows = 4;
            ld8f(stf + ((size_t)s * 2 + 0) * DFF + c, a2); ld8f(stf + ((size_t)s * 2 + 1) * DFF + c, a1);
            fo = out + O_FS + (size_t)s * 2 * DFF + c; fofrom = 2; }
        float w0[8], w1[8], w2[8], bs[8]; ld8f(dwf + c, w0); ld8f(dwf + DFF + c, w1); ld8f(dwf + 2 * DFF + c, w2); ld8f(bdw + c, bs);
        for (int i = 0; i < nrows; ++i) {
            bf16* ap = AB + (row0 + i) * NUP + c; float a0[8], bb[8]; unpack8(*(const v4u*)ap, a0); unpack8(*(const v4u*)(ap + DFF), bb);
            float o[8];
#pragma unroll
            for (int j = 0; j < 8; j += 2) { f32x2 cv = (f32x2){a2[j] * w0[j] + a1[j] * w1[j] + a0[j] * w2[j] + bs[j], a2[j + 1] * w0[j + 1] + a1[j + 1] * w1[j + 1] + a0[j + 1] * w2[j + 1] + bs[j + 1]};
                cv = pg8::gelu_pk(cv); o[j] = cv.x * bb[j]; o[j + 1] = cv.y * bb[j + 1]; }
            v4u w; w.x = pk2(o[0], o[1]); w.y = pk2(o[2], o[3]); w.z = pk2(o[4], o[5]); w.w = pk2(o[6], o[7]);
            *(v4u*)(ap + DFF) = w;
            if (fo && i >= fofrom) st8f(fo + (size_t)(i - fofrom) * DFF, a0);
#pragma unroll
            for (int j = 0; j < 8; ++j) { a2[j] = a1[j]; a1[j] = a0[j]; }
        }
    }
}


struct SmallSrc { const bf16* A; int lda; const bf16* Bt; };
template <int NSRC, class Epi>
__device__ __forceinline__ void small_gemm(const Frame& F0, const SmallSrc (&src)[NSRC], int K, int N, const Epi& E) {
    const Frame F = phase_frame(F0);
    const int fr = F.lane & 15, fq = F.lane >> 4;
    const int ntn = N / 16, ntiles = (MS / 16) * ntn;
    for (int tile = F.vcu * NWAVES + F.wave; tile < ntiles; tile += F.G * NWAVES) {
        const int tm = tile / ntn, tn = tile - tm * ntn;
        f32x4 acc[NSRC];
#pragma unroll
        for (int sidx = 0; sidx < NSRC; ++sidx) {
            const bf16* ap = src[sidx].A + (size_t)(16 * tm + fr) * src[sidx].lda + 8 * fq;
            const bf16* bp = src[sidx].Bt + (size_t)(16 * tn + fr) * K + 8 * fq;
            f32x4 c = (f32x4){0.f, 0.f, 0.f, 0.f};
#pragma unroll 1
            for (int k = 0; k < K; k += 256) {
                bf16x8 af[8], bfm[8];
#pragma unroll
                for (int i = 0; i < 8; ++i) { af[i] = *(const bf16x8*)(ap + k + 32 * i); bfm[i] = *(const bf16x8*)(bp + k + 32 * i); }
#pragma unroll
                for (int i = 0; i < 8; ++i) c = __builtin_amdgcn_mfma_f32_16x16x32_bf16(bfm[i], af[i], c, 0, 0, 0);
            }
            acc[sidx] = c;
        }
        E(acc, 16 * tm + fr, 16 * tn + 4 * fq, fq);
    }
}
struct SEpiMerge {
    bf16* MG; const bf16* GG;
    __device__ __forceinline__ void operator()(const f32x4 (&acc)[2], int r, int c, int fq) const {
        const size_t row = (size_t)MP + r;
        const v2u ga = *(const v2u*)(GG + row * 2048 + c), gb = *(const v2u*)(GG + row * 2048 + 1024 + c);
        v2u o; o.x = pk2(blo(ga.x) * acc[0][0] + blo(gb.x) * acc[1][0], bhi(ga.x) * acc[0][1] + bhi(gb.x) * acc[1][1]);
        o.y = pk2(blo(ga.y) * acc[0][2] + blo(gb.y) * acc[1][2], bhi(ga.y) * acc[0][3] + bhi(gb.y) * acc[1][3]);
        *(v2u*)(MG + row * DM + c) = o;
    }
};
template <bool RB16> struct SEpiRes {
    const float* R; const bf16* RB; float* Y; bf16* YB; float* ss;
    __device__ __forceinline__ void operator()(const f32x4 (&acc)[1], int r, int c, int fq) const {
        const size_t off = (size_t)r * DM + c;
        f32x4 h;
        if (RB16) { const v2u p = *(const v2u*)(RB + off); h = (f32x4){blo(p.x), bhi(p.x), blo(p.y), bhi(p.y)} + acc[0]; *(f32x4*)(Y + off) = h; }
        else { h = *(const f32x4*)(R + off) + acc[0]; v2u w; w.x = pk2(h[0], h[1]); w.y = pk2(h[2], h[3]); *(v2u*)(YB + off) = w; }
        float sq = (h[0] * h[0] + h[1] * h[1]) + (h[2] * h[2] + h[3] * h[3]);
        sq += __shfl_xor(sq, 16); sq += __shfl_xor(sq, 32);
        if (fq == 0) atomicAdd(ss + r, sq);
    }
};

__global__ void __launch_bounds__(NTHR, 2) fwd_mega(Args a) {
    extern __shared__ __attribute__((aligned(16))) unsigned char lds_raw[];
    cg::grid_group grid = cg::this_grid();
    Frame F; F.lds = (LAS unsigned char*)lds_raw; F.tid = threadIdx.x; F.lane = F.tid & 63; F.wave = __builtin_amdgcn_readfirstlane(F.tid >> 6);
    F.G = gridDim.x; { const int bx = blockIdx.x; F.vcu = (F.G % 8 == 0) ? (bx % 8) * (F.G / 8) + bx / 8 : bx; }
    unsigned char* ws = a.ws; float* out = a.out;
    volatile LAS unsigned* bst = (volatile LAS unsigned*)(F.lds + 131072 + 64);
    if (F.tid < 2) bst[F.tid] = 0u;
    __syncthreads();
    bf16* XN = (bf16*)(ws + WS_XN); bf16* GLU = (bf16*)(ws + WS_GLU); bf16* UV = (bf16*)(ws + WS_UV); bf16* GG = (bf16*)(ws + WS_GG);
    bf16* MG = (bf16*)(ws + WS_MG); bf16* AB = (bf16*)(ws + WS_AB); bf16* ACTA = (bf16*)(out + O_Y);
    float* ss1 = (float*)(ws + WS_SS1); float* ss2 = (float*)(ws + WS_SS2);

    const XcdBarrier bar = xcd_barrier_post((unsigned*)(ws + WS_BAR), bst);
    if (a.ws == nullptr) grid.sync();
    p0_prologue(F, a);
    xcd_barrier(bar);
    { pg8::Gemm g{XN, (const bf16*)(ws + WS_WIN), MT, NIN, DM, DM}; pg8::StaticOrder S; S.init(MT, NIN, F.G, (int)blockIdx.x);
      pg8::EpiG1 E{GLU, UV, GG};
      pg8::gemm_phase<pg8::EpiG1, pg8::StaticOrder, true, true>(F.lds, g, S, E); }
    xcd_barrier(bar);
    for (int u = F.vcu; u < 256; u += F.G) {
        mixB_prompt(F, a, UV, u >> 1, u & 1);
        { const int b = u >> 5, t0 = (u & 31) * 64; const bool last = (u & 31) == 31;
          convA_prompt(F, a, (const unsigned*)GLU, ACTA, (size_t)b * SEQ + t0, t0 > 0, last ? out + O_CAP + (size_t)b * 30 * DM : nullptr); }
        if (u < 128) convA_sample(F, a, (const unsigned*)GLU, ACTA, u, a.in[2] + (size_t)u * 30 * DM, out + O_CAS + (size_t)u * 30 * DM);
        else mixB_sample(F, a, UV, u - 128, out + O_VS);
    }
    xcd_barrier(bar);
    { const SmallSrc src[2] = {{ACTA + (size_t)MP * DM, DM, (const bf16*)(ws + WS_WA)}, {UV + (size_t)MP * 2048, 2048, (const bf16*)(ws + WS_WB)}};
      SEpiMerge E{MG, GG}; small_gemm<2, SEpiMerge>(F, src, DM, DM, E); }
    { pg8::Gemm g{ACTA, (const bf16*)(ws + WS_WA), MP, DM, DM, DM}; pg8::StaticOrder S; S.init(MP, DM, F.G, (int)blockIdx.x);
      pg8::EpiMerge<0> E{MG, GG};
      pg8::gemm_phase<pg8::EpiMerge<0>, pg8::StaticOrder, true, true>(F.lds, g, S, E); }
    { pg8::Gemm g{UV, (const bf16*)(ws + WS_WB), MP, DM, DM, 2048}; pg8::StaticOrder S; S.init(MP, DM, F.G, (int)blockIdx.x);
      pg8::EpiMerge<1> E{MG, GG};
      pg8::gemm_phase<pg8::EpiMerge<1>, pg8::StaticOrder, true, true>(F.lds, g, S, E); }
    xcd_barrier(bar);
    { const SmallSrc src[1] = {{MG + (size_t)MP * DM, DM, (const bf16*)(ws + WS_WO)}};
      SEpiRes<false> E{a.in[1], nullptr, nullptr, XN + (size_t)MP * DM, ss1 + MP}; small_gemm<1, SEpiRes<false>>(F, src, DM, DM, E); }
    { pg8::Gemm g{MG, (const bf16*)(ws + WS_WO), MP, DM, DM, DM}; pg8::StaticOrder S; S.init(MP, DM, F.G, (int)blockIdx.x);
      pg8::EpiRes<false> E{a.in[0], nullptr, nullptr, XN, ss1};
      pg8::gemm_phase<pg8::EpiRes<false>, pg8::StaticOrder, true, true>(F.lds, g, S, E); }
    xcd_barrier(bar);
    { pg8::Gemm g{XN, (const bf16*)(ws + WS_WUP), MT, NUP, DM, DM}; pg8::StaticOrder S; S.init(MT, NUP, F.G, (int)blockIdx.x);
      pg8::EpiUp E{AB, ss1, NUP};
      pg8::gemm_phase<pg8::EpiUp, pg8::StaticOrder, true, true>(F.lds, g, S, E); }
    xcd_barrier(bar);
    p6_ffn_act(F, a, out);
    xcd_barrier(bar);
    { const SmallSrc src[1] = {{AB + (size_t)MP * NUP + DFF, NUP, (const bf16*)(ws + WS_WDN)}};
      SEpiRes<true> E{nullptr, XN + (size_t)MP * DM, out + O_Y + (size_t)MP * DM, nullptr, ss2 + MP}; small_gemm<1, SEpiRes<true>>(F, src, DFF, DM, E); }
    { pg8::Gemm g{AB + DFF, (const bf16*)(ws + WS_WDN), MP, DM, DFF, NUP}; pg8::StaticOrder S; S.init(MP, DM, F.G, (int)blockIdx.x);
      pg8::EpiRes<true> E{nullptr, XN, out + O_Y, nullptr, ss2};
      pg8::gemm_phase<pg8::EpiRes<true>, pg8::StaticOrder, true, true>(F.lds, g, S, E); }
    xcd_barrier(bar);
    { const Frame F8 = phase_frame(F); const float* gf = a.in[22];
      for (int m = F8.vcu * NWAVES + F8.wave; m < MT; m += F.G * NWAVES) {
          f32x4* yr = (f32x4*)(out + O_Y + (size_t)m * DM) + F8.lane; const f32x4* gr = (const f32x4*)gf + F8.lane;
          const float rstd = 1.0f / sqrtf(ss2[m] * (1.f / DM) + EPS);
#pragma unroll
          for (int j = 0; j < 4; ++j) yr[64 * j] = yr[64 * j] * rstd * gr[64 * j]; } }
}

extern "C" void kernel_launch(void* const* d_in, const int* in_sizes, int n_in, void* d_out, int out_size, void* d_ws, size_t ws_size, hipStream_t stream) {
    static int grid = 0;
    if (grid == 0) {
        if (n_in != 23 || (size_t)out_size != O_END || ws_size < WS_END) { fprintf(stderr, "kernel_launch: unexpected shapes: n_in %d out %d ws %zu\n", n_in, out_size, ws_size); grid = -1; return; }
        int dev = 0, cus = 0, per_cu = 0;
        if (hipGetDevice(&dev) != hipSuccess || hipDeviceGetAttribute(&cus, hipDeviceAttributeMultiprocessorCount, dev) != hipSuccess) { grid = -1; return; }
        if (hipFuncSetAttribute((const void*)fwd_mega, hipFuncAttributeMaxDynamicSharedMemorySize, LDS_BYTES) != hipSuccess) { fprintf(stderr, "kernel_launch: hipFuncSetAttribute failed\n"); grid = -1; return; }
        if (hipOccupancyMaxActiveBlocksPerMultiprocessor(&per_cu, (const void*)fwd_mega, NTHR, LDS_BYTES) != hipSuccess || per_cu < 1) { fprintf(stderr, "kernel_launch: occupancy query says %d\n", per_cu); per_cu = 1; }
        (void)hipGetLastError();
        grid = cus * 1;
        fprintf(stderr, "kernel_launch: cus %d per_cu %d grid %d\n", cus, per_cu, grid);
    }
    if (grid < 0) return;
    if (hipMemsetAsync((char*)d_ws + WS_BAR, 0, XCD_BAR_WORDS * 4, stream) != hipSuccess) { fprintf(stderr, "kernel_launch: memset failed\n"); return; }
    Args a{};
    for (int i = 0; i < 23; ++i) a.in[i] = (const float*)d_in[i];
    a.out = (float*)d_out; a.ws = (unsigned char*)d_ws;
    void* args[] = {&a};
    hipError_t e = hipLaunchCooperativeKernel((const void*)fwd_mega, dim3(grid), dim3(NTHR), args, LDS_BYTES, stream);
    if (e != hipSuccess) fprintf(stderr, "kernel_launch: cooperative launch failed: %s (grid %d)\n", hipGetErrorString(e), grid);
}
```

```cpp
#include <hip/hip_runtime.h>
#include <hip/hip_cooperative_groups.h>
#include <cstdio>
#include <cstdint>
namespace cg = cooperative_groups;
namespace pg8 {
#define PG8_LAS __attribute__((address_space(3)))
typedef unsigned short bf16_t;
typedef short bf16x8 __attribute__((ext_vector_type(8)));
typedef float f32x4 __attribute__((ext_vector_type(4)));
typedef unsigned u32x4 __attribute__((ext_vector_type(4)));
constexpr int BM = 256, BK = 64, HALF = 128, HTB = HALF * BK * 2  , STAGE_BYTES = 8 * HTB, NXCD = 8, WGM = 8;

__host__ __device__ __forceinline__ int lds_byte(int r, int c) { const int st = (r >> 4) * 2 + (c >> 5), rr = r & 15, cc = c & 31, ob = rr * 64 + cc * 2; return st * 1024 + (ob ^ (((ob >> 9) & 1) << 5)); }
__host__ __device__ __forceinline__ void stage_rc(int b, int& R, int& C) { const int st = b / 1024, sb = b % 1024, swz = sb ^ (((sb >> 9) & 1) << 5); R = (st >> 1) * 16 + swz / 64; C = (st & 1) * 32 + (swz % 64) / 2; }
__host__ __device__ __forceinline__ int perm32(int rho) { const int n = rho >> 4, i = rho & 15; return 8 * (i >> 2) + 4 * n + (i & 3); }

struct Unit { int pm, pn; };
struct Gemm { const bf16_t* A; const bf16_t* Bt; int M, N, K, lda; };

struct StaticOrder {
    int nM, nN, nwg, G, c;
    __host__ __device__ void init(int M, int N, int G_, int c_) { nM = M / BM; nN = N / BM; nwg = nM * nN; G = G_; c = c_; }
    __host__ __device__ bool next(int i, Unit& u) const {
        const long L = (long)i * G + c; if (L >= nwg) return false;
        int wgid = (int)L; { const int q = nwg / NXCD, r = nwg % NXCD, xcd = wgid % NXCD, off = wgid / NXCD; wgid = (xcd < r ? xcd * (q + 1) : r * (q + 1) + (xcd - r) * q) + off; }
        const int nig = WGM * nN, gid = wgid / nig, fm = gid * WGM, gsz = (nM - fm) < WGM ? (nM - fm) : WGM;
        u.pm = fm + ((wgid % nig) % gsz); u.pn = (wgid % nig) / gsz; return true;
    }
    __device__ __forceinline__ void a_ready(const Unit&) const {}
    __device__ __forceinline__ void done(const Unit&) const {}
};

__device__ __forceinline__ unsigned cvt_pk_bf16(float lo, float hi) { unsigned r; asm volatile("v_cvt_pk_bf16_f32 %0, %1, %2" : "=v"(r) : "v"(lo), "v"(hi)); return r; }
typedef float f32x2 __attribute__((ext_vector_type(2)));
__device__ __forceinline__ f32x2 gelu_pk(f32x2 v) {
    const f32x2 av = __builtin_elementwise_abs(v), d = av * 0.2316418882f + 1.0f;
    f32x2 t; t.x = __builtin_amdgcn_rcpf(d.x); t.y = __builtin_amdgcn_rcpf(d.y);
    f32x2 q = t * 0.5307027145f + (-0.7265760135f); q = q * t + 0.7107068705f; q = q * t + (-0.142248368f); q = q * t + 0.127414796f; q = q * t;
    const f32x2 s = (v * v) * (-0.72134752044f);
    f32x2 e; e.x = __builtin_amdgcn_exp2f(s.x); e.y = __builtin_amdgcn_exp2f(s.y);
    const f32x2 m = v * (q * e), r = v - m;
    f32x2 o; o.x = v.x < 0.f ? m.x : r.x; o.y = v.y < 0.f ? m.y : r.y; return o;
}
typedef unsigned u32x2 __attribute__((ext_vector_type(2)));
__device__ __forceinline__ float sigm(float x) { return __builtin_amdgcn_rcpf(1.0f + __builtin_amdgcn_exp2f(x * -1.44269504089f)); }
__device__ __forceinline__ float bf_lo(unsigned u) { return __uint_as_float(u << 16); }
__device__ __forceinline__ float bf_hi(unsigned u) { return __uint_as_float(u & 0xffff0000u); }

struct EpiG1 {
    static constexpr bool PERM = true, AFTER_DRAIN = false;
    bf16_t* GLU; bf16_t* UV; bf16_t* GG;
    __device__ __forceinline__ void operator()(const f32x4 (&acc)[2][2][4][2], const Unit& u, int wr, int wc, int fr, int fq) const {
        const int row0 = u.pm * BM + wr * 64 + fr;
        if (u.pn < 8) {
            const int col = u.pn * 128 + wc * 32 + 8 * fq;
#pragma unroll
            for (int ai = 0; ai < 2; ++ai)
#pragma unroll
                for (int m = 0; m < 4; ++m) {
                    const f32x4 v0 = acc[ai][0][m][0], v1 = acc[ai][0][m][1], g0 = acc[ai][1][m][0], g1 = acc[ai][1][m][1];
                    u32x4 w; w.x = cvt_pk_bf16(v0[0] * sigm(g0[0]), v0[1] * sigm(g0[1])); w.y = cvt_pk_bf16(v0[2] * sigm(g0[2]), v0[3] * sigm(g0[3]));
                    w.z = cvt_pk_bf16(v1[0] * sigm(g1[0]), v1[1] * sigm(g1[1])); w.w = cvt_pk_bf16(v1[2] * sigm(g1[2]), v1[3] * sigm(g1[3]));
                    *(u32x4*)(GLU + (size_t)(row0 + ai * HALF + m * 16) * 1024 + col) = w; }
        } else {
            const bool isg = u.pn < 16;
            bf16_t* base = isg ? UV : GG;
            const int col0 = (isg ? (u.pn - 8) : (u.pn - 16)) * BM + wc * 32 + 8 * fq;
#pragma unroll
            for (int ai = 0; ai < 2; ++ai)
#pragma unroll
                for (int m = 0; m < 4; ++m) { bf16_t* rowp = base + (size_t)(row0 + ai * HALF + m * 16) * 2048 + col0;
#pragma unroll
                    for (int bj = 0; bj < 2; ++bj) { f32x4 v0 = acc[ai][bj][m][0], v1 = acc[ai][bj][m][1];
                        if (isg) { f32x2 a = gelu_pk((f32x2){v0[0], v0[1]}), b = gelu_pk((f32x2){v0[2], v0[3]}), c = gelu_pk((f32x2){v1[0], v1[1]}), d = gelu_pk((f32x2){v1[2], v1[3]});
                            v0 = (f32x4){a.x, a.y, b.x, b.y}; v1 = (f32x4){c.x, c.y, d.x, d.y}; }
                        else { v0 = (f32x4){sigm(v0[0]), sigm(v0[1]), sigm(v0[2]), sigm(v0[3])}; v1 = (f32x4){sigm(v1[0]), sigm(v1[1]), sigm(v1[2]), sigm(v1[3])}; }
                        u32x4 w; w.x = cvt_pk_bf16(v0[0], v0[1]); w.y = cvt_pk_bf16(v0[2], v0[3]); w.z = cvt_pk_bf16(v1[0], v1[1]); w.w = cvt_pk_bf16(v1[2], v1[3]);
                        *(u32x4*)(rowp + bj * HALF) = w; } }
        }
    }
};
template <int MODE> struct EpiMerge {
    static constexpr bool PERM = true, AFTER_DRAIN = false;
    bf16_t* MG; const bf16_t* GG;
    __device__ __forceinline__ void operator()(const f32x4 (&acc)[2][2][4][2], const Unit& u, int wr, int wc, int fr, int fq) const {
        const int row0 = u.pm * BM + wr * 64 + fr, col0 = u.pn * BM + wc * 32 + 8 * fq;
#pragma unroll
        for (int ai = 0; ai < 2; ++ai)
#pragma unroll
            for (int m = 0; m < 4; ++m) { const size_t row = (size_t)(row0 + ai * HALF + m * 16);
#pragma unroll
                for (int bj = 0; bj < 2; ++bj) { const int col = col0 + bj * HALF;
                    const u32x4 g = *(const u32x4*)(GG + row * 2048 + MODE * 1024 + col);
                    f32x4 v0 = acc[ai][bj][m][0], v1 = acc[ai][bj][m][1];
                    v0 = v0 * (f32x4){bf_lo(g.x), bf_hi(g.x), bf_lo(g.y), bf_hi(g.y)}; v1 = v1 * (f32x4){bf_lo(g.z), bf_hi(g.z), bf_lo(g.w), bf_hi(g.w)};
                    if (MODE == 1) { const u32x4 p = *(const u32x4*)(MG + row * 1024 + col);
                        v0 = v0 + (f32x4){bf_lo(p.x), bf_hi(p.x), bf_lo(p.y), bf_hi(p.y)}; v1 = v1 + (f32x4){bf_lo(p.z), bf_hi(p.z), bf_lo(p.w), bf_hi(p.w)}; }
                    u32x4 w; w.x = cvt_pk_bf16(v0[0], v0[1]); w.y = cvt_pk_bf16(v0[2], v0[3]); w.z = cvt_pk_bf16(v1[0], v1[1]); w.w = cvt_pk_bf16(v1[2], v1[3]);
                    *(u32x4*)(MG + row * 1024 + col) = w; }
                asm volatile("" ::: "memory"); }
    }
};
template <bool RB16> struct EpiRes {
    static constexpr bool PERM = false, AFTER_DRAIN = false;
    const float* R; const bf16_t* RB; float* Y; bf16_t* YB; float* ss;
    __device__ __forceinline__ void operator()(const f32x4 (&acc)[2][2][4][2], const Unit& u, int wr, int wc, int fr, int fq) const {
        const int row0 = u.pm * BM + wr * 64 + fr, col0 = u.pn * BM + wc * 32 + 4 * fq;
#pragma unroll
        for (int ai = 0; ai < 2; ++ai)
#pragma unroll
            for (int m = 0; m < 4; ++m) { const size_t row = (size_t)(row0 + ai * HALF + m * 16); float s = 0.f;
#pragma unroll
                for (int bj = 0; bj < 2; ++bj)
#pragma unroll
                    for (int n = 0; n < 2; ++n) { const size_t off = row * 1024 + col0 + bj * HALF + n * 16;
                        f32x4 h;
                        if (RB16) { const u32x2 p = *(const u32x2*)(RB + off); h = (f32x4){bf_lo(p.x), bf_hi(p.x), bf_lo(p.y), bf_hi(p.y)} + acc[ai][bj][m][n]; *(f32x4*)(Y + off) = h; }
                        else { h = *(const f32x4*)(R + off) + acc[ai][bj][m][n]; u32x2 w; w.x = cvt_pk_bf16(h[0], h[1]); w.y = cvt_pk_bf16(h[2], h[3]); *(u32x2*)(YB + off) = w; }
                        s += (h[0] * h[0] + h[1] * h[1]) + (h[2] * h[2] + h[3] * h[3]); }
                s += __shfl_xor(s, 16); s += __shfl_xor(s, 32);
                if (fq == 0) atomicAdd(ss + row, s);
                asm volatile("" ::: "memory"); }
    }
};
struct EpiUpFused {
    static constexpr bool PERM = true, AFTER_DRAIN = false;
    bf16_t* ACT; const float* ss; const float* dwf; const float* bdw; const float* stf; float* sideLast; float* sideFirst; float* out_fs;
    __device__ __forceinline__ void operator()(const f32x4 (&acc)[2][2][4][2], const Unit& u, int wr, int wc, int fr, int fq) const {
        constexpr int DFF_ = 2816, MP_ = 16384;
        const int cch = u.pn * 128 + wc * 32 + 8 * fq;
        const int lane = fq * 16 + fr, src1 = (lane & 48) | ((fr - 1) & 15), src2 = (lane & 48) | ((fr - 2) & 15);
        f32x4 w0[2], w1[2], w2[2], bs[2];
#pragma unroll
        for (int n = 0; n < 2; ++n) { w0[n] = *(const f32x4*)(dwf + cch + 4 * n); w1[n] = *(const f32x4*)(dwf + DFF_ + cch + 4 * n); w2[n] = *(const f32x4*)(dwf + 2 * DFF_ + cch + 4 * n); bs[n] = *(const f32x4*)(bdw + cch + 4 * n); }
        const bool sample = u.pm >= 64;
#pragma unroll
        for (int ai = 0; ai < 2; ++ai) {
            const int blk = u.pm * 4 + ai * 2 + wr;
            f32x4 p1[2], p2[2];
#pragma unroll
            for (int n = 0; n < 2; ++n) { p1[n] = (f32x4){0.f, 0.f, 0.f, 0.f}; p2[n] = (f32x4){0.f, 0.f, 0.f, 0.f}; }
#pragma unroll
            for (int m = 0; m < 4; ++m) {
                const int row = blk * 64 + 16 * m + fr;
                const float rs = __builtin_amdgcn_rsqf(ss[row] * (1.0f / 1024.0f) + 1e-6f);
                const int t4 = fr & 3, sq = (row - MP_) >> 2;
                u32x4 wout;
#pragma unroll
                for (int n = 0; n < 2; ++n) {
                    const f32x4 av = acc[ai][0][m][n] * rs, bv = acc[ai][1][m][n] * rs;
                    f32x4 r1, r2;
#pragma unroll
                    for (int j = 0; j < 4; ++j) { r1[j] = __shfl(av[j], src1); r2[j] = __shfl(av[j], src2); }
                    f32x4 x1, x2;
                    if (!sample) {
                        x1 = fr == 0 ? p1[n] : r1; x2 = fr < 2 ? p2[n] : r2;
                        if (m == 0 && fr < 2) { float* sf = sideFirst + ((size_t)(blk * 2 + fr) * 2) * DFF_ + cch + 4 * n; *(f32x4*)sf = av; *(f32x4*)(sf + DFF_) = bv; }
                        if (m == 3 && fr >= 14) *(f32x4*)(sideLast + (size_t)(blk * 2 + fr - 14) * DFF_ + cch + 4 * n) = av;
                    } else {
                        const f32x4 s0 = *(const f32x4*)(stf + ((size_t)sq * 2 + 0) * DFF_ + cch + 4 * n), s1 = *(const f32x4*)(stf + ((size_t)sq * 2 + 1) * DFF_ + cch + 4 * n);
                        x1 = t4 >= 1 ? r1 : s1; x2 = t4 >= 2 ? r2 : (t4 == 1 ? s1 : s0);
                        if (t4 >= 2) *(f32x4*)(out_fs + ((size_t)sq * 2 + (t4 - 2)) * DFF_ + cch + 4 * n) = av;
                    }
                    p1[n] = r1; p2[n] = r2;
                    const f32x4 cv = w0[n] * x2 + w1[n] * x1 + w2[n] * av + bs[n];
                    const f32x2 g0 = gelu_pk((f32x2){cv[0], cv[1]}), g1 = gelu_pk((f32x2){cv[2], cv[3]});
                    const unsigned lo = cvt_pk_bf16(g0.x * bv[0], g0.y * bv[1]), hi = cvt_pk_bf16(g1.x * bv[2], g1.y * bv[3]);
                    if (n == 0) { wout.x = lo; wout.y = hi; } else { wout.z = lo; wout.w = hi; }
                }
                *(u32x4*)(ACT + (size_t)row * DFF_ + cch) = wout;
            }
        }
    }
};
template <class Epi, class Sched, bool ALIGN_EPI = false, bool SP2 = false>
__device__ __forceinline__ void gemm_phase(PG8_LAS unsigned char* lds, const Gemm g, const Sched& S, const Epi& E) {
    int tid_ = threadIdx.x; asm volatile("" : "+v"(tid_));
    const int tid = tid_, wid = __builtin_amdgcn_readfirstlane(tid >> 6), lane = tid & 63, wr = wid >> 2, wc = wid & 3, fr = lane & 15, fq = lane >> 4;
    const int K = g.K, nt = K / BK;
    unsigned voffA[2], voffB[2];
#pragma unroll
    for (int i = 0; i < 2; ++i) { int R, C; stage_rc(tid * 16 + i * 8192, R, C); const int Rb = Epi::PERM ? ((R & ~31) + perm32(R & 31)) : R;
        voffA[i] = (unsigned)(R * g.lda + C) * 2u; voffB[i] = (unsigned)(Rb * K + C) * 2u; }
    const size_t kstep = (size_t)(BK * 2);
    const size_t hA = (size_t)HALF * g.lda * 2, hB = (size_t)HALF * K * 2;
    const size_t tA = 2 * hA, tB = 2 * hB;
    const unsigned ldsw = (unsigned)wid * 1024u;
    const int aoff = lds_byte(wr * 64 + fr, fq * 8), boff = lds_byte(wc * 32 + fr, fq * 8);
#define PG8_SA(b, h) (((b) * 2 + (h)) * HTB)
#define PG8_SB(b, h) ((4 + (b) * 2 + (h)) * HTB)
#define PG8_STAGE(bufoff, gbase, voff) do { _Pragma("unroll") for (int _i = 0; _i < 2; ++_i) \
        __builtin_amdgcn_global_load_lds((const unsigned*)((const char*)(gbase) + (voff)[_i]), (PG8_LAS unsigned*)(lds + (bufoff) + ldsw + _i * 8192), 16, 0, 0); } while (0)
#define PG8_LDA(dst, b, h) do { _Pragma("unroll") for (int m = 0; m < 4; ++m) _Pragma("unroll") for (int k = 0; k < 2; ++k) dst[m][k] = *(const PG8_LAS bf16x8*)(lds + PG8_SA(b, h) + aoff + m * 2048 + k * 1024); } while (0)
#define PG8_LDB(dst, b, h) do { _Pragma("unroll") for (int n = 0; n < 2; ++n) _Pragma("unroll") for (int k = 0; k < 2; ++k) dst[n][k] = *(const PG8_LAS bf16x8*)(lds + PG8_SB(b, h) + boff + n * 2048 + k * 1024); } while (0)
#define PG8_MMA(ai, bj, At, Bt) do { __builtin_amdgcn_s_setprio(1); _Pragma("unroll") for (int m = 0; m < 4; ++m) _Pragma("unroll") for (int n = 0; n < 2; ++n) _Pragma("unroll") for (int k = 0; k < 2; ++k) \
        acc[ai][bj][m][n] = __builtin_amdgcn_mfma_f32_16x16x32_bf16(Bt[n][k], At[m][k], acc[ai][bj][m][n], 0, 0, 0); __builtin_amdgcn_s_setprio(0); } while (0)
#define PG8_WAIT_V(n) asm volatile("s_waitcnt vmcnt(" #n ")" ::: "memory")
#define PG8_WAIT_L(n) asm volatile("s_waitcnt lgkmcnt(" #n ")" ::: "memory")
#define PG8_BAR __builtin_amdgcn_s_barrier()
#define PG8_SCHED __builtin_amdgcn_sched_barrier(0)
    Unit cur, nxt; int ui = 0;
    if (!S.next(0, cur)) return;
    f32x4 acc[2][2][4][2];
#pragma unroll
    for (int a = 0; a < 2; ++a)
#pragma unroll
        for (int b = 0; b < 2; ++b)
#pragma unroll
            for (int m = 0; m < 4; ++m)
#pragma unroll
                for (int n = 0; n < 2; ++n) acc[a][b][m][n] = (f32x4){0.f, 0.f, 0.f, 0.f};
    bf16x8 At[4][2], B0[2][2], B1[2][2];
    const char* cA = (const char*)g.A + (size_t)cur.pm * tA; const char* cB = (const char*)g.Bt + (size_t)cur.pn * tB;
    S.a_ready(cur);
    if constexpr (SP2) {
        PG8_STAGE(PG8_SB(0, 0), cB, voffB); PG8_STAGE(PG8_SB(0, 1), cB + hB, voffB); PG8_STAGE(PG8_SA(0, 0), cA, voffA); PG8_STAGE(PG8_SA(0, 1), cA + hA, voffA);
        if (wr == 1) PG8_BAR;
        PG8_WAIT_V(2); PG8_BAR;
        PG8_STAGE(PG8_SB(1, 0), cB + kstep, voffB); PG8_STAGE(PG8_SA(1, 0), cA + kstep, voffA); PG8_STAGE(PG8_SB(1, 1), cB + hB + kstep, voffB);
        PG8_WAIT_V(6); PG8_BAR;
    } else {
        PG8_STAGE(PG8_SB(0, 0), cB, voffB); PG8_STAGE(PG8_SA(0, 0), cA, voffA); PG8_STAGE(PG8_SB(0, 1), cB + hB, voffB); PG8_STAGE(PG8_SA(0, 1), cA + hA, voffA);
        if (wr == 1) PG8_BAR;
        PG8_WAIT_V(4); PG8_BAR;
        PG8_STAGE(PG8_SB(1, 0), cB + kstep, voffB); PG8_STAGE(PG8_SA(1, 0), cA + kstep, voffA); PG8_STAGE(PG8_SB(1, 1), cB + hB + kstep, voffB);
        PG8_WAIT_V(6); PG8_BAR;
    }
    for (;;) {
        const bool has_next = S.next(ui + 1, nxt);
        const char* nA = has_next ? (const char*)g.A + (size_t)nxt.pm * tA : cA; const char* nB = has_next ? (const char*)g.Bt + (size_t)nxt.pn * tB : cB;
        for (int t = 0; t < nt; t += 2) {
            const bool last = (t == nt - 2);
            const char* a1 = cA + (size_t)(t + 1) * kstep;
            const char* a2 = last ? nA : cA + (size_t)(t + 2) * kstep; const char* b2 = last ? nB : cB + (size_t)(t + 2) * kstep;
            const char* a3 = a2 + kstep; const char* b3 = b2 + kstep;
            if (last && has_next) S.a_ready(nxt);
            if constexpr (SP2) {
            PG8_LDB(B0, 0, 0); PG8_LDB(B1, 0, 1); PG8_SCHED; PG8_LDA(At, 0, 0); PG8_STAGE(PG8_SA(1, 1), a1 + hA, voffA);
            PG8_WAIT_V(8); PG8_WAIT_L(0); PG8_BAR; PG8_MMA(0, 0, At, B0); PG8_MMA(0, 1, At, B1); PG8_BAR; PG8_SCHED;
            PG8_LDA(At, 0, 1); PG8_STAGE(PG8_SB(0, 0), b2, voffB); PG8_STAGE(PG8_SB(0, 1), b2 + hB, voffB); PG8_STAGE(PG8_SA(0, 0), a2, voffA);
            PG8_WAIT_V(8); PG8_WAIT_L(0); PG8_BAR; PG8_MMA(1, 0, At, B0); PG8_MMA(1, 1, At, B1); PG8_BAR; PG8_SCHED;
            PG8_LDB(B0, 1, 0); PG8_LDB(B1, 1, 1); PG8_SCHED; PG8_LDA(At, 1, 0); PG8_STAGE(PG8_SA(0, 1), a2 + hA, voffA);
            PG8_WAIT_V(8); PG8_WAIT_L(0); PG8_BAR; PG8_MMA(0, 0, At, B0); PG8_MMA(0, 1, At, B1); PG8_BAR; PG8_SCHED;
            PG8_LDA(At, 1, 1); PG8_STAGE(PG8_SB(1, 0), b3, voffB); PG8_STAGE(PG8_SB(1, 1), b3 + hB, voffB); PG8_STAGE(PG8_SA(1, 0), a3, voffA);
            PG8_WAIT_V(8); PG8_WAIT_L(0); PG8_BAR; PG8_MMA(1, 0, At, B0); PG8_MMA(1, 1, At, B1); PG8_BAR; PG8_SCHED;
            } else {
            PG8_LDB(B0, 0, 0); PG8_SCHED; PG8_LDA(At, 0, 0); PG8_STAGE(PG8_SA(1, 1), a1 + hA, voffA);
            PG8_WAIT_L(8); PG8_BAR; PG8_WAIT_L(0); PG8_MMA(0, 0, At, B0); PG8_BAR; PG8_SCHED;
            PG8_LDB(B1, 0, 1); PG8_STAGE(PG8_SB(0, 0), b2, voffB);
            PG8_BAR; PG8_WAIT_L(0); PG8_MMA(0, 1, At, B1); PG8_BAR;
            PG8_LDA(At, 0, 1); PG8_STAGE(PG8_SA(0, 0), a2, voffA);
            PG8_BAR; PG8_WAIT_L(0); PG8_MMA(1, 0, At, B0); PG8_BAR; PG8_SCHED;
            PG8_STAGE(PG8_SB(0, 1), b2 + hB, voffB);
            PG8_WAIT_V(6); PG8_BAR; PG8_MMA(1, 1, At, B1); PG8_BAR;
            PG8_LDB(B0, 1, 0); PG8_SCHED; PG8_LDA(At, 1, 0); PG8_STAGE(PG8_SA(0, 1), a2 + hA, voffA);
            PG8_WAIT_L(8); PG8_BAR; PG8_WAIT_L(0); PG8_MMA(0, 0, At, B0); PG8_BAR; PG8_SCHED;
            PG8_LDB(B1, 1, 1); PG8_STAGE(PG8_SB(1, 0), b3, voffB);
            PG8_BAR; PG8_WAIT_L(0); PG8_MMA(0, 1, At, B1); PG8_BAR;
            PG8_LDA(At, 1, 1); PG8_STAGE(PG8_SA(1, 0), a3, voffA);
            PG8_BAR; PG8_WAIT_L(0); PG8_MMA(1, 0, At, B0); PG8_BAR; PG8_SCHED;
            PG8_STAGE(PG8_SB(1, 1), b3 + hB, voffB);
            PG8_WAIT_V(6); PG8_BAR; PG8_MMA(1, 1, At, B1); PG8_BAR;
            }
        }
        if constexpr (ALIGN_EPI) { if (wr == 0) PG8_BAR; }
        if constexpr (!Epi::AFTER_DRAIN) { E(acc, cur, wr, wc, fr, fq); S.done(cur); }
        if (!has_next) break;
#pragma unroll
        for (int a = 0; a < 2; ++a)
#pragma unroll
            for (int b = 0; b < 2; ++b)
#pragma unroll
                for (int m = 0; m < 4; ++m)
#pragma unroll
                    for (int n = 0; n < 2; ++n) acc[a][b][m][n] = (f32x4){0.f, 0.f, 0.f, 0.f};
        cur = nxt; cA = nA; cB = nB; ++ui;
        if constexpr (ALIGN_EPI) { if (wr == 1) PG8_BAR; }
    }
    PG8_WAIT_V(0);
    if constexpr (!ALIGN_EPI) { if (wr == 0) PG8_BAR; }
    PG8_BAR;
    if constexpr (Epi::AFTER_DRAIN) { E.fused(acc, cur, wr, wc, fr, fq, lds, wid, lane); S.done(cur); }
#undef PG8_SA
#undef PG8_SB
#undef PG8_STAGE
#undef PG8_LDA
#undef PG8_LDB
#undef PG8_MMA
#undef PG8_WAIT_V
#undef PG8_WAIT_L
#undef PG8_BAR
#undef PG8_SCHED
}
}

constexpr int DM = 1024, NBP = 8, SEQ = 2048, NBS = 128, TS = 4, MP = NBP * SEQ, MS = NBS * TS, MT = MP + MS;
constexpr int NIN = 6144, DFF = 2816, NUP = 2 * DFF, CAW = 31, HB = 8;
constexpr float EPS = 1e-6f;
constexpr int NWAVES = 8, NTHR = 512;
constexpr size_t O_Y = 0, O_CAP = (size_t)MT * DM, O_CAS = O_CAP + (size_t)NBP * 30 * DM, O_VS = O_CAS + (size_t)NBS * 30 * DM, O_FP = O_VS + (size_t)MS * DM, O_FS = O_FP + (size_t)NBP * 2 * DFF, O_END = O_FS + (size_t)NBS * 2 * DFF;
constexpr size_t MiB = 1u << 20;
constexpr size_t WS_SS1 = 0, WS_SS2 = 128 * 1024, WS_BAR = 512 * 1024;
constexpr size_t WS_WUP = 1 * MiB, WS_WDN = 12 * MiB, WS_WIN = 18 * MiB, WS_WA = 30 * MiB, WS_WB = 32 * MiB, WS_WO = 34 * MiB;
constexpr size_t WS_XN = 36 * MiB;
constexpr size_t WS_GLU = 69 * MiB, WS_UV = 102 * MiB, WS_GG = 168 * MiB;
constexpr size_t WS_MG = WS_GLU;
constexpr size_t WS_ACT = WS_GLU;
constexpr size_t WS_SL = 192 * MiB, WS_SF = 200 * MiB;
constexpr size_t WS_END = WS_SF + (size_t)256 * 4 * DFF * 4;
static_assert(WS_ACT + (size_t)MT * DFF * 2 <= WS_SL && WS_SL + (size_t)256 * 2 * DFF * 4 <= WS_SF && WS_END <= 256 * MiB && WS_GG + (size_t)MT * 2048 * 2 <= 256 * MiB, "d_ws map");
constexpr int LDS_BYTES = 147456;

#define LAS __attribute__((address_space(3)))
typedef unsigned short bf16;
typedef unsigned v4u __attribute__((ext_vector_type(4)));
typedef unsigned v2u __attribute__((ext_vector_type(2)));
typedef float f32x4 __attribute__((ext_vector_type(4)));
typedef float f32x2 __attribute__((ext_vector_type(2)));
typedef short bf16x8 __attribute__((ext_vector_type(8)));
#define LDS_WAIT() asm volatile("s_waitcnt lgkmcnt(0)" ::: "memory")
__device__ __forceinline__ unsigned f2bf(float f) { unsigned u = __builtin_bit_cast(unsigned, f); return (u + 0x7fffu + ((u >> 16) & 1u)) >> 16; }
__device__ __forceinline__ unsigned pk2(float lo, float hi) { return f2bf(lo) | (f2bf(hi) << 16); }
__device__ __forceinline__ float blo(unsigned u) { return __uint_as_float(u << 16); }
__device__ __forceinline__ float bhi(unsigned u) { return __uint_as_float(u & 0xffff0000u); }
__device__ __forceinline__ float sigmf(float x) { return __builtin_amdgcn_rcpf(1.0f + __builtin_amdgcn_exp2f(x * -1.44269504089f)); }
__device__ __forceinline__ float wave_sum(float v) {
#pragma unroll
    for (int o = 1; o < 64; o <<= 1) v += __shfl_xor(v, o);
    return v;
}

struct Args { const float* in[23]; float* out; unsigned char* ws; };
struct Frame { LAS unsigned char* lds; int tid, lane, wave, vcu, G; };
__device__ __forceinline__ Frame phase_frame(const Frame& F0) { Frame F = F0; int t = F0.tid; asm volatile("" : "+v"(t)); F.tid = t; F.lane = t & 63; return F; }

#define XB_TMO      128
#define XB_XCNT(j)  (256  + 64 * (j))
#define XB_XSUB(j)  (1280 + 64 * (j))
#define XB_XGEN(j)  (2304 + 64 * (j))
#define XB_TOP      3328
#define XB_TOPGEN   3392
#define XCD_BAR_WORDS 3456
#define XB_SPIN_CAP (1u << 18)

__device__ __forceinline__ unsigned xb_ld(unsigned* p)              { return __hip_atomic_load(p, __ATOMIC_RELAXED, __HIP_MEMORY_SCOPE_AGENT); }
__device__ __forceinline__ unsigned xb_add(unsigned* p, unsigned v) { return __hip_atomic_fetch_add(p, v, __ATOMIC_RELAXED, __HIP_MEMORY_SCOPE_AGENT); }
__device__ __forceinline__ unsigned xb_xcc_id() { return (unsigned)__builtin_amdgcn_s_getreg((3 << 11) | 20) & 0xFu; }
#define XB_SPIN(cond, bar) do { unsigned _sp = 0; while (cond) { __builtin_amdgcn_s_sleep(1); \
    if ((++_sp & 255u) == 0u) { if (xb_ld(&(bar)[XB_TMO])) break; if (_sp > XB_SPIN_CAP) { atomicAdd(&(bar)[XB_TMO], 1u); break; } } } } while (0)

struct XcdBarrier {
    unsigned* bar; unsigned x;
    volatile LAS unsigned* st;
};

__device__ __forceinline__ XcdBarrier xcd_barrier_post(unsigned* bar, volatile LAS unsigned* st) {
    XcdBarrier b; b.bar = bar; b.x = xb_xcc_id(); b.st = st;
    if (threadIdx.x == 0) (void)xb_add(&bar[XB_XCNT(b.x)], 1u);
    return b;
}
__device__ __forceinline__ void xcd_barrier_complete(unsigned* bar, unsigned x, unsigned& nloc, unsigned& nx) {
    const unsigned G = gridDim.x * gridDim.y * gridDim.z;
    unsigned sum, cnt, mine, sp = 0u;
    for (;;) {
        sum = 0u; cnt = 0u; mine = 0u;
#pragma unroll
        for (unsigned j = 0; j < 16; ++j) { const unsigned c = xb_ld(&bar[XB_XCNT(j)]); sum += c; cnt += (c > 0u) ? 1u : 0u; mine = (j == x) ? c : mine; }
        if (sum == G) break;
        __builtin_amdgcn_s_sleep(1);
        if ((++sp & 255u) == 0u) { if (xb_ld(&bar[XB_TMO])) break; if (sp > XB_SPIN_CAP) { atomicAdd(&bar[XB_TMO], 1u); break; } }
    }
    nloc = mine > 0u ? mine : 1u; nx = cnt > 0u ? cnt : 1u;
}

__device__ __forceinline__ void xcd_barrier(const XcdBarrier& b) {
    asm volatile("s_waitcnt vmcnt(0)" ::: "memory");
    __syncthreads();
    if (threadIdx.x == 0) {
        unsigned* bar = b.bar;
        __builtin_amdgcn_s_waitcnt(0);
        unsigned nloc = b.st[0], nx = b.st[1];
        if (nloc == 0u) { xcd_barrier_complete(bar, b.x, nloc, nx); b.st[0] = nloc; b.st[1] = nx; }
        const unsigned old = xb_add(&bar[XB_XSUB(b.x)], 1u);
        const unsigned gen = old / nloc;
        if (old + 1u == (gen + 1u) * nloc) {
            __builtin_amdgcn_fence(__ATOMIC_RELEASE, "agent");
            asm volatile("s_waitcnt vmcnt(0)" ::: "memory");
            const unsigned og = xb_add(&bar[XB_TOP], 1u);
            const unsigned tg = og / nx;
            if (og + 1u == (tg + 1u) * nx) xb_add(&bar[XB_TOPGEN], 1u);
            else XB_SPIN(xb_ld(&bar[XB_TOPGEN]) == tg, bar);
            __builtin_amdgcn_fence(__ATOMIC_ACQUIRE, "agent");
            xb_add(&bar[XB_XGEN(b.x)], 1u);
            asm volatile("s_waitcnt vmcnt(0)" ::: "memory");
        } else {
            XB_SPIN(xb_ld(&bar[XB_XGEN(b.x)]) == gen, bar);
            __builtin_amdgcn_fence(__ATOMIC_ACQUIRE, "agent");
            asm volatile("s_waitcnt vmcnt(0)" ::: "memory");
        }
    }
    __syncthreads();
}

__device__ __forceinline__ void p0_transpose_item(const float* W, int K, int N, bf16* WT, int mode, const float* kscale, LAS float* scr, int item, int lane) {
    const int nblk = N / 32, kb = item / nblk, nb = item % nblk, k0 = 64 * kb, n0 = 32 * nb;
#pragma unroll 8
    for (int i = 0; i < 32; ++i) { const int kk = 2 * i + (lane >> 5); float v = W[(size_t)(k0 + kk) * N + n0 + (lane & 31)]; if (kscale) v *= kscale[k0 + kk]; scr[kk * 33 + (lane & 31)] = v; }
    LDS_WAIT(); asm volatile("" ::: "memory");
    int n0m = n0;
    if (mode == 1 && n0 < 2048) { const int half = n0 >= 1024 ? 1 : 0, ch = n0 - 1024 * half; n0m = 256 * (ch >> 7) + 128 * half + (ch & 127); }
    if (mode == 2) { const int half = n0 >= 2816 ? 1 : 0, ch = n0 - 2816 * half; n0m = 256 * (ch >> 7) + 128 * half + (ch & 127); }
    const int c = lane & 7;
#pragma unroll
    for (int j = 0; j < 4; ++j) { const int n = (lane >> 3) + 8 * j; const LAS float* s = scr + (8 * c) * 33 + n;
        v4u o; o.x = pk2(s[0 * 33], s[1 * 33]); o.y = pk2(s[2 * 33], s[3 * 33]); o.z = pk2(s[4 * 33], s[5 * 33]); o.w = pk2(s[6 * 33], s[7 * 33]);
        *(v4u*)(WT + (size_t)(n0m + n) * K + k0 + 8 * c) = o; }
    LDS_WAIT(); asm volatile("" ::: "memory");
}
__device__ __forceinline__ void rms_row_to_bf16(const float* xrow, const float* g, bf16* orow, int lane) {
    const f32x4* xr = (const f32x4*)xrow + lane; const f32x4* gr = (const f32x4*)g + lane;
    f32x4 v[4]; float s = 0.f;
#pragma unroll
    for (int j = 0; j < 4; ++j) { v[j] = xr[64 * j]; s += (v[j].x * v[j].x + v[j].y * v[j].y) + (v[j].z * v[j].z + v[j].w * v[j].w); }
    const float rstd = 1.0f / sqrtf(wave_sum(s) * (1.f / DM) + EPS);
    unsigned long long* o8 = (unsigned long long*)orow + lane;
#pragma unroll
    for (int j = 0; j < 4; ++j) { const f32x4 gg = gr[64 * j]; o8[64 * j] = (unsigned long long)pk2(v[j].x * rstd * gg.x, v[j].y * rstd * gg.y) | ((unsigned long long)pk2(v[j].z * rstd * gg.z, v[j].w * rstd * gg.w) << 32); }
}
__device__ __forceinline__ void p0_prologue(const Frame& F0, const Args& a) {
    const Frame F = phase_frame(F0);
    unsigned char* ws = a.ws;
    LAS float* scr = (LAS float*)(F.lds + F.wave * 16384);
    const int gw = F.vcu * NWAVES + F.wave, NGW = F.G * NWAVES;
    constexpr int I_IN = (DM / 64) * (NIN / 32), I_SQ = (DM / 64) * (DM / 32), I_UP = (DM / 64) * (NUP / 32), I_DN = (DFF / 64) * (DM / 32);
    constexpr int NITEMS = I_IN + 3 * I_SQ + I_UP + I_DN;
    for (int it = gw; it < NITEMS; it += NGW) {
        int r = it;
        if (r < I_IN) { p0_transpose_item(a.in[5], DM, NIN, (bf16*)(ws + WS_WIN), 1, nullptr, scr, r, F.lane); continue; } r -= I_IN;
        if (r < I_SQ) { p0_transpose_item(a.in[10], DM, DM, (bf16*)(ws + WS_WA), 0, nullptr, scr, r, F.lane); continue; } r -= I_SQ;
        if (r < I_SQ) { p0_transpose_item(a.in[15], DM, DM, (bf16*)(ws + WS_WB), 0, nullptr, scr, r, F.lane); continue; } r -= I_SQ;
        if (r < I_SQ) { p0_transpose_item(a.in[16], DM, DM, (bf16*)(ws + WS_WO), 0, nullptr, scr, r, F.lane); continue; } r -= I_SQ;
        if (r < I_UP) { p0_transpose_item(a.in[18], DM, NUP, (bf16*)(ws + WS_WUP), 2, a.in[17], scr, r, F.lane); continue; } r -= I_UP;
        p0_transpose_item(a.in[21], DFF, DM, (bf16*)(ws + WS_WDN), 0, nullptr, scr, r, F.lane);
    }
    bf16* XN = (bf16*)(ws + WS_XN);
    for (int m = gw; m < MT; m += NGW) {
        const float* xr = m < MP ? a.in[0] + (size_t)m * DM : a.in[1] + (size_t)(m - MP) * DM;
        rms_row_to_bf16(xr, a.in[4], XN + (size_t)m * DM, F.lane);
    }
    float* ss = (float*)(ws + WS_SS1);
    for (int i = F.vcu * NTHR + F.tid; i < (int)(2 * WS_SS2 / 4); i += F.G * NTHR) ss[i] = 0.f;

}

__device__ __forceinline__ void ln_silu_row(const LAS float* src, bf16* dst, const float* g, const float* bt, int lane) {
    f32x4 v[4]; float s = 0.f;
#pragma unroll
    for (int j = 0; j < 4; ++j) { v[j] = *(const LAS f32x4*)(src + 4 * lane + 256 * j); s += (v[j].x + v[j].y) + (v[j].z + v[j].w); }
    const float mean = wave_sum(s) * (1.f / DM); float s2 = 0.f;
#pragma unroll
    for (int j = 0; j < 4; ++j) { v[j] = v[j] - mean; s2 += (v[j].x * v[j].x + v[j].y * v[j].y) + (v[j].z * v[j].z + v[j].w * v[j].w); }
    const float rstd = 1.0f / sqrtf(wave_sum(s2) * (1.f / DM) + EPS);
#pragma unroll
    for (int j = 0; j < 4; ++j) { const f32x4 gg = *(const f32x4*)(g + 4 * lane + 256 * j), bb = *(const f32x4*)(bt + 4 * lane + 256 * j);
        f32x4 y = v[j] * rstd * gg + bb; y = (f32x4){y.x * sigmf(y.x), y.y * sigmf(y.y), y.z * sigmf(y.z), y.w * sigmf(y.w)};
        v2u w; w.x = pk2(y.x, y.y); w.y = pk2(y.z, y.w); *(v2u*)(dst + 4 * lane + 256 * j) = w; }
}
__device__ __forceinline__ void convA_prompt(const Frame& F0, const Args& a, const unsigned* G32, bf16* ACTA, size_t grow0, bool has_hist, float* capout) {
    const Frame F = phase_frame(F0);
    const int c0 = 2 * F.tid;
    LAS float* CB = (LAS float*)F.lds;
    const float* dw = a.in[6];
    f32x2 w[CAW];
#pragma unroll
    for (int k = 0; k < CAW; ++k) w[k] = *(const f32x2*)(dw + k * DM + c0);
    const f32x2 bias = *(const f32x2*)(a.in[7] + c0);
    f32x2 ring[32];
#pragma unroll
    for (int j = 0; j < 32; ++j) ring[j] = (f32x2){0.f, 0.f};
    if (has_hist) {
        const unsigned* hp = G32 + (grow0 - 30) * 512 + F.tid;
#pragma unroll
        for (int j = 0; j < 30; ++j) { const unsigned u = hp[(size_t)j * 512]; ring[2 + j] = (f32x2){blo(u), bhi(u)}; }
    }
    for (int base = 0; base < 64; base += 32) {
        const unsigned* gp = G32 + (grow0 + base) * 512 + F.tid;
#pragma unroll
        for (int jg = 0; jg < 32; jg += 8) {
            unsigned tmp[8];
#pragma unroll
            for (int jj = 0; jj < 8; ++jj) tmp[jj] = gp[(size_t)(jg + jj) * 512];
#pragma unroll
            for (int jj = 0; jj < 8; ++jj) {
                const int j = jg + jj;
                const f32x2 nv = (f32x2){blo(tmp[jj]), bhi(tmp[jj])};
                ring[j] = nv;
                f32x2 o = bias;
#pragma unroll
                for (int k = 0; k < CAW; ++k) o += ring[(j + k + 2) & 31] * w[k];
                *(LAS f32x2*)(CB + j * DM + c0) = o;
            }
            __builtin_amdgcn_sched_barrier(0);
        }
        if (capout && base == 32) {
#pragma unroll
            for (int j = 2; j < 32; ++j) *(f32x2*)(capout + (size_t)(j - 2) * DM + c0) = ring[j];
        }
        __syncthreads();
#pragma unroll 1
        for (int r = F.wave; r < 32; r += NWAVES) ln_silu_row(CB + r * DM, ACTA + (grow0 + base + r) * DM, a.in[8], a.in[9], F.lane);
        __syncthreads();
    }
}
__device__ __forceinline__ void convA_sample(const Frame& F0, const Args& a, const unsigned* G32, bf16* ACTA, int s, const float* hst, float* casout) {
    const Frame F = phase_frame(F0);
    const int c0 = 2 * F.tid;
    LAS float* CB = (LAS float*)F.lds;
    const float* dw = a.in[6];
    f32x2 w[CAW];
#pragma unroll
    for (int k = 0; k < CAW; ++k) w[k] = *(const f32x2*)(dw + k * DM + c0);
    const f32x2 bias = *(const f32x2*)(a.in[7] + c0);
    f32x2 o[4] = {bias, bias, bias, bias};
    const size_t grow0 = (size_t)MP + 4 * s;
#pragma unroll
    for (int i = 0; i < 34; ++i) {
        f32x2 x;
        if (i < 30) x = *(const f32x2*)(hst + i * DM + c0);
        else { const unsigned u = G32[(grow0 + (i - 30)) * 512 + F.tid]; x = (f32x2){blo(u), bhi(u)}; }
        if (i >= 4) *(f32x2*)(casout + (i - 4) * DM + c0) = x;
#pragma unroll
        for (int t = 0; t < 4; ++t) { const int k = i - t; if (k >= 0 && k < CAW) o[t] += x * w[k]; }
    }
#pragma unroll
    for (int t = 0; t < 4; ++t) *(LAS f32x2*)(CB + t * DM + c0) = o[t];
    __syncthreads();
    if (F.wave < 4) ln_silu_row(CB + F.wave * DM, ACTA + (grow0 + F.wave) * DM, a.in[8], a.in[9], F.lane);
    __syncthreads();
}

__device__ __forceinline__ void ln_stats16(const bf16* vrow, int lane, float (&x)[16], float& mean, float& rstd) {
    const v4u p = *(const v4u*)(vrow + 8 * lane), q = *(const v4u*)(vrow + 512 + 8 * lane);
    x[0] = blo(p.x); x[1] = bhi(p.x); x[2] = blo(p.y); x[3] = bhi(p.y); x[4] = blo(p.z); x[5] = bhi(p.z); x[6] = blo(p.w); x[7] = bhi(p.w);
    x[8] = blo(q.x); x[9] = bhi(q.x); x[10] = blo(q.y); x[11] = bhi(q.y); x[12] = blo(q.z); x[13] = bhi(q.z); x[14] = blo(q.w); x[15] = bhi(q.w);
    float s = 0.f;
#pragma unroll
    for (int i = 0; i < 16; ++i) s += x[i];
    mean = wave_sum(s) * (1.f / DM); float s2 = 0.f;
#pragma unroll
    for (int i = 0; i < 16; ++i) { const float d = x[i] - mean; s2 += d * d; }
    rstd = 1.0f / sqrtf(wave_sum(s2) * (1.f / DM) + EPS);
}
constexpr int VT_LD = 130, WT_LD = 136;
constexpr int MB_STAT = 0, MB_VT = 1024, MB_WT = MB_VT + 128 * VT_LD * 2 + 64;
static_assert(MB_WT % 16 == 0 && MB_WT + 128 * WT_LD * 2 <= 131072, "mixer-B LDS map");
__device__ __forceinline__ void mixB_prompt(const Frame& F0, const Args& a, bf16* UV, int ch, int hh) {
    const Frame F = phase_frame(F0);
    const size_t R0 = (size_t)ch * 128;
    LAS f32x2* STAT = (LAS f32x2*)(F.lds + MB_STAT);
    LAS unsigned char* VT = F.lds + MB_VT; LAS unsigned char* WT = F.lds + MB_WT;
    const float* lng = a.in[11]; const float* lnb = a.in[12]; const float* w_s = a.in[13]; const float* b_s = a.in[14];
    for (int i = 0; i < 16; ++i) { const int r = F.wave * 16 + i; float x[16], mean, rstd; ln_stats16(UV + (R0 + r) * 2048 + 1024, F.lane, x, mean, rstd); if (F.lane == 0) STAT[r] = (f32x2){mean, rstd}; }
    __syncthreads();
    const int lr = F.lane & 15, lq = F.lane >> 4;
    for (int hq = 0; hq < 4; ++hq) {
        const int h = hh * 4 + hq;
#pragma unroll
        for (int i = 0; i < 4; ++i) { const int idx = F.tid + NTHR * i, r = idx >> 4, cgp = idx & 15, c = h * 128 + cgp * 8;
            const v4u p = *(const v4u*)(UV + (R0 + r) * 2048 + 1024 + c); const f32x2 st = STAT[r];
            const f32x4 g0 = *(const f32x4*)(lng + c), g1 = *(const f32x4*)(lng + c + 4), b0 = *(const f32x4*)(lnb + c), b1 = *(const f32x4*)(lnb + c + 4);
            LAS unsigned* dst = (LAS unsigned*)(VT + (r * VT_LD + cgp * 8) * 2);
            dst[0] = pk2((blo(p.x) - st.x) * st.y * g0.x + b0.x, (bhi(p.x) - st.x) * st.y * g0.y + b0.y);
            dst[1] = pk2((blo(p.y) - st.x) * st.y * g0.z + b0.z, (bhi(p.y) - st.x) * st.y * g0.w + b0.w);
            dst[2] = pk2((blo(p.z) - st.x) * st.y * g1.x + b1.x, (bhi(p.z) - st.x) * st.y * g1.y + b1.y);
            dst[3] = pk2((blo(p.w) - st.x) * st.y * g1.z + b1.z, (bhi(p.w) - st.x) * st.y * g1.w + b1.w); }
#pragma unroll
        for (int i = 0; i < 8; ++i) { const int idx = F.tid + NTHR * i, t = idx >> 5, sg = idx & 31;
            const f32x4 wv = *(const f32x4*)(w_s + ((size_t)h * 128 + t) * 128 + sg * 4); const int s0 = sg * 4;
            v2u o; o.x = pk2(s0 <= t ? wv.x : 0.f, s0 + 1 <= t ? wv.y : 0.f); o.y = pk2(s0 + 2 <= t ? wv.z : 0.f, s0 + 3 <= t ? wv.w : 0.f);
            *(LAS v2u*)(WT + (t * WT_LD + s0) * 2) = o; }
        __syncthreads();
        bf16x8 af[4];
#pragma unroll
        for (int ks = 0; ks < 4; ++ks) {
#pragma unroll
            for (int kk = 0; kk < 8; ++kk) af[ks][kk] = (short)*(const LAS unsigned short*)(VT + ((32 * ks + 8 * lq + kk) * VT_LD + 16 * F.wave + lr) * 2);
        }
#pragma unroll
        for (int tb = 0; tb < 8; ++tb) {
            f32x4 acc = (f32x4){0.f, 0.f, 0.f, 0.f};
#pragma unroll
            for (int ks = 0; ks < 4; ++ks) {
                if (32 * ks <= 16 * tb + 15) {
                    const bf16x8 bfr = *(const LAS bf16x8*)(WT + ((16 * tb + lr) * WT_LD + 32 * ks + 8 * lq) * 2);
                    acc = __builtin_amdgcn_mfma_f32_16x16x32_bf16(af[ks], bfr, acc, 0, 0, 0);
                }
            }
            const int t = 16 * tb + lr, c = h * 128 + 16 * F.wave + 4 * lq;
            bf16* up = UV + (R0 + t) * 2048 + c;
            const v2u uu = *(const v2u*)up; const float bsv = b_s[h * 128 + t];
            v2u o; o.x = pk2(blo(uu.x) * (acc[0] + bsv), bhi(uu.x) * (acc[1] + bsv)); o.y = pk2(blo(uu.y) * (acc[2] + bsv), bhi(uu.y) * (acc[3] + bsv));
            *(v2u*)up = o;
        }
        __syncthreads();
    }
}
__device__ __forceinline__ void mixB_sample(const Frame& F0, const Args& a, bf16* UV, int s, float* out_vs) {
    const Frame F = phase_frame(F0);
    LAS float* SV = (LAS float*)F.lds;
    const float* lng = a.in[11]; const float* lnb = a.in[12]; const float* w_s = a.in[13]; const float* b_s = a.in[14];
    const size_t R0 = (size_t)MP + 4 * s;
    if (F.wave < 4) {
        const int t = F.wave; float x[16], mean, rstd; ln_stats16(UV + (R0 + t) * 2048 + 1024, F.lane, x, mean, rstd);
#pragma unroll
        for (int hf = 0; hf < 2; ++hf) { const int c = 512 * hf + 8 * F.lane;
#pragma unroll
            for (int q = 0; q < 2; ++q) { const f32x4 g = *(const f32x4*)(lng + c + 4 * q), b = *(const f32x4*)(lnb + c + 4 * q);
                const f32x4 xv = (f32x4){x[8 * hf + 4 * q], x[8 * hf + 4 * q + 1], x[8 * hf + 4 * q + 2], x[8 * hf + 4 * q + 3]};
                const f32x4 y = (xv - mean) * rstd * g + b;
                *(f32x4*)(out_vs + ((size_t)4 * s + t) * DM + c + 4 * q) = y; *(LAS f32x4*)(SV + t * DM + c + 4 * q) = y; } }
    }
    __syncthreads();
    const int c0 = 2 * F.tid, h = c0 >> 7;
#pragma unroll
    for (int t = 0; t < 4; ++t) {
        const float bsv = b_s[h * 128 + t]; float s0 = bsv, s1 = bsv;
#pragma unroll
        for (int sp = 0; sp <= t; ++sp) { const float wv = w_s[((size_t)h * 128 + t) * 128 + sp]; const f32x2 vv = *(const LAS f32x2*)(SV + sp * DM + c0); s0 += wv * vv.x; s1 += wv * vv.y; }
        unsigned* up = (unsigned*)(UV + (R0 + t) * 2048 + c0); const unsigned uu = *up;
        *up = pk2(blo(uu) * s0, bhi(uu) * s1);
    }
    __syncthreads();
}

__device__ __forceinline__ void ld8f(const float* p, float (&x)[8]) { const f32x4 a = *(const f32x4*)p, b = *(const f32x4*)(p + 4); x[0] = a.x; x[1] = a.y; x[2] = a.z; x[3] = a.w; x[4] = b.x; x[5] = b.y; x[6] = b.z; x[7] = b.w; }
__device__ __forceinline__ void st8f(float* p, const float (&x)[8]) { *(f32x4*)p = (f32x4){x[0], x[1], x[2], x[3]}; *(f32x4*)(p + 4) = (f32x4){x[4], x[5], x[6], x[7]}; }
__device__ __forceinline__ void p6_fixup(const Frame& F0, const Args& a, float* out) {
    const Frame F = phase_frame(F0);
    bf16* ACT = (bf16*)(a.ws + WS_ACT); const float* SL = (const float*)(a.ws + WS_SL); const float* SF = (const float*)(a.ws + WS_SF);
    constexpr int NG = DFF / 8, NIT = 256 * 2 * NG;
    const float* dwf = a.in[19]; const float* bdw = a.in[20];
    for (int it = F.vcu * NTHR + F.tid; it < NIT; it += F.G * NTHR) {
        const int bi = it / NG, cgp = it - bi * NG, c = cgp * 8, blk = bi >> 1, i = bi & 1;
        if ((blk & 31) != 0) {
            float l0[8], l1[8], f0[8], f1[8], fb[8], w0[8], w1[8], w2[8], bs[8];
            ld8f(SL + ((size_t)(blk - 1) * 2 + 0) * DFF + c, l0); ld8f(SL + ((size_t)(blk - 1) * 2 + 1) * DFF + c, l1);
            ld8f(SF + ((size_t)(blk * 2 + 0) * 2 + 0) * DFF + c, f0); ld8f(SF + ((size_t)(blk * 2 + 1) * 2 + 0) * DFF + c, f1); ld8f(SF + ((size_t)(blk * 2 + i) * 2 + 1) * DFF + c, fb);
            ld8f(dwf + c, w0); ld8f(dwf + DFF + c, w1); ld8f(dwf + 2 * DFF + c, w2); ld8f(bdw + c, bs);
            float o[8];
#pragma unroll
            for (int j = 0; j < 8; j += 2) {
                const float x2a = i == 0 ? l0[j] : l1[j], x1a = i == 0 ? l1[j] : f0[j], x0a = i == 0 ? f0[j] : f1[j];
                const float x2b = i == 0 ? l0[j + 1] : l1[j + 1], x1b = i == 0 ? l1[j + 1] : f0[j + 1], x0b = i == 0 ? f0[j + 1] : f1[j + 1];
                f32x2 cv = (f32x2){x2a * w0[j] + x1a * w1[j] + x0a * w2[j] + bs[j], x2b * w0[j + 1] + x1b * w1[j + 1] + x0b * w2[j + 1] + bs[j + 1]};
                cv = pg8::gelu_pk(cv); o[j] = cv.x * fb[j]; o[j + 1] = cv.y * fb[j + 1]; }
            v4u w; w.x = pk2(o[0], o[1]); w.y = pk2(o[2], o[3]); w.z = pk2(o[4], o[5]); w.w = pk2(o[6], o[7]);
            *(v4u*)(ACT + ((size_t)blk * 64 + i) * DFF + c) = w;
        }
        if ((blk & 31) == 31) { float l[8]; ld8f(SL + ((size_t)blk * 2 + i) * DFF + c, l); st8f(out + O_FP + ((size_t)(blk >> 5) * 2 + i) * DFF + c, l); }
    }
}

struct SmallSrc { const bf16* A; int lda; const bf16* Bt; };
template <int NSRC, class Epi>
__device__ __forceinline__ void small_gemm(const Frame& F0, const SmallSrc (&src)[NSRC], int K, int N, const Epi& E) {
    const Frame F = phase_frame(F0);
    const int fr = F.lane & 15, fq = F.lane >> 4;
    const int ntn = N / 16, ntiles = (MS / 16) * ntn;
    for (int tile = F.vcu * NWAVES + F.wave; tile < ntiles; tile += F.G * NWAVES) {
        const int tm = tile / ntn, tn = tile - tm * ntn;
        f32x4 acc[NSRC];
#pragma unroll
        for (int sidx = 0; sidx < NSRC; ++sidx) {
            const bf16* ap = src[sidx].A + (size_t)(16 * tm + fr) * src[sidx].lda + 8 * fq;
            const bf16* bp = src[sidx].Bt + (size_t)(16 * tn + fr) * K + 8 * fq;
            f32x4 c = (f32x4){0.f, 0.f, 0.f, 0.f};
#pragma unroll 1
            for (int k = 0; k < K; k += 256) {
                bf16x8 af[8], bfm[8];
#pragma unroll
                for (int i = 0; i < 8; ++i) { af[i] = *(const bf16x8*)(ap + k + 32 * i); bfm[i] = *(const bf16x8*)(bp + k + 32 * i); }
#pragma unroll
                for (int i = 0; i < 8; ++i) c = __builtin_amdgcn_mfma_f32_16x16x32_bf16(bfm[i], af[i], c, 0, 0, 0);
            }
            acc[sidx] = c;
        }
        E(acc, 16 * tm + fr, 16 * tn + 4 * fq, fq);
    }
}
struct SEpiMerge {
    bf16* MG; const bf16* GG;
    __device__ __forceinline__ void operator()(const f32x4 (&acc)[2], int r, int c, int fq) const {
        const size_t row = (size_t)MP + r;
        const v2u ga = *(const v2u*)(GG + row * 2048 + c), gb = *(const v2u*)(GG + row * 2048 + 1024 + c);
        v2u o; o.x = pk2(blo(ga.x) * acc[0][0] + blo(gb.x) * acc[1][0], bhi(ga.x) * acc[0][1] + bhi(gb.x) * acc[1][1]);
        o.y = pk2(blo(ga.y) * acc[0][2] + blo(gb.y) * acc[1][2], bhi(ga.y) * acc[0][3] + bhi(gb.y) * acc[1][3]);
        *(v2u*)(MG + row * DM + c) = o;
    }
};
template <bool RB16> struct SEpiRes {
    const float* R; const bf16* RB; float* Y; bf16* YB; float* ss;
    __device__ __forceinline__ void operator()(const f32x4 (&acc)[1], int r, int c, int fq) const {
        const size_t off = (size_t)r * DM + c;
        f32x4 h;
        if (RB16) { const v2u p = *(const v2u*)(RB + off); h = (f32x4){blo(p.x), bhi(p.x), blo(p.y), bhi(p.y)} + acc[0]; *(f32x4*)(Y + off) = h; }
        else { h = *(const f32x4*)(R + off) + acc[0]; v2u w; w.x = pk2(h[0], h[1]); w.y = pk2(h[2], h[3]); *(v2u*)(YB + off) = w; }
        float sq = (h[0] * h[0] + h[1] * h[1]) + (h[2] * h[2] + h[3] * h[3]);
        sq += __shfl_xor(sq, 16); sq += __shfl_xor(sq, 32);
        if (fq == 0) atomicAdd(ss + r, sq);
    }
};

__global__ void __launch_bounds__(NTHR, 2) fwd_mega(Args a) {
    extern __shared__ __attribute__((aligned(16))) unsigned char lds_raw[];
    cg::grid_group grid = cg::this_grid();
    Frame F; F.lds = (LAS unsigned char*)lds_raw; F.tid = threadIdx.x; F.lane = F.tid & 63; F.wave = __builtin_amdgcn_readfirstlane(F.tid >> 6);
    F.G = gridDim.x; { const int bx = blockIdx.x; F.vcu = (F.G % 8 == 0) ? (bx % 8) * (F.G / 8) + bx / 8 : bx; }
    unsigned char* ws = a.ws; float* out = a.out;
    volatile LAS unsigned* bst = (volatile LAS unsigned*)(F.lds + 131072 + 64);
    if (F.tid < 2) bst[F.tid] = 0u;
    __syncthreads();
    bf16* XN = (bf16*)(ws + WS_XN); bf16* GLU = (bf16*)(ws + WS_GLU); bf16* UV = (bf16*)(ws + WS_UV); bf16* GG = (bf16*)(ws + WS_GG);
    bf16* MG = (bf16*)(ws + WS_MG); bf16* ACT = (bf16*)(ws + WS_ACT); bf16* ACTA = (bf16*)(out + O_Y);
    float* ss1 = (float*)(ws + WS_SS1); float* ss2 = (float*)(ws + WS_SS2);

    const XcdBarrier bar = xcd_barrier_post((unsigned*)(ws + WS_BAR), bst);
    if (a.ws == nullptr) grid.sync();
    p0_prologue(F, a);
    xcd_barrier(bar);
    { pg8::Gemm g{XN, (const bf16*)(ws + WS_WIN), MT, NIN, DM, DM}; pg8::StaticOrder S; S.init(MT, NIN, F.G, (int)blockIdx.x);
      pg8::EpiG1 E{GLU, UV, GG};
      pg8::gemm_phase<pg8::EpiG1, pg8::StaticOrder, true, true>(F.lds, g, S, E); }
    xcd_barrier(bar);
    for (int u = F.vcu; u < 256; u += F.G) {
        mixB_prompt(F, a, UV, u >> 1, u & 1);
        { const int b = u >> 5, t0 = (u & 31) * 64; const bool last = (u & 31) == 31;
          convA_prompt(F, a, (const unsigned*)GLU, ACTA, (size_t)b * SEQ + t0, t0 > 0, last ? out + O_CAP + (size_t)b * 30 * DM : nullptr); }
        if (u < 128) convA_sample(F, a, (const unsigned*)GLU, ACTA, u, a.in[2] + (size_t)u * 30 * DM, out + O_CAS + (size_t)u * 30 * DM);
        else mixB_sample(F, a, UV, u - 128, out + O_VS);
    }
    xcd_barrier(bar);
    { const SmallSrc src[2] = {{ACTA + (size_t)MP * DM, DM, (const bf16*)(ws + WS_WA)}, {UV + (size_t)MP * 2048, 2048, (const bf16*)(ws + WS_WB)}};
      SEpiMerge E{MG, GG}; small_gemm<2, SEpiMerge>(F, src, DM, DM, E); }
    { pg8::Gemm g{ACTA, (const bf16*)(ws + WS_WA), MP, DM, DM, DM}; pg8::StaticOrder S; S.init(MP, DM, F.G, (int)blockIdx.x);
      pg8::EpiMerge<0> E{MG, GG};
      pg8::gemm_phase<pg8::EpiMerge<0>, pg8::StaticOrder, true, true>(F.lds, g, S, E); }
    { pg8::Gemm g{UV, (const bf16*)(ws + WS_WB), MP, DM, DM, 2048}; pg8::StaticOrder S; S.init(MP, DM, F.G, (int)blockIdx.x);
      pg8::EpiMerge<1> E{MG, GG};
      pg8::gemm_phase<pg8::EpiMerge<1>, pg8::StaticOrder, true, true>(F.lds, g, S, E); }
    xcd_barrier(bar);
    { const SmallSrc src[1] = {{MG + (size_t)MP * DM, DM, (const bf16*)(ws + WS_WO)}};
      SEpiRes<false> E{a.in[1], nullptr, nullptr, XN + (size_t)MP * DM, ss1 + MP}; small_gemm<1, SEpiRes<false>>(F, src, DM, DM, E); }
    { pg8::Gemm g{MG, (const bf16*)(ws + WS_WO), MP, DM, DM, DM}; pg8::StaticOrder S; S.init(MP, DM, F.G, (int)blockIdx.x);
      pg8::EpiRes<false> E{a.in[0], nullptr, nullptr, XN, ss1};
      pg8::gemm_phase<pg8::EpiRes<false>, pg8::StaticOrder, true, true>(F.lds, g, S, E); }
    xcd_barrier(bar);
    { pg8::Gemm g{XN, (const bf16*)(ws + WS_WUP), MT, NUP, DM, DM}; pg8::StaticOrder S; S.init(MT, NUP, F.G, (int)blockIdx.x);
      pg8::EpiUpFused E{ACT, ss1, a.in[19], a.in[20], a.in[3], (float*)(ws + WS_SL), (float*)(ws + WS_SF), out + O_FS};
      pg8::gemm_phase<pg8::EpiUpFused, pg8::StaticOrder, true, true>(F.lds, g, S, E); }
    xcd_barrier(bar);
    p6_fixup(F, a, out);
    xcd_barrier(bar);
    { const SmallSrc src[1] = {{ACT + (size_t)MP * DFF, DFF, (const bf16*)(ws + WS_WDN)}};
      SEpiRes<true> E{nullptr, XN + (size_t)MP * DM, out + O_Y + (size_t)MP * DM, nullptr, ss2 + MP}; small_gemm<1, SEpiRes<true>>(F, src, DFF, DM, E); }
    { pg8::Gemm g{ACT, (const bf16*)(ws + WS_WDN), MP, DM, DFF, DFF}; pg8::StaticOrder S; S.init(MP, DM, F.G, (int)blockIdx.x);
      pg8::EpiRes<true> E{nullptr, XN, out + O_Y, nullptr, ss2};
      pg8::gemm_phase<pg8::EpiRes<true>, pg8::StaticOrder, true, true>(F.lds, g, S, E); }
    xcd_barrier(bar);
    { const Frame F8 = phase_frame(F); const float* gf = a.in[22];
      for (int m = F8.vcu * NWAVES + F8.wave; m < MT; m += F.G * NWAVES) {
          f32x4* yr = (f32x4*)(out + O_Y + (size_t)m * DM) + F8.lane; const f32x4* gr = (const f32x4*)gf + F8.lane;
          const float rstd = 1.0f / sqrtf(ss2[m] * (1.f / DM) + EPS);
#pragma unroll
          for (int j = 0; j < 4; ++j) yr[64 * j] = yr[64 * j] * rstd * gr[64 * j]; } }
}

extern "C" void kernel_launch(void* const* d_in, const int* in_sizes, int n_in, void* d_out, int out_size, void* d_ws, size_t ws_size, hipStream_t stream) {
    static int grid = 0;
    if (grid == 0) {
        if (n_in != 23 || (size_t)out_size != O_END || ws_size < WS_END) { fprintf(stderr, "kernel_launch: unexpected shapes: n_in %d out %d ws %zu\n", n_in, out_size, ws_size); grid = -1; return; }
        int dev = 0, cus = 0, per_cu = 0;
        if (hipGetDevice(&dev) != hipSuccess || hipDeviceGetAttribute(&cus, hipDeviceAttributeMultiprocessorCount, dev) != hipSuccess) { grid = -1; return; }
        if (hipFuncSetAttribute((const void*)fwd_mega, hipFuncAttributeMaxDynamicSharedMemorySize, LDS_BYTES) != hipSuccess) { fprintf(stderr, "kernel_launch: hipFuncSetAttribute failed\n"); grid = -1; return; }
        if (hipOccupancyMaxActiveBlocksPerMultiprocessor(&per_cu, (const void*)fwd_mega, NTHR, LDS_BYTES) != hipSuccess || per_cu < 1) { fprintf(stderr, "kernel_launch: occupancy query says %d\n", per_cu); per_cu = 1; }
        (void)hipGetLastError();
        grid = cus * 1;
        fprintf(stderr, "kernel_launch: cus %d per_cu %d grid %d\n", cus, per_cu, grid);
    }
    if (grid < 0) return;
    if (hipMemsetAsync((char*)d_ws + WS_BAR, 0, XCD_BAR_WORDS * 4, stream) != hipSuccess) { fprintf(stderr, "kernel_launch: memset failed\n"); return; }
    Args a{};
    for (int i = 0; i < 23; ++i) a.in[i] = (const float*)d_in[i];
    a.out = (float*)d_out; a.ws = (unsigned char*)d_ws;
    void* args[] = {&a};
    hipError_t e = hipLaunchCooperativeKernel((const void*)fwd_mega, dim3(grid), dim3(NTHR), args, LDS_BYTES, stream);
    if (e != hipSuccess) fprintf(stderr, "kernel_launch: cooperative launch failed: %s (grid %d)\n", hipGetErrorString(e), grid);
}
```

```cpp
#include <hip/hip_runtime.h>
#include <hip/hip_cooperative_groups.h>
#include <cstdio>
#include <cstdint>
namespace cg = cooperative_groups;
namespace pg8 {
#define PG8_LAS __attribute__((address_space(3)))
typedef unsigned short bf16_t;
typedef short bf16x8 __attribute__((ext_vector_type(8)));
typedef float f32x4 __attribute__((ext_vector_type(4)));
typedef unsigned u32x4 __attribute__((ext_vector_type(4)));
constexpr int BM = 256, BK = 64, HALF = 128, HTB = HALF * BK * 2  , STAGE_BYTES = 8 * HTB, NXCD = 8, WGM = 8;

__host__ __device__ __forceinline__ int lds_byte(int r, int c) { const int st = (r >> 4) * 2 + (c >> 5), rr = r & 15, cc = c & 31, ob = rr * 64 + cc * 2; return st * 1024 + (ob ^ (((ob >> 9) & 1) << 5)); }
__host__ __device__ __forceinline__ void stage_rc(int b, int& R, int& C) { const int st = b / 1024, sb = b % 1024, swz = sb ^ (((sb >> 9) & 1) << 5); R = (st >> 1) * 16 + swz / 64; C = (st & 1) * 32 + (swz % 64) / 2; }
__host__ __device__ __forceinline__ int perm32(int rho) { const int n = rho >> 4, i = rho & 15; return 8 * (i >> 2) + 4 * n + (i & 3); }

struct Unit { int pm, pn; };
struct Gemm { const bf16_t* A; const bf16_t* Bt; int M, N, K, lda; };

struct StaticOrder {
    int nM, nN, nwg, G, c;
    __host__ __device__ void init(int M, int N, int G_, int c_) { nM = M / BM; nN = N / BM; nwg = nM * nN; G = G_; c = c_; }
    __host__ __device__ bool next(int i, Unit& u) const {
        const long L = (long)i * G + c; if (L >= nwg) return false;
        int wgid = (int)L; { const int q = nwg / NXCD, r = nwg % NXCD, xcd = wgid % NXCD, off = wgid / NXCD; wgid = (xcd < r ? xcd * (q + 1) : r * (q + 1) + (xcd - r) * q) + off; }
        const int nig = WGM * nN, gid = wgid / nig, fm = gid * WGM, gsz = (nM - fm) < WGM ? (nM - fm) : WGM;
        u.pm = fm + ((wgid % nig) % gsz); u.pn = (wgid % nig) / gsz; return true;
    }
    __device__ __forceinline__ void a_ready(const Unit&) const {}
    __device__ __forceinline__ void done(const Unit&) const {}
};

__device__ __forceinline__ unsigned cvt_pk_bf16(float lo, float hi) { unsigned r; asm volatile("v_cvt_pk_bf16_f32 %0, %1, %2" : "=v"(r) : "v"(lo), "v"(hi)); return r; }
typedef float f32x2 __attribute__((ext_vector_type(2)));
__device__ __forceinline__ f32x2 gelu_pk(f32x2 v) {
    const f32x2 av = __builtin_elementwise_abs(v), d = av * 0.2316418882f + 1.0f;
    f32x2 t; t.x = __builtin_amdgcn_rcpf(d.x); t.y = __builtin_amdgcn_rcpf(d.y);
    f32x2 q = t * 0.5307027145f + (-0.7265760135f); q = q * t + 0.7107068705f; q = q * t + (-0.142248368f); q = q * t + 0.127414796f; q = q * t;
    const f32x2 s = (v * v) * (-0.72134752044f);
    f32x2 e; e.x = __builtin_amdgcn_exp2f(s.x); e.y = __builtin_amdgcn_exp2f(s.y);
    const f32x2 m = v * (q * e), r = v - m;
    f32x2 o; o.x = v.x < 0.f ? m.x : r.x; o.y = v.y < 0.f ? m.y : r.y; return o;
}
typedef unsigned u32x2 __attribute__((ext_vector_type(2)));
__device__ __forceinline__ float sigm(float x) { return __builtin_amdgcn_rcpf(1.0f + __builtin_amdgcn_exp2f(x * -1.44269504089f)); }
__device__ __forceinline__ float bf_lo(unsigned u) { return __uint_as_float(u << 16); }
__device__ __forceinline__ float bf_hi(unsigned u) { return __uint_as_float(u & 0xffff0000u); }

struct EpiG1 {
    static constexpr bool PERM = true, AFTER_DRAIN = false;
    bf16_t* GLU; bf16_t* UV; bf16_t* GG;
    __device__ __forceinline__ void operator()(const f32x4 (&acc)[2][2][4][2], const Unit& u, int wr, int wc, int fr, int fq) const {
        const int row0 = u.pm * BM + wr * 64 + fr;
        if (u.pn < 8) {
            const int col = u.pn * 128 + wc * 32 + 8 * fq;
#pragma unroll
            for (int ai = 0; ai < 2; ++ai)
#pragma unroll
                for (int m = 0; m < 4; ++m) {
                    const f32x4 v0 = acc[ai][0][m][0], v1 = acc[ai][0][m][1], g0 = acc[ai][1][m][0], g1 = acc[ai][1][m][1];
                    u32x4 w; w.x = cvt_pk_bf16(v0[0] * sigm(g0[0]), v0[1] * sigm(g0[1])); w.y = cvt_pk_bf16(v0[2] * sigm(g0[2]), v0[3] * sigm(g0[3]));
                    w.z = cvt_pk_bf16(v1[0] * sigm(g1[0]), v1[1] * sigm(g1[1])); w.w = cvt_pk_bf16(v1[2] * sigm(g1[2]), v1[3] * sigm(g1[3]));
                    *(u32x4*)(GLU + (size_t)(row0 + ai * HALF + m * 16) * 1024 + col) = w; }
        } else {
            const bool isg = u.pn < 16;
            bf16_t* base = isg ? UV : GG;
            const int col0 = (isg ? (u.pn - 8) : (u.pn - 16)) * BM + wc * 32 + 8 * fq;
#pragma unroll
            for (int ai = 0; ai < 2; ++ai)
#pragma unroll
                for (int m = 0; m < 4; ++m) { bf16_t* rowp = base + (size_t)(row0 + ai * HALF + m * 16) * 2048 + col0;
#pragma unroll
                    for (int bj = 0; bj < 2; ++bj) { f32x4 v0 = acc[ai][bj][m][0], v1 = acc[ai][bj][m][1];
                        if (isg) { f32x2 a = gelu_pk((f32x2){v0[0], v0[1]}), b = gelu_pk((f32x2){v0[2], v0[3]}), c = gelu_pk((f32x2){v1[0], v1[1]}), d = gelu_pk((f32x2){v1[2], v1[3]});
                            v0 = (f32x4){a.x, a.y, b.x, b.y}; v1 = (f32x4){c.x, c.y, d.x, d.y}; }
                        else { v0 = (f32x4){sigm(v0[0]), sigm(v0[1]), sigm(v0[2]), sigm(v0[3])}; v1 = (f32x4){sigm(v1[0]), sigm(v1[1]), sigm(v1[2]), sigm(v1[3])}; }
                        u32x4 w; w.x = cvt_pk_bf16(v0[0], v0[1]); w.y = cvt_pk_bf16(v0[2], v0[3]); w.z = cvt_pk_bf16(v1[0], v1[1]); w.w = cvt_pk_bf16(v1[2], v1[3]);
                        *(u32x4*)(rowp + bj * HALF) = w; } }
        }
    }
};
template <int MODE> struct EpiMerge {
    static constexpr bool PERM = true, AFTER_DRAIN = false;
    bf16_t* MG; const bf16_t* GG;
    __device__ __forceinline__ void operator()(const f32x4 (&acc)[2][2][4][2], const Unit& u, int wr, int wc, int fr, int fq) const {
        const int row0 = u.pm * BM + wr * 64 + fr, col0 = u.pn * BM + wc * 32 + 8 * fq;
#pragma unroll
        for (int ai = 0; ai < 2; ++ai)
#pragma unroll
            for (int m = 0; m < 4; ++m) { const size_t row = (size_t)(row0 + ai * HALF + m * 16);
#pragma unroll
                for (int bj = 0; bj < 2; ++bj) { const int col = col0 + bj * HALF;
                    const u32x4 g = *(const u32x4*)(GG + row * 2048 + MODE * 1024 + col);
                    f32x4 v0 = acc[ai][bj][m][0], v1 = acc[ai][bj][m][1];
                    v0 = v0 * (f32x4){bf_lo(g.x), bf_hi(g.x), bf_lo(g.y), bf_hi(g.y)}; v1 = v1 * (f32x4){bf_lo(g.z), bf_hi(g.z), bf_lo(g.w), bf_hi(g.w)};
                    if (MODE == 1) { const u32x4 p = *(const u32x4*)(MG + row * 1024 + col);
                        v0 = v0 + (f32x4){bf_lo(p.x), bf_hi(p.x), bf_lo(p.y), bf_hi(p.y)}; v1 = v1 + (f32x4){bf_lo(p.z), bf_hi(p.z), bf_lo(p.w), bf_hi(p.w)}; }
                    u32x4 w; w.x = cvt_pk_bf16(v0[0], v0[1]); w.y = cvt_pk_bf16(v0[2], v0[3]); w.z = cvt_pk_bf16(v1[0], v1[1]); w.w = cvt_pk_bf16(v1[2], v1[3]);
                    *(u32x4*)(MG + row * 1024 + col) = w; }
                asm volatile("" ::: "memory"); }
    }
};
template <bool RB16> struct EpiRes {
    static constexpr bool PERM = false, AFTER_DRAIN = false;
    const float* R; const bf16_t* RB; float* Y; bf16_t* YB; float* ss;
    __device__ __forceinline__ void operator()(const f32x4 (&acc)[2][2][4][2], const Unit& u, int wr, int wc, int fr, int fq) const {
        const int row0 = u.pm * BM + wr * 64 + fr, col0 = u.pn * BM + wc * 32 + 4 * fq;
#pragma unroll
        for (int ai = 0; ai < 2; ++ai)
#pragma unroll
            for (int m = 0; m < 4; ++m) { const size_t row = (size_t)(row0 + ai * HALF + m * 16); float s = 0.f;
#pragma unroll
                for (int bj = 0; bj < 2; ++bj)
#pragma unroll
                    for (int n = 0; n < 2; ++n) { const size_t off = row * 1024 + col0 + bj * HALF + n * 16;
                        f32x4 h;
                        if (RB16) { const u32x2 p = *(const u32x2*)(RB + off); h = (f32x4){bf_lo(p.x), bf_hi(p.x), bf_lo(p.y), bf_hi(p.y)} + acc[ai][bj][m][n]; *(f32x4*)(Y + off) = h; }
                        else { h = *(const f32x4*)(R + off) + acc[ai][bj][m][n]; u32x2 w; w.x = cvt_pk_bf16(h[0], h[1]); w.y = cvt_pk_bf16(h[2], h[3]); *(u32x2*)(YB + off) = w; }
                        s += (h[0] * h[0] + h[1] * h[1]) + (h[2] * h[2] + h[3] * h[3]); }
                s += __shfl_xor(s, 16); s += __shfl_xor(s, 32);
                if (fq == 0) atomicAdd(ss + row, s);
                asm volatile("" ::: "memory"); }
    }
};
struct EpiUpFused {
    static constexpr bool PERM = true, AFTER_DRAIN = false;
    bf16_t* ACT; const float* ss; const float* dwf; const float* bdw; const float* stf; float* sideLast; float* sideFirst; float* out_fs;
    __device__ __forceinline__ void operator()(const f32x4 (&acc)[2][2][4][2], const Unit& u, int wr, int wc, int fr, int fq) const {
        constexpr int DFF_ = 2816, MP_ = 16384;
        const int cch = u.pn * 128 + wc * 32 + 8 * fq;
        const int lane = fq * 16 + fr, src1 = (lane & 48) | ((fr - 1) & 15), src2 = (lane & 48) | ((fr - 2) & 15);
        f32x4 w0[2], w1[2], w2[2], bs[2];
#pragma unroll
        for (int n = 0; n < 2; ++n) { w0[n] = *(const f32x4*)(dwf + cch + 4 * n); w1[n] = *(const f32x4*)(dwf + DFF_ + cch + 4 * n); w2[n] = *(const f32x4*)(dwf + 2 * DFF_ + cch + 4 * n); bs[n] = *(const f32x4*)(bdw + cch + 4 * n); }
        const bool sample = u.pm >= 64;
#pragma unroll
        for (int ai = 0; ai < 2; ++ai) {
            const int blk = u.pm * 4 + ai * 2 + wr;
            f32x4 p1[2], p2[2];
#pragma unroll
            for (int n = 0; n < 2; ++n) { p1[n] = (f32x4){0.f, 0.f, 0.f, 0.f}; p2[n] = (f32x4){0.f, 0.f, 0.f, 0.f}; }
#pragma unroll
            for (int m = 0; m < 4; ++m) {
                const int row = blk * 64 + 16 * m + fr;
                const float rs = __builtin_amdgcn_rsqf(ss[row] * (1.0f / 1024.0f) + 1e-6f);
                const int t4 = fr & 3, sq = (row - MP_) >> 2;
                u32x4 wout;
#pragma unroll
                for (int n = 0; n < 2; ++n) {
                    const f32x4 av = acc[ai][0][m][n] * rs, bv = acc[ai][1][m][n] * rs;
                    f32x4 r1, r2;
#pragma unroll
                    for (int j = 0; j < 4; ++j) { r1[j] = __shfl(av[j], src1); r2[j] = __shfl(av[j], src2); }
                    f32x4 x1, x2;
                    if (!sample) {
                        x1 = fr == 0 ? p1[n] : r1; x2 = fr < 2 ? p2[n] : r2;
                        if (m == 0 && fr < 2) { float* sf = sideFirst + ((size_t)(blk * 2 + fr) * 2) * DFF_ + cch + 4 * n; *(f32x4*)sf = av; *(f32x4*)(sf + DFF_) = bv; }
                        if (m == 3 && fr >= 14) *(f32x4*)(sideLast + (size_t)(blk * 2 + fr - 14) * DFF_ + cch + 4 * n) = av;
                    } else {
                        const f32x4 s0 = *(const f32x4*)(stf + ((size_t)sq * 2 + 0) * DFF_ + cch + 4 * n), s1 = *(const f32x4*)(stf + ((size_t)sq * 2 + 1) * DFF_ + cch + 4 * n);
                        x1 = t4 >= 1 ? r1 : s1; x2 = t4 >= 2 ? r2 : (t4 == 1 ? s1 : s0);
                        if (t4 >= 2) *(f32x4*)(out_fs + ((size_t)sq * 2 + (t4 - 2)) * DFF_ + cch + 4 * n) = av;
                    }
                    p1[n] = r1; p2[n] = r2;
                    const f32x4 cv = w0[n] * x2 + w1[n] * x1 + w2[n] * av + bs[n];
                    const f32x2 g0 = gelu_pk((f32x2){cv[0], cv[1]}), g1 = gelu_pk((f32x2){cv[2], cv[3]});
                    const unsigned lo = cvt_pk_bf16(g0.x * bv[0], g0.y * bv[1]), hi = cvt_pk_bf16(g1.x * bv[2], g1.y * bv[3]);
                    if (n == 0) { wout.x = lo; wout.y = hi; } else { wout.z = lo; wout.w = hi; }
                }
                *(u32x4*)(ACT + (size_t)row * DFF_ + cch) = wout;
            }
        }
    }
};
template <class Epi, class Sched, bool ALIGN_EPI = false, bool SP2 = false>
__device__ __forceinline__ void gemm_phase(PG8_LAS unsigned char* lds, const Gemm g, const Sched& S, const Epi& E) {
    int tid_ = threadIdx.x; asm volatile("" : "+v"(tid_));
    const int tid = tid_, wid = __builtin_amdgcn_readfirstlane(tid >> 6), lane = tid & 63, wr = wid >> 2, wc = wid & 3, fr = lane & 15, fq = lane >> 4;
    const int K = g.K, nt = K / BK;
    unsigned voffA[2], voffB[2];
#pragma unroll
    for (int i = 0; i < 2; ++i) { int R, C; stage_rc(tid * 16 + i * 8192, R, C); const int Rb = Epi::PERM ? ((R & ~31) + perm32(R & 31)) : R;
        voffA[i] = (unsigned)(R * g.lda + C) * 2u; voffB[i] = (unsigned)(Rb * K + C) * 2u; }
    const size_t kstep = (size_t)(BK * 2);
    const size_t hA = (size_t)HALF * g.lda * 2, hB = (size_t)HALF * K * 2;
    const size_t tA = 2 * hA, tB = 2 * hB;
    const unsigned ldsw = (unsigned)wid * 1024u;
    const int aoff = lds_byte(wr * 64 + fr, fq * 8), boff = lds_byte(wc * 32 + fr, fq * 8);
#define PG8_SA(b, h) (((b) * 2 + (h)) * HTB)
#define PG8_SB(b, h) ((4 + (b) * 2 + (h)) * HTB)
#define PG8_STAGE(bufoff, gbase, voff) do { _Pragma("unroll") for (int _i = 0; _i < 2; ++_i) \
        __builtin_amdgcn_global_load_lds((const unsigned*)((const char*)(gbase) + (voff)[_i]), (PG8_LAS unsigned*)(lds + (bufoff) + ldsw + _i * 8192), 16, 0, 0); } while (0)
#define PG8_LDA(dst, b, h) do { _Pragma("unroll") for (int m = 0; m < 4; ++m) _Pragma("unroll") for (int k = 0; k < 2; ++k) dst[m][k] = *(const PG8_LAS bf16x8*)(lds + PG8_SA(b, h) + aoff + m * 2048 + k * 1024); } while (0)
#define PG8_LDB(dst, b, h) do { _Pragma("unroll") for (int n = 0; n < 2; ++n) _Pragma("unroll") for (int k = 0; k < 2; ++k) dst[n][k] = *(const PG8_LAS bf16x8*)(lds + PG8_SB(b, h) + boff + n * 2048 + k * 1024); } while (0)
#define PG8_MMA(ai, bj, At, Bt) do { __builtin_amdgcn_s_setprio(1); _Pragma("unroll") for (int m = 0; m < 4; ++m) _Pragma("unroll") for (int n = 0; n < 2; ++n) _Pragma("unroll") for (int k = 0; k < 2; ++k) \
        acc[ai][bj][m][n] = __builtin_amdgcn_mfma_f32_16x16x32_bf16(Bt[n][k], At[m][k], acc[ai][bj][m][n], 0, 0, 0); __builtin_amdgcn_s_setprio(0); } while (0)
#define PG8_WAIT_V(n) asm volatile("s_waitcnt vmcnt(" #n ")" ::: "memory")
#define PG8_WAIT_L(n) asm volatile("s_waitcnt lgkmcnt(" #n ")" ::: "memory")
#define PG8_BAR __builtin_amdgcn_s_barrier()
#define PG8_SCHED __builtin_amdgcn_sched_barrier(0)
    Unit cur, nxt; int ui = 0;
    if (!S.next(0, cur)) return;
    f32x4 acc[2][2][4][2];
#pragma unroll
    for (int a = 0; a < 2; ++a)
#pragma unroll
        for (int b = 0; b < 2; ++b)
#pragma unroll
            for (int m = 0; m < 4; ++m)
#pragma unroll
                for (int n = 0; n < 2; ++n) acc[a][b][m][n] = (f32x4){0.f, 0.f, 0.f, 0.f};
    bf16x8 At[4][2], B0[2][2], B1[2][2];
    const char* cA = (const char*)g.A + (size_t)cur.pm * tA; const char* cB = (const char*)g.Bt + (size_t)cur.pn * tB;
    S.a_ready(cur);
    if constexpr (SP2) {
        PG8_STAGE(PG8_SB(0, 0), cB, voffB); PG8_STAGE(PG8_SB(0, 1), cB + hB, voffB); PG8_STAGE(PG8_SA(0, 0), cA, voffA); PG8_STAGE(PG8_SA(0, 1), cA + hA, voffA);
        if (wr == 1) PG8_BAR;
        PG8_WAIT_V(2); PG8_BAR;
        PG8_STAGE(PG8_SB(1, 0), cB + kstep, voffB); PG8_STAGE(PG8_SA(1, 0), cA + kstep, voffA); PG8_STAGE(PG8_SB(1, 1), cB + hB + kstep, voffB);
        PG8_WAIT_V(6); PG8_BAR;
    } else {
        PG8_STAGE(PG8_SB(0, 0), cB, voffB); PG8_STAGE(PG8_SA(0, 0), cA, voffA); PG8_STAGE(PG8_SB(0, 1), cB + hB, voffB); PG8_STAGE(PG8_SA(0, 1), cA + hA, voffA);
        if (wr == 1) PG8_BAR;
        PG8_WAIT_V(4); PG8_BAR;
        PG8_STAGE(PG8_SB(1, 0), cB + kstep, voffB); PG8_STAGE(PG8_SA(1, 0), cA + kstep, voffA); PG8_STAGE(PG8_SB(1, 1), cB + hB + kstep, voffB);
        PG8_WAIT_V(6); PG8_BAR;
    }
    for (;;) {
        const bool has_next = S.next(ui + 1, nxt);
        const char* nA = has_next ? (const char*)g.A + (size_t)nxt.pm * tA : cA; const char* nB = has_next ? (const char*)g.Bt + (size_t)nxt.pn * tB : cB;
        for (int t = 0; t < nt; t += 2) {
            const bool last = (t == nt - 2);
            const char* a1 = cA + (size_t)(t + 1) * kstep;
            const char* a2 = last ? nA : cA + (size_t)(t + 2) * kstep; const char* b2 = last ? nB : cB + (size_t)(t + 2) * kstep;
            const char* a3 = a2 + kstep; const char* b3 = b2 + kstep;
            if (last && has_next) S.a_ready(nxt);
            if constexpr (SP2) {
            PG8_LDB(B0, 0, 0); PG8_LDB(B1, 0, 1); PG8_SCHED; PG8_LDA(At, 0, 0); PG8_STAGE(PG8_SA(1, 1), a1 + hA, voffA);
            PG8_WAIT_V(8); PG8_WAIT_L(0); PG8_BAR; PG8_MMA(0, 0, At, B0); PG8_MMA(0, 1, At, B1); PG8_BAR; PG8_SCHED;
            PG8_LDA(At, 0, 1); PG8_STAGE(PG8_SB(0, 0), b2, voffB); PG8_STAGE(PG8_SB(0, 1), b2 + hB, voffB); PG8_STAGE(PG8_SA(0, 0), a2, voffA);
            PG8_WAIT_V(8); PG8_WAIT_L(0); PG8_BAR; PG8_MMA(1, 0, At, B0); PG8_MMA(1, 1, At, B1); PG8_BAR; PG8_SCHED;
            PG8_LDB(B0, 1, 0); PG8_LDB(B1, 1, 1); PG8_SCHED; PG8_LDA(At, 1, 0); PG8_STAGE(PG8_SA(0, 1), a2 + hA, voffA);
            PG8_WAIT_V(8); PG8_WAIT_L(0); PG8_BAR; PG8_MMA(0, 0, At, B0); PG8_MMA(0, 1, At, B1); PG8_BAR; PG8_SCHED;
            PG8_LDA(At, 1, 1); PG8_STAGE(PG8_SB(1, 0), b3, voffB); PG8_STAGE(PG8_SB(1, 1), b3 + hB, voffB); PG8_STAGE(PG8_SA(1, 0), a3, voffA);
            PG8_WAIT_V(8); PG8_WAIT_L(0); PG8_BAR; PG8_MMA(1, 0, At, B0); PG8_MMA(1, 1, At, B1); PG8_BAR; PG8_SCHED;
            } else {
            PG8_LDB(B0, 0, 0); PG8_SCHED; PG8_LDA(At, 0, 0); PG8_STAGE(PG8_SA(1, 1), a1 + hA, voffA);
            PG8_WAIT_L(8); PG8_BAR; PG8_WAIT_L(0); PG8_MMA(0, 0, At, B0); PG8_BAR; PG8_SCHED;
            PG8_LDB(B1, 0, 1); PG8_STAGE(PG8_SB(0, 0), b2, voffB);
            PG8_BAR; PG8_WAIT_L(0); PG8_MMA(0, 1, At, B1); PG8_BAR;
            PG8_LDA(At, 0, 1); PG8_STAGE(PG8_SA(0, 0), a2, voffA);
            PG8_BAR; PG8_WAIT_L(0); PG8_MMA(1, 0, At, B0); PG8_BAR; PG8_SCHED;
            PG8_STAGE(PG8_SB(0, 1), b2 + hB, voffB);
            PG8_WAIT_V(6); PG8_BAR; PG8_MMA(1, 1, At, B1); PG8_BAR;
            PG8_LDB(B0, 1, 0); PG8_SCHED; PG8_LDA(At, 1, 0); PG8_STAGE(PG8_SA(0, 1), a2 + hA, voffA);
            PG8_WAIT_L(8); PG8_BAR; PG8_WAIT_L(0); PG8_MMA(0, 0, At, B0); PG8_BAR; PG8_SCHED;
            PG8_LDB(B1, 1, 1); PG8_STAGE(PG8_SB(1, 0), b3, voffB);
            PG8_BAR; PG8_WAIT_L(0); PG8_MMA(0, 1, At, B1); PG8_BAR;
            PG8_LDA(At, 1, 1); PG8_STAGE(PG8_SA(1, 0), a3, voffA);
            PG8_BAR; PG8_WAIT_L(0); PG8_MMA(1, 0, At, B0); PG8_BAR; PG8_SCHED;
            PG8_STAGE(PG8_SB(1, 1), b3 + hB, voffB);
            PG8_WAIT_V(6); PG8_BAR; PG8_MMA(1, 1, At, B1); PG8_BAR;
            }
        }
        if constexpr (ALIGN_EPI) { if (wr == 0) PG8_BAR; }
        if constexpr (!Epi::AFTER_DRAIN) { E(acc, cur, wr, wc, fr, fq); S.done(cur); }
        if (!has_next) break;
#pragma unroll
        for (int a = 0; a < 2; ++a)
#pragma unroll
            for (int b = 0; b < 2; ++b)
#pragma unroll
                for (int m = 0; m < 4; ++m)
#pragma unroll
                    for (int n = 0; n < 2; ++n) acc[a][b][m][n] = (f32x4){0.f, 0.f, 0.f, 0.f};
        cur = nxt; cA = nA; cB = nB; ++ui;
        if constexpr (ALIGN_EPI) { if (wr == 1) PG8_BAR; }
    }
    PG8_WAIT_V(0);
    if constexpr (!ALIGN_EPI) { if (wr == 0) PG8_BAR; }
    PG8_BAR;
    if constexpr (Epi::AFTER_DRAIN) { E.fused(acc, cur, wr, wc, fr, fq, lds, wid, lane); S.done(cur); }
#undef PG8_SA
#undef PG8_SB
#undef PG8_STAGE
#undef PG8_LDA
#undef PG8_LDB
#undef PG8_MMA
#undef PG8_WAIT_V
#undef PG8_WAIT_L
#undef PG8_BAR
#undef PG8_SCHED
}
}

constexpr int DM = 1024, NBP = 8, SEQ = 2048, NBS = 128, TS = 4, MP = NBP * SEQ, MS = NBS * TS, MT = MP + MS;
constexpr int NIN = 6144, DFF = 2816, NUP = 2 * DFF, CAW = 31, HB = 8;
constexpr float EPS = 1e-6f;
constexpr int NWAVES = 8, NTHR = 512;
constexpr size_t O_Y = 0, O_CAP = (size_t)MT * DM, O_CAS = O_CAP + (size_t)NBP * 30 * DM, O_VS = O_CAS + (size_t)NBS * 30 * DM, O_FP = O_VS + (size_t)MS * DM, O_FS = O_FP + (size_t)NBP * 2 * DFF, O_END = O_FS + (size_t)NBS * 2 * DFF;
constexpr size_t MiB = 1u << 20;
constexpr size_t WS_SS1 = 0, WS_SS2 = 128 * 1024, WS_BAR = 512 * 1024;
constexpr size_t WS_WUP = 1 * MiB, WS_WDN = 12 * MiB, WS_WIN = 18 * MiB, WS_WA = 30 * MiB, WS_WB = 32 * MiB, WS_WO = 34 * MiB;
constexpr size_t WS_XN = 36 * MiB;
constexpr size_t WS_GLU = 69 * MiB, WS_UV = 102 * MiB, WS_GG = 168 * MiB;
constexpr size_t WS_MG = WS_GLU;
constexpr size_t WS_ACT = WS_GLU;
constexpr size_t WS_SL = 192 * MiB, WS_SF = 200 * MiB;
constexpr size_t WS_END = WS_SF + (size_t)256 * 4 * DFF * 4;
static_assert(WS_ACT + (size_t)MT * DFF * 2 <= WS_SL && WS_SL + (size_t)256 * 2 * DFF * 4 <= WS_SF && WS_END <= 256 * MiB && WS_GG + (size_t)MT * 2048 * 2 <= 256 * MiB, "d_ws map");
constexpr int LDS_BYTES = 147456;

#define LAS __attribute__((address_space(3)))
typedef unsigned short bf16;
typedef unsigned v4u __attribute__((ext_vector_type(4)));
typedef unsigned v2u __attribute__((ext_vector_type(2)));
typedef float f32x4 __attribute__((ext_vector_type(4)));
typedef float f32x2 __attribute__((ext_vector_type(2)));
typedef short bf16x8 __attribute__((ext_vector_type(8)));
#define LDS_WAIT() asm volatile("s_waitcnt lgkmcnt(0)" ::: "memory")
__device__ __forceinline__ unsigned f2bf(float f) { unsigned u = __builtin_bit_cast(unsigned, f); return (u + 0x7fffu + ((u >> 16) & 1u)) >> 16; }
__device__ __forceinline__ unsigned pk2(float lo, float hi) { return f2bf(lo) | (f2bf(hi) << 16); }
__device__ __forceinline__ float blo(unsigned u) { return __uint_as_float(u << 16); }
__device__ __forceinline__ float bhi(unsigned u) { return __uint_as_float(u & 0xffff0000u); }
__device__ __forceinline__ float sigmf(float x) { return __builtin_amdgcn_rcpf(1.0f + __builtin_amdgcn_exp2f(x * -1.44269504089f)); }
__device__ __forceinline__ float wave_sum(float v) {
#pragma unroll
    for (int o = 1; o < 64; o <<= 1) v += __shfl_xor(v, o);
    return v;
}

struct Args { const float* in[23]; float* out; unsigned char* ws; };
struct Frame { LAS unsigned char* lds; int tid, lane, wave, vcu, G; };
__device__ __forceinline__ Frame phase_frame(const Frame& F0) { Frame F = F0; int t = F0.tid; asm volatile("" : "+v"(t)); F.tid = t; F.lane = t & 63; return F; }

#define XB_TMO      128
#define XB_XCNT(j)  (256  + 64 * (j))
#define XB_XSUB(j)  (1280 + 64 * (j))
#define XB_XGEN(j)  (2304 + 64 * (j))
#define XB_TOP      3328
#define XB_TOPGEN   3392
#define XCD_BAR_WORDS 3456
#define XB_SPIN_CAP (1u << 18)

__device__ __forceinline__ unsigned xb_ld(unsigned* p)              { return __hip_atomic_load(p, __ATOMIC_RELAXED, __HIP_MEMORY_SCOPE_AGENT); }
__device__ __forceinline__ unsigned xb_add(unsigned* p, unsigned v) { return __hip_atomic_fetch_add(p, v, __ATOMIC_RELAXED, __HIP_MEMORY_SCOPE_AGENT); }
__device__ __forceinline__ unsigned xb_xcc_id() { return (unsigned)__builtin_amdgcn_s_getreg((3 << 11) | 20) & 0xFu; }
#define XB_SPIN(cond, bar) do { unsigned _sp = 0; while (cond) { __builtin_amdgcn_s_sleep(1); \
    if ((++_sp & 255u) == 0u) { if (xb_ld(&(bar)[XB_TMO])) break; if (_sp > XB_SPIN_CAP) { atomicAdd(&(bar)[XB_TMO], 1u); break; } } } } while (0)

struct XcdBarrier {
    unsigned* bar; unsigned x;
    volatile LAS unsigned* st;
};

__device__ __forceinline__ XcdBarrier xcd_barrier_post(unsigned* bar, volatile LAS unsigned* st) {
    XcdBarrier b; b.bar = bar; b.x = xb_xcc_id(); b.st = st;
    if (threadIdx.x == 0) (void)xb_add(&bar[XB_XCNT(b.x)], 1u);
    return b;
}
__device__ __forceinline__ void xcd_barrier_complete(unsigned* bar, unsigned x, unsigned& nloc, unsigned& nx) {
    const unsigned G = gridDim.x * gridDim.y * gridDim.z;
    unsigned sum, cnt, mine, sp = 0u;
    for (;;) {
        sum = 0u; cnt = 0u; mine = 0u;
#pragma unroll
        for (unsigned j = 0; j < 16; ++j) { const unsigned c = xb_ld(&bar[XB_XCNT(j)]); sum += c; cnt += (c > 0u) ? 1u : 0u; mine = (j == x) ? c : mine; }
        if (sum == G) break;
        __builtin_amdgcn_s_sleep(1);
        if ((++sp & 255u) == 0u) { if (xb_ld(&bar[XB_TMO])) break; if (sp > XB_SPIN_CAP) { atomicAdd(&bar[XB_TMO], 1u); break; } }
    }
    nloc = mine > 0u ? mine : 1u; nx = cnt > 0u ? cnt : 1u;
}

__device__ __forceinline__ void xcd_barrier(const XcdBarrier& b) {
    asm volatile("s_waitcnt vmcnt(0)" ::: "memory");
    __syncthreads();
    if (threadIdx.x == 0) {
        unsigned* bar = b.bar;
        __builtin_amdgcn_s_waitcnt(0);
        unsigned nloc = b.st[0], nx = b.st[1];
        if (nloc == 0u) { xcd_barrier_complete(bar, b.x, nloc, nx); b.st[0] = nloc; b.st[1] = nx; }
        const unsigned old = xb_add(&bar[XB_XSUB(b.x)], 1u);
        const unsigned gen = old / nloc;
        if (old + 1u == (gen + 1u) * nloc) {
            __builtin_amdgcn_fence(__ATOMIC_RELEASE, "agent");
            asm volatile("s_waitcnt vmcnt(0)" ::: "memory");
            const unsigned og = xb_add(&bar[XB_TOP], 1u);
            const unsigned tg = og / nx;
            if (og + 1u == (tg + 1u) * nx) xb_add(&bar[XB_TOPGEN], 1u);
            else XB_SPIN(xb_ld(&bar[XB_TOPGEN]) == tg, bar);
            __builtin_amdgcn_fence(__ATOMIC_ACQUIRE, "agent");
            xb_add(&bar[XB_XGEN(b.x)], 1u);
            asm volatile("s_waitcnt vmcnt(0)" ::: "memory");
        } else {
            XB_SPIN(xb_ld(&bar[XB_XGEN(b.x)]) == gen, bar);
            __builtin_amdgcn_fence(__ATOMIC_ACQUIRE, "agent");
            asm volatile("s_waitcnt vmcnt(0)" ::: "memory");
        }
    }
    __syncthreads();
}

__device__ __forceinline__ void p0_transpose_item(const float* W, int K, int N, bf16* WT, int mode, const float* kscale, LAS float* scr, int item, int lane) {
    const int nblk = N / 32, kb = item / nblk, nb = item % nblk, k0 = 64 * kb, n0 = 32 * nb;
    float tv[32];
    const float* wp = W + (size_t)(k0 + (lane >> 5)) * N + n0 + (lane & 31);
#pragma unroll
    for (int i = 0; i < 32; ++i) tv[i] = wp[(size_t)(2 * i) * N];
    if (kscale) {
#pragma unroll
        for (int i = 0; i < 32; ++i) tv[i] *= kscale[k0 + 2 * i + (lane >> 5)];
    }
#pragma unroll
    for (int i = 0; i < 32; ++i) scr[(2 * i + (lane >> 5)) * 33 + (lane & 31)] = tv[i];
    LDS_WAIT(); asm volatile("" ::: "memory");
    int n0m = n0;
    if (mode == 1 && n0 < 2048) { const int half = n0 >= 1024 ? 1 : 0, ch = n0 - 1024 * half; n0m = 256 * (ch >> 7) + 128 * half + (ch & 127); }
    if (mode == 2) { const int half = n0 >= 2816 ? 1 : 0, ch = n0 - 2816 * half; n0m = 256 * (ch >> 7) + 128 * half + (ch & 127); }
    const int c = lane & 7;
#pragma unroll
    for (int j = 0; j < 4; ++j) { const int n = (lane >> 3) + 8 * j; const LAS float* s = scr + (8 * c) * 33 + n;
        v4u o; o.x = pk2(s[0 * 33], s[1 * 33]); o.y = pk2(s[2 * 33], s[3 * 33]); o.z = pk2(s[4 * 33], s[5 * 33]); o.w = pk2(s[6 * 33], s[7 * 33]);
        *(v4u*)(WT + (size_t)(n0m + n) * K + k0 + 8 * c) = o; }
    LDS_WAIT(); asm volatile("" ::: "memory");
}
__device__ __forceinline__ void rms_row_to_bf16(const float* xrow, const float* g, bf16* orow, int lane) {
    const f32x4* xr = (const f32x4*)xrow + lane; const f32x4* gr = (const f32x4*)g + lane;
    f32x4 v[4]; float s = 0.f;
#pragma unroll
    for (int j = 0; j < 4; ++j) { v[j] = xr[64 * j]; s += (v[j].x * v[j].x + v[j].y * v[j].y) + (v[j].z * v[j].z + v[j].w * v[j].w); }
    const float rstd = 1.0f / sqrtf(wave_sum(s) * (1.f / DM) + EPS);
    unsigned long long* o8 = (unsigned long long*)orow + lane;
#pragma unroll
    for (int j = 0; j < 4; ++j) { const f32x4 gg = gr[64 * j]; o8[64 * j] = (unsigned long long)pk2(v[j].x * rstd * gg.x, v[j].y * rstd * gg.y) | ((unsigned long long)pk2(v[j].z * rstd * gg.z, v[j].w * rstd * gg.w) << 32); }
}
constexpr int I_IN = (DM / 64) * (NIN / 32), I_SQ = (DM / 64) * (DM / 32), I_UP = (DM / 64) * (NUP / 32), I_DN = (DFF / 64) * (DM / 32), NITEMS = I_IN + 3 * I_SQ + I_UP + I_DN;
__device__ __forceinline__ void p0_weights(const Frame& F0, const Args& a, int it_lo, int it_hi, int widx, int wcnt) {
    const Frame F = phase_frame(F0);
    unsigned char* ws = a.ws;
    LAS float* scr = (LAS float*)(F.lds + F.wave * 16384);
    for (int it = it_lo + widx; it < it_hi; it += wcnt) {
        int r = it;
        if (r < I_IN) { p0_transpose_item(a.in[5], DM, NIN, (bf16*)(ws + WS_WIN), 1, nullptr, scr, r, F.lane); continue; } r -= I_IN;
        if (r < I_SQ) { p0_transpose_item(a.in[10], DM, DM, (bf16*)(ws + WS_WA), 0, nullptr, scr, r, F.lane); continue; } r -= I_SQ;
        if (r < I_SQ) { p0_transpose_item(a.in[15], DM, DM, (bf16*)(ws + WS_WB), 0, nullptr, scr, r, F.lane); continue; } r -= I_SQ;
        if (r < I_SQ) { p0_transpose_item(a.in[16], DM, DM, (bf16*)(ws + WS_WO), 0, nullptr, scr, r, F.lane); continue; } r -= I_SQ;
        if (r < I_UP) { p0_transpose_item(a.in[18], DM, NUP, (bf16*)(ws + WS_WUP), 2, a.in[17], scr, r, F.lane); continue; } r -= I_UP;
        p0_transpose_item(a.in[21], DFF, DM, (bf16*)(ws + WS_WDN), 0, nullptr, scr, r, F.lane);
    }
}
__device__ __forceinline__ void p0_rows(const Frame& F0, const Args& a) {
    const Frame F = phase_frame(F0);
    unsigned char* ws = a.ws;
    const int gw = F.vcu * NWAVES + F.wave, NGW = F.G * NWAVES;
    bf16* XN = (bf16*)(ws + WS_XN);
    for (int m = gw; m < MT; m += 2 * NGW) {
        const int m2 = m + NGW; const bool has2 = m2 < MT; const int mb = has2 ? m2 : m;
        const float* xa = m < MP ? a.in[0] + (size_t)m * DM : a.in[1] + (size_t)(m - MP) * DM;
        const float* xb = mb < MP ? a.in[0] + (size_t)mb * DM : a.in[1] + (size_t)(mb - MP) * DM;
        const f32x4* pa = (const f32x4*)xa + F.lane; const f32x4* pb = (const f32x4*)xb + F.lane; const f32x4* gr = (const f32x4*)a.in[4] + F.lane;
        f32x4 va[4], vb[4]; float sa = 0.f, sb = 0.f;
#pragma unroll
        for (int j = 0; j < 4; ++j) { va[j] = pa[64 * j]; vb[j] = pb[64 * j]; }
#pragma unroll
        for (int j = 0; j < 4; ++j) { sa += (va[j].x * va[j].x + va[j].y * va[j].y) + (va[j].z * va[j].z + va[j].w * va[j].w); sb += (vb[j].x * vb[j].x + vb[j].y * vb[j].y) + (vb[j].z * vb[j].z + vb[j].w * vb[j].w); }
#pragma unroll
        for (int o = 1; o < 64; o <<= 1) { sa += __shfl_xor(sa, o); sb += __shfl_xor(sb, o); }
        const float ra = 1.0f / sqrtf(sa * (1.f / DM) + EPS), rb = 1.0f / sqrtf(sb * (1.f / DM) + EPS);
        unsigned long long* oa = (unsigned long long*)(XN + (size_t)m * DM) + F.lane; unsigned long long* ob = (unsigned long long*)(XN + (size_t)mb * DM) + F.lane;
#pragma unroll
        for (int j = 0; j < 4; ++j) { const f32x4 gg = gr[64 * j];
            oa[64 * j] = (unsigned long long)pk2(va[j].x * ra * gg.x, va[j].y * ra * gg.y) | ((unsigned long long)pk2(va[j].z * ra * gg.z, va[j].w * ra * gg.w) << 32);
            if (has2) ob[64 * j] = (unsigned long long)pk2(vb[j].x * rb * gg.x, vb[j].y * rb * gg.y) | ((unsigned long long)pk2(vb[j].z * rb * gg.z, vb[j].w * rb * gg.w) << 32); }
    }
    float* ss = (float*)(ws + WS_SS1);
    for (int i = F.vcu * NTHR + F.tid; i < (int)(2 * WS_SS2 / 4); i += F.G * NTHR) ss[i] = 0.f;
}

__device__ __forceinline__ void ln_silu_row(const LAS float* src, bf16* dst, const float* g, const float* bt, int lane) {
    f32x4 v[4]; float s = 0.f;
#pragma unroll
    for (int j = 0; j < 4; ++j) { v[j] = *(const LAS f32x4*)(src + 4 * lane + 256 * j); s += (v[j].x + v[j].y) + (v[j].z + v[j].w); }
    const float mean = wave_sum(s) * (1.f / DM); float s2 = 0.f;
#pragma unroll
    for (int j = 0; j < 4; ++j) { v[j] = v[j] - mean; s2 += (v[j].x * v[j].x + v[j].y * v[j].y) + (v[j].z * v[j].z + v[j].w * v[j].w); }
    const float rstd = 1.0f / sqrtf(wave_sum(s2) * (1.f / DM) + EPS);
#pragma unroll
    for (int j = 0; j < 4; ++j) { const f32x4 gg = *(const f32x4*)(g + 4 * lane + 256 * j), bb = *(const f32x4*)(bt + 4 * lane + 256 * j);
        f32x4 y = v[j] * rstd * gg + bb; y = (f32x4){y.x * sigmf(y.x), y.y * sigmf(y.y), y.z * sigmf(y.z), y.w * sigmf(y.w)};
        v2u w; w.x = pk2(y.x, y.y); w.y = pk2(y.z, y.w); *(v2u*)(dst + 4 * lane + 256 * j) = w; }
}
__device__ __forceinline__ void convA_prompt(const Frame& F0, const Args& a, const unsigned* G32, bf16* ACTA, size_t grow0, bool has_hist, float* capout) {
    const Frame F = phase_frame(F0);
    const int c0 = 2 * F.tid;
    LAS float* CB = (LAS float*)F.lds;
    const float* dw = a.in[6];
    f32x2 w[CAW];
#pragma unroll
    for (int k = 0; k < CAW; ++k) w[k] = *(const f32x2*)(dw + k * DM + c0);
    const f32x2 bias = *(const f32x2*)(a.in[7] + c0);
    f32x2 ring[32];
#pragma unroll
    for (int j = 0; j < 32; ++j) ring[j] = (f32x2){0.f, 0.f};
    if (has_hist) {
        const unsigned* hp = G32 + (grow0 - 30) * 512 + F.tid;
#pragma unroll
        for (int j = 0; j < 30; ++j) { const unsigned u = hp[(size_t)j * 512]; ring[2 + j] = (f32x2){blo(u), bhi(u)}; }
    }
    for (int base = 0; base < 64; base += 32) {
        const unsigned* gp = G32 + (grow0 + base) * 512 + F.tid;
#pragma unroll
        for (int jg = 0; jg < 32; jg += 8) {
            unsigned tmp[8];
#pragma unroll
            for (int jj = 0; jj < 8; ++jj) tmp[jj] = gp[(size_t)(jg + jj) * 512];
#pragma unroll
            for (int jj = 0; jj < 8; ++jj) {
                const int j = jg + jj;
                const f32x2 nv = (f32x2){blo(tmp[jj]), bhi(tmp[jj])};
                ring[j] = nv;
                f32x2 o = bias;
#pragma unroll
                for (int k = 0; k < CAW; ++k) o += ring[(j + k + 2) & 31] * w[k];
                *(LAS f32x2*)(CB + j * DM + c0) = o;
            }
            __builtin_amdgcn_sched_barrier(0);
        }
        if (capout && base == 32) {
#pragma unroll
            for (int j = 2; j < 32; ++j) *(f32x2*)(capout + (size_t)(j - 2) * DM + c0) = ring[j];
        }
        __syncthreads();
#pragma unroll 1
        for (int r = F.wave; r < 32; r += NWAVES) ln_silu_row(CB + r * DM, ACTA + (grow0 + base + r) * DM, a.in[8], a.in[9], F.lane);
        __syncthreads();
    }
}
__device__ __forceinline__ void convA_sample(const Frame& F0, const Args& a, const unsigned* G32, bf16* ACTA, int s, const float* hst, float* casout) {
    const Frame F = phase_frame(F0);
    const int c0 = 2 * F.tid;
    LAS float* CB = (LAS float*)F.lds;
    const float* dw = a.in[6];
    f32x2 w[CAW];
#pragma unroll
    for (int k = 0; k < CAW; ++k) w[k] = *(const f32x2*)(dw + k * DM + c0);
    const f32x2 bias = *(const f32x2*)(a.in[7] + c0);
    f32x2 o[4] = {bias, bias, bias, bias};
    const size_t grow0 = (size_t)MP + 4 * s;
#pragma unroll
    for (int i = 0; i < 34; ++i) {
        f32x2 x;
        if (i < 30) x = *(const f32x2*)(hst + i * DM + c0);
        else { const unsigned u = G32[(grow0 + (i - 30)) * 512 + F.tid]; x = (f32x2){blo(u), bhi(u)}; }
        if (i >= 4) *(f32x2*)(casout + (i - 4) * DM + c0) = x;
#pragma unroll
        for (int t = 0; t < 4; ++t) { const int k = i - t; if (k >= 0 && k < CAW) o[t] += x * w[k]; }
    }
#pragma unroll
    for (int t = 0; t < 4; ++t) *(LAS f32x2*)(CB + t * DM + c0) = o[t];
    __syncthreads();
    if (F.wave < 4) ln_silu_row(CB + F.wave * DM, ACTA + (grow0 + F.wave) * DM, a.in[8], a.in[9], F.lane);
    __syncthreads();
}

__device__ __forceinline__ void ln_stats16(const bf16* vrow, int lane, float (&x)[16], float& mean, float& rstd) {
    const v4u p = *(const v4u*)(vrow + 8 * lane), q = *(const v4u*)(vrow + 512 + 8 * lane);
    x[0] = blo(p.x); x[1] = bhi(p.x); x[2] = blo(p.y); x[3] = bhi(p.y); x[4] = blo(p.z); x[5] = bhi(p.z); x[6] = blo(p.w); x[7] = bhi(p.w);
    x[8] = blo(q.x); x[9] = bhi(q.x); x[10] = blo(q.y); x[11] = bhi(q.y); x[12] = blo(q.z); x[13] = bhi(q.z); x[14] = blo(q.w); x[15] = bhi(q.w);
    float s = 0.f;
#pragma unroll
    for (int i = 0; i < 16; ++i) s += x[i];
    mean = wave_sum(s) * (1.f / DM); float s2 = 0.f;
#pragma unroll
    for (int i = 0; i < 16; ++i) { const float d = x[i] - mean; s2 += d * d; }
    rstd = 1.0f / sqrtf(wave_sum(s2) * (1.f / DM) + EPS);
}
constexpr int VT_LD = 130, WT_LD = 136;
constexpr int MB_STAT = 0, MB_VT = 1024, MB_WT = MB_VT + 128 * VT_LD * 2 + 64;
static_assert(MB_WT % 16 == 0 && MB_WT + 128 * WT_LD * 2 <= 131072, "mixer-B LDS map");
__device__ __forceinline__ void mixB_prompt(const Frame& F0, const Args& a, bf16* UV, int ch, int hh) {
    const Frame F = phase_frame(F0);
    const size_t R0 = (size_t)ch * 128;
    LAS f32x2* STAT = (LAS f32x2*)(F.lds + MB_STAT);
    LAS unsigned char* VT = F.lds + MB_VT; LAS unsigned char* WT = F.lds + MB_WT;
    const float* lng = a.in[11]; const float* lnb = a.in[12]; const float* w_s = a.in[13]; const float* b_s = a.in[14];
    for (int i = 0; i < 16; ++i) { const int r = F.wave * 16 + i; float x[16], mean, rstd; ln_stats16(UV + (R0 + r) * 2048 + 1024, F.lane, x, mean, rstd); if (F.lane == 0) STAT[r] = (f32x2){mean, rstd}; }
    __syncthreads();
    const int lr = F.lane & 15, lq = F.lane >> 4;
    for (int hq = 0; hq < 4; ++hq) {
        const int h = hh * 4 + hq;
#pragma unroll
        for (int i = 0; i < 4; ++i) { const int idx = F.tid + NTHR * i, r = idx >> 4, cgp = idx & 15, c = h * 128 + cgp * 8;
            const v4u p = *(const v4u*)(UV + (R0 + r) * 2048 + 1024 + c); const f32x2 st = STAT[r];
            const f32x4 g0 = *(const f32x4*)(lng + c), g1 = *(const f32x4*)(lng + c + 4), b0 = *(const f32x4*)(lnb + c), b1 = *(const f32x4*)(lnb + c + 4);
            LAS unsigned* dst = (LAS unsigned*)(VT + (r * VT_LD + cgp * 8) * 2);
            dst[0] = pk2((blo(p.x) - st.x) * st.y * g0.x + b0.x, (bhi(p.x) - st.x) * st.y * g0.y + b0.y);
            dst[1] = pk2((blo(p.y) - st.x) * st.y * g0.z + b0.z, (bhi(p.y) - st.x) * st.y * g0.w + b0.w);
            dst[2] = pk2((blo(p.z) - st.x) * st.y * g1.x + b1.x, (bhi(p.z) - st.x) * st.y * g1.y + b1.y);
            dst[3] = pk2((blo(p.w) - st.x) * st.y * g1.z + b1.z, (bhi(p.w) - st.x) * st.y * g1.w + b1.w); }
#pragma unroll
        for (int i = 0; i < 8; ++i) { const int idx = F.tid + NTHR * i, t = idx >> 5, sg = idx & 31;
            const f32x4 wv = *(const f32x4*)(w_s + ((size_t)h * 128 + t) * 128 + sg * 4); const int s0 = sg * 4;
            v2u o; o.x = pk2(s0 <= t ? wv.x : 0.f, s0 + 1 <= t ? wv.y : 0.f); o.y = pk2(s0 + 2 <= t ? wv.z : 0.f, s0 + 3 <= t ? wv.w : 0.f);
            *(LAS v2u*)(WT + (t * WT_LD + s0) * 2) = o; }
        __syncthreads();
        bf16x8 af[4];
#pragma unroll
        for (int ks = 0; ks < 4; ++ks) {
#pragma unroll
            for (int kk = 0; kk < 8; ++kk) af[ks][kk] = (short)*(const LAS unsigned short*)(VT + ((32 * ks + 8 * lq + kk) * VT_LD + 16 * F.wave + lr) * 2);
        }
#pragma unroll
        for (int tb = 0; tb < 8; ++tb) {
            f32x4 acc = (f32x4){0.f, 0.f, 0.f, 0.f};
#pragma unroll
            for (int ks = 0; ks < 4; ++ks) {
                if (32 * ks <= 16 * tb + 15) {
                    const bf16x8 bfr = *(const LAS bf16x8*)(WT + ((16 * tb + lr) * WT_LD + 32 * ks + 8 * lq) * 2);
                    acc = __builtin_amdgcn_mfma_f32_16x16x32_bf16(af[ks], bfr, acc, 0, 0, 0);
                }
            }
            const int t = 16 * tb + lr, c = h * 128 + 16 * F.wave + 4 * lq;
            bf16* up = UV + (R0 + t) * 2048 + c;
            const v2u uu = *(const v2u*)up; const float bsv = b_s[h * 128 + t];
            v2u o; o.x = pk2(blo(uu.x) * (acc[0] + bsv), bhi(uu.x) * (acc[1] + bsv)); o.y = pk2(blo(uu.y) * (acc[2] + bsv), bhi(uu.y) * (acc[3] + bsv));
            *(v2u*)up = o;
        }
        __syncthreads();
    }
}
__device__ __forceinline__ void mixB_sample(const Frame& F0, const Args& a, bf16* UV, int s, float* out_vs) {
    const Frame F = phase_frame(F0);
    LAS float* SV = (LAS float*)F.lds;
    const float* lng = a.in[11]; const float* lnb = a.in[12]; const float* w_s = a.in[13]; const float* b_s = a.in[14];
    const size_t R0 = (size_t)MP + 4 * s;
    if (F.wave < 4) {
        const int t = F.wave; float x[16], mean, rstd; ln_stats16(UV + (R0 + t) * 2048 + 1024, F.lane, x, mean, rstd);
#pragma unroll
        for (int hf = 0; hf < 2; ++hf) { const int c = 512 * hf + 8 * F.lane;
#pragma unroll
            for (int q = 0; q < 2; ++q) { const f32x4 g = *(const f32x4*)(lng + c + 4 * q), b = *(const f32x4*)(lnb + c + 4 * q);
                const f32x4 xv = (f32x4){x[8 * hf + 4 * q], x[8 * hf + 4 * q + 1], x[8 * hf + 4 * q + 2], x[8 * hf + 4 * q + 3]};
                const f32x4 y = (xv - mean) * rstd * g + b;
                *(f32x4*)(out_vs + ((size_t)4 * s + t) * DM + c + 4 * q) = y; *(LAS f32x4*)(SV + t * DM + c + 4 * q) = y; } }
    }
    __syncthreads();
    const int c0 = 2 * F.tid, h = c0 >> 7;
#pragma unroll
    for (int t = 0; t < 4; ++t) {
        const float bsv = b_s[h * 128 + t]; float s0 = bsv, s1 = bsv;
#pragma unroll
        for (int sp = 0; sp <= t; ++sp) { const float wv = w_s[((size_t)h * 128 + t) * 128 + sp]; const f32x2 vv = *(const LAS f32x2*)(SV + sp * DM + c0); s0 += wv * vv.x; s1 += wv * vv.y; }
        unsigned* up = (unsigned*)(UV + (R0 + t) * 2048 + c0); const unsigned uu = *up;
        *up = pk2(blo(uu) * s0, bhi(uu) * s1);
    }
    __syncthreads();
}

__device__ __forceinline__ void ld8f(const float* p, float (&x)[8]) { const f32x4 a = *(const f32x4*)p, b = *(const f32x4*)(p + 4); x[0] = a.x; x[1] = a.y; x[2] = a.z; x[3] = a.w; x[4] = b.x; x[5] = b.y; x[6] = b.z; x[7] = b.w; }
__device__ __forceinline__ void st8f(float* p, const float (&x)[8]) { *(f32x4*)p = (f32x4){x[0], x[1], x[2], x[3]}; *(f32x4*)(p + 4) = (f32x4){x[4], x[5], x[6], x[7]}; }
__device__ __forceinline__ void p6_fixup(const Frame& F0, const Args& a, float* out) {
    const Frame F = phase_frame(F0);
    bf16* ACT = (bf16*)(a.ws + WS_ACT); const float* SL = (const float*)(a.ws + WS_SL); const float* SF = (const float*)(a.ws + WS_SF);
    constexpr int NG = DFF / 8, NIT = 256 * 2 * NG;
    const float* dwf = a.in[19]; const float* bdw = a.in[20];
    for (int it = F.vcu * NTHR + F.tid; it < NIT; it += F.G * NTHR) {
        const int bi = it / NG, cgp = it - bi * NG, c = cgp * 8, blk = bi >> 1, i = bi & 1;
        if ((blk & 31) != 0) {
            float l0[8], l1[8], f0[8], f1[8], fb[8], w0[8], w1[8], w2[8], bs[8];
            ld8f(SL + ((size_t)(blk - 1) * 2 + 0) * DFF + c, l0); ld8f(SL + ((size_t)(blk - 1) * 2 + 1) * DFF + c, l1);
            ld8f(SF + ((size_t)(blk * 2 + 0) * 2 + 0) * DFF + c, f0); ld8f(SF + ((size_t)(blk * 2 + 1) * 2 + 0) * DFF + c, f1); ld8f(SF + ((size_t)(blk * 2 + i) * 2 + 1) * DFF + c, fb);
            ld8f(dwf + c, w0); ld8f(dwf + DFF + c, w1); ld8f(dwf + 2 * DFF + c, w2); ld8f(bdw + c, bs);
            float o[8];
#pragma unroll
            for (int j = 0; j < 8; j += 2) {
                const float x2a = i == 0 ? l0[j] : l1[j], x1a = i == 0 ? l1[j] : f0[j], x0a = i == 0 ? f0[j] : f1[j];
                const float x2b = i == 0 ? l0[j + 1] : l1[j + 1], x1b = i == 0 ? l1[j + 1] : f0[j + 1], x0b = i == 0 ? f0[j + 1] : f1[j + 1];
                f32x2 cv = (f32x2){x2a * w0[j] + x1a * w1[j] + x0a * w2[j] + bs[j], x2b * w0[j + 1] + x1b * w1[j + 1] + x0b * w2[j + 1] + bs[j + 1]};
                cv = pg8::gelu_pk(cv); o[j] = cv.x * fb[j]; o[j + 1] = cv.y * fb[j + 1]; }
            v4u w; w.x = pk2(o[0], o[1]); w.y = pk2(o[2], o[3]); w.z = pk2(o[4], o[5]); w.w = pk2(o[6], o[7]);
            *(v4u*)(ACT + ((size_t)blk * 64 + i) * DFF + c) = w;
        }
        if ((blk & 31) == 31) { float l[8]; ld8f(SL + ((size_t)blk * 2 + i) * DFF + c, l); st8f(out + O_FP + ((size_t)(blk >> 5) * 2 + i) * DFF + c, l); }
    }
}

struct SmallSrc { const bf16* A; int lda; const bf16* Bt; };
template <int NSRC, class Epi>
__device__ __forceinline__ void small_gemm(const Frame& F0, const SmallSrc (&src)[NSRC], int K, int N, const Epi& E) {
    const Frame F = phase_frame(F0);
    const int fr = F.lane & 15, fq = F.lane >> 4;
    const int ntn = N / 16, ntiles = (MS / 16) * ntn;
    for (int tile = F.vcu * NWAVES + F.wave; tile < ntiles; tile += F.G * NWAVES) {
        const int tm = tile / ntn, tn = tile - tm * ntn;
        f32x4 acc[NSRC];
#pragma unroll
        for (int sidx = 0; sidx < NSRC; ++sidx) {
            const bf16* ap = src[sidx].A + (size_t)(16 * tm + fr) * src[sidx].lda + 8 * fq;
            const bf16* bp = src[sidx].Bt + (size_t)(16 * tn + fr) * K + 8 * fq;
            f32x4 c = (f32x4){0.f, 0.f, 0.f, 0.f};
#pragma unroll 1
            for (int k = 0; k < K; k += 256) {
                bf16x8 af[8], bfm[8];
#pragma unroll
                for (int i = 0; i < 8; ++i) { af[i] = *(const bf16x8*)(ap + k + 32 * i); bfm[i] = *(const bf16x8*)(bp + k + 32 * i); }
#pragma unroll
                for (int i = 0; i < 8; ++i) c = __builtin_amdgcn_mfma_f32_16x16x32_bf16(bfm[i], af[i], c, 0, 0, 0);
            }
            acc[sidx] = c;
        }
        E(acc, 16 * tm + fr, 16 * tn + 4 * fq, fq);
    }
}
struct SEpiMerge {
    bf16* MG; const bf16* GG;
    __device__ __forceinline__ void operator()(const f32x4 (&acc)[2], int r, int c, int fq) const {
        const size_t row = (size_t)MP + r;
        const v2u ga = *(const v2u*)(GG + row * 2048 + c), gb = *(const v2u*)(GG + row * 2048 + 1024 + c);
        v2u o; o.x = pk2(blo(ga.x) * acc[0][0] + blo(gb.x) * acc[1][0], bhi(ga.x) * acc[0][1] + bhi(gb.x) * acc[1][1]);
        o.y = pk2(blo(ga.y) * acc[0][2] + blo(gb.y) * acc[1][2], bhi(ga.y) * acc[0][3] + bhi(gb.y) * acc[1][3]);
        *(v2u*)(MG + row * DM + c) = o;
    }
};
template <bool RB16> struct SEpiRes {
    const float* R; const bf16* RB; float* Y; bf16* YB; float* ss;
    __device__ __forceinline__ void operator()(const f32x4 (&acc)[1], int r, int c, int fq) const {
        const size_t off = (size_t)r * DM + c;
        f32x4 h;
        if (RB16) { const v2u p = *(const v2u*)(RB + off); h = (f32x4){blo(p.x), bhi(p.x), blo(p.y), bhi(p.y)} + acc[0]; *(f32x4*)(Y + off) = h; }
        else { h = *(const f32x4*)(R + off) + acc[0]; v2u w; w.x = pk2(h[0], h[1]); w.y = pk2(h[2], h[3]); *(v2u*)(YB + off) = w; }
        float sq = (h[0] * h[0] + h[1] * h[1]) + (h[2] * h[2] + h[3] * h[3]);
        sq += __shfl_xor(sq, 16); sq += __shfl_xor(sq, 32);
        if (fq == 0) atomicAdd(ss + r, sq);
    }
};

__global__ void __launch_bounds__(NTHR, 2) fwd_mega(Args a) {
    extern __shared__ __attribute__((aligned(16))) unsigned char lds_raw[];
    cg::grid_group grid = cg::this_grid();
    Frame F; F.lds = (LAS unsigned char*)lds_raw; F.tid = threadIdx.x; F.lane = F.tid & 63; F.wave = __builtin_amdgcn_readfirstlane(F.tid >> 6);
    F.G = gridDim.x; { const int bx = blockIdx.x; F.vcu = (F.G % 8 == 0) ? (bx % 8) * (F.G / 8) + bx / 8 : bx; }
    unsigned char* ws = a.ws; float* out = a.out;
    volatile LAS unsigned* bst = (volatile LAS unsigned*)(F.lds + 131072 + 64);
    if (F.tid < 2) bst[F.tid] = 0u;
    __syncthreads();
    bf16* XN = (bf16*)(ws + WS_XN); bf16* GLU = (bf16*)(ws + WS_GLU); bf16* UV = (bf16*)(ws + WS_UV); bf16* GG = (bf16*)(ws + WS_GG);
    bf16* MG = (bf16*)(ws + WS_MG); bf16* ACT = (bf16*)(ws + WS_ACT); bf16* ACTA = (bf16*)(out + O_Y);
    float* ss1 = (float*)(ws + WS_SS1); float* ss2 = (float*)(ws + WS_SS2);

    const XcdBarrier bar = xcd_barrier_post((unsigned*)(ws + WS_BAR), bst);
    if (a.ws == nullptr) grid.sync();
    p0_weights(F, a, 0, I_IN, F.vcu * NWAVES + F.wave, F.G * NWAVES);
    p0_rows(F, a);
    xcd_barrier(bar);
    { pg8::Gemm g{XN, (const bf16*)(ws + WS_WIN), MT, NIN, DM, DM}; pg8::StaticOrder S; S.init(MT, NIN, F.G, (int)blockIdx.x);
      pg8::EpiG1 E{GLU, UV, GG};
      pg8::gemm_phase<pg8::EpiG1, pg8::StaticOrder, true, true>(F.lds, g, S, E);
      const int nu = (MT / 256) * (NIN / 256), extra = nu % F.G;
      if (extra == 0) p0_weights(F, a, I_IN, NITEMS, (int)blockIdx.x * NWAVES + F.wave, F.G * NWAVES);
      else if ((int)blockIdx.x >= extra) p0_weights(F, a, I_IN, NITEMS, ((int)blockIdx.x - extra) * NWAVES + F.wave, (F.G - extra) * NWAVES); }
    xcd_barrier(bar);
    for (int u = F.vcu; u < 256; u += F.G) {
        mixB_prompt(F, a, UV, u >> 1, u & 1);
        { const int b = u >> 5, t0 = (u & 31) * 64; const bool last = (u & 31) == 31;
          convA_prompt(F, a, (const unsigned*)GLU, ACTA, (size_t)b * SEQ + t0, t0 > 0, last ? out + O_CAP + (size_t)b * 30 * DM : nullptr); }
        if (u < 128) convA_sample(F, a, (const unsigned*)GLU, ACTA, u, a.in[2] + (size_t)u * 30 * DM, out + O_CAS + (size_t)u * 30 * DM);
        else mixB_sample(F, a, UV, u - 128, out + O_VS);
    }
    xcd_barrier(bar);
    { const SmallSrc src[2] = {{ACTA + (size_t)MP * DM, DM, (const bf16*)(ws + WS_WA)}, {UV + (size_t)MP * 2048, 2048, (const bf16*)(ws + WS_WB)}};
      SEpiMerge E{MG, GG}; small_gemm<2, SEpiMerge>(F, src, DM, DM, E); }
    { pg8::Gemm g{ACTA, (const bf16*)(ws + WS_WA), MP, DM, DM, DM}; pg8::StaticOrder S; S.init(MP, DM, F.G, (int)blockIdx.x);
      pg8::EpiMerge<0> E{MG, GG};
      pg8::gemm_phase<pg8::EpiMerge<0>, pg8::StaticOrder, true, true>(F.lds, g, S, E); }
    { pg8::Gemm g{UV, (const bf16*)(ws + WS_WB), MP, DM, DM, 2048}; pg8::StaticOrder S; S.init(MP, DM, F.G, (int)blockIdx.x);
      pg8::EpiMerge<1> E{MG, GG};
      pg8::gemm_phase<pg8::EpiMerge<1>, pg8::StaticOrder, true, true>(F.lds, g, S, E); }
    xcd_barrier(bar);
    { const SmallSrc src[1] = {{MG + (size_t)MP * DM, DM, (const bf16*)(ws + WS_WO)}};
      SEpiRes<false> E{a.in[1], nullptr, nullptr, XN + (size_t)MP * DM, ss1 + MP}; small_gemm<1, SEpiRes<false>>(F, src, DM, DM, E); }
    { pg8::Gemm g{MG, (const bf16*)(ws + WS_WO), MP, DM, DM, DM}; pg8::StaticOrder S; S.init(MP, DM, F.G, (int)blockIdx.x);
      pg8::EpiRes<false> E{a.in[0], nullptr, nullptr, XN, ss1};
      pg8::gemm_phase<pg8::EpiRes<false>, pg8::StaticOrder, true, true>(F.lds, g, S, E); }
    xcd_barrier(bar);
    { pg8::Gemm g{XN, (const bf16*)(ws + WS_WUP), MT, NUP, DM, DM}; pg8::StaticOrder S; S.init(MT, NUP, F.G, (int)blockIdx.x);
      pg8::EpiUpFused E{ACT, ss1, a.in[19], a.in[20], a.in[3], (float*)(ws + WS_SL), (float*)(ws + WS_SF), out + O_FS};
      pg8::gemm_phase<pg8::EpiUpFused, pg8::StaticOrder, true, true>(F.lds, g, S, E); }
    xcd_barrier(bar);
    p6_fixup(F, a, out);
    xcd_barrier(bar);
    { const SmallSrc src[1] = {{ACT + (size_t)MP * DFF, DFF, (const bf16*)(ws + WS_WDN)}};
      SEpiRes<true> E{nullptr, XN + (size_t)MP * DM, out + O_Y + (size_t)MP * DM, nullptr, ss2 + MP}; small_gemm<1, SEpiRes<true>>(F, src, DFF, DM, E); }
    { pg8::Gemm g{ACT, (const bf16*)(ws + WS_WDN), MP, DM, DFF, DFF}; pg8::StaticOrder S; S.init(MP, DM, F.G, (int)blockIdx.x);
      pg8::EpiRes<true> E{nullptr, XN, out + O_Y, nullptr, ss2};
      pg8::gemm_phase<pg8::EpiRes<true>, pg8::StaticOrder, true, true>(F.lds, g, S, E); }
    xcd_barrier(bar);
    { const Frame F8 = phase_frame(F); const float* gf = a.in[22];
      for (int m = F8.vcu * NWAVES + F8.wave; m < MT; m += F.G * NWAVES) {
          f32x4* yr = (f32x4*)(out + O_Y + (size_t)m * DM) + F8.lane; const f32x4* gr = (const f32x4*)gf + F8.lane;
          const float rstd = 1.0f / sqrtf(ss2[m] * (1.f / DM) + EPS);
#pragma unroll
          for (int j = 0; j < 4; ++j) yr[64 * j] = yr[64 * j] * rstd * gr[64 * j]; } }
}

extern "C" void kernel_launch(void* const* d_in, const int* in_sizes, int n_in, void* d_out, int out_size, void* d_ws, size_t ws_size, hipStream_t stream) {
    static int grid = 0;
    if (grid == 0) {
        if (n_in != 23 || (size_t)out_size != O_END || ws_size < WS_END) { fprintf(stderr, "kernel_launch: unexpected shapes: n_in %d out %d ws %zu\n", n_in, out_size, ws_size); grid = -1; return; }
        int dev = 0, cus = 0, per_cu = 0;
        if (hipGetDevice(&dev) != hipSuccess || hipDeviceGetAttribute(&cus, hipDeviceAttributeMultiprocessorCount, dev) != hipSuccess) { grid = -1; return; }
        if (hipFuncSetAttribute((const void*)fwd_mega, hipFuncAttributeMaxDynamicSharedMemorySize, LDS_BYTES) != hipSuccess) { fprintf(stderr, "kernel_launch: hipFuncSetAttribute failed\n"); grid = -1; return; }
        if (hipOccupancyMaxActiveBlocksPerMultiprocessor(&per_cu, (const void*)fwd_mega, NTHR, LDS_BYTES) != hipSuccess || per_cu < 1) { fprintf(stderr, "kernel_launch: occupancy query says %d\n", per_cu); per_cu = 1; }
        (void)hipGetLastError();
        grid = cus * 1;
        fprintf(stderr, "kernel_launch: cus %d per_cu %d grid %d\n", cus, per_cu, grid);
    }
    if (grid < 0) return;
    if (hipMemsetAsync((char*)d_ws + WS_BAR, 0, XCD_BAR_WORDS * 4, stream) != hipSuccess) { fprintf(stderr, "kernel_launch: memset failed\n"); return; }
    Args a{};
    for (int i = 0; i < 23; ++i) a.in[i] = (const float*)d_in[i];
    a.out = (float*)d_out; a.ws = (unsigned char*)d_ws;
    void* args[] = {&a};
    hipError_t e = hipLaunchCooperativeKernel((const void*)fwd_mega, dim3(grid), dim3(NTHR), args, LDS_BYTES, stream);
    if (e != hipSuccess) fprintf(stderr, "kernel_launch: cooperative launch failed: %s (grid %d)\n", hipGetErrorString(e), grid);
}
```

```cpp
#include <hip/hip_runtime.h>
#include <hip/hip_cooperative_groups.h>
#include <cstdio>
#include <cstdint>
namespace cg = cooperative_groups;
namespace pg8 {
#define PG8_LAS __attribute__((address_space(3)))
typedef unsigned short bf16_t;
typedef short bf16x8 __attribute__((ext_vector_type(8)));
typedef float f32x4 __attribute__((ext_vector_type(4)));
typedef unsigned u32x4 __attribute__((ext_vector_type(4)));
constexpr int BM = 256, BK = 64, HALF = 128, HTB = HALF * BK * 2  , STAGE_BYTES = 8 * HTB, NXCD = 8, WGM = 8;

__host__ __device__ __forceinline__ int lds_byte(int r, int c) { const int st = (r >> 4) * 2 + (c >> 5), rr = r & 15, cc = c & 31, ob = rr * 64 + cc * 2; return st * 1024 + (ob ^ (((ob >> 9) & 1) << 5)); }
__host__ __device__ __forceinline__ void stage_rc(int b, int& R, int& C) { const int st = b / 1024, sb = b % 1024, swz = sb ^ (((sb >> 9) & 1) << 5); R = (st >> 1) * 16 + swz / 64; C = (st & 1) * 32 + (swz % 64) / 2; }
__host__ __device__ __forceinline__ int perm32(int rho) { const int n = rho >> 4, i = rho & 15; return 8 * (i >> 2) + 4 * n + (i & 3); }

struct Unit { int pm, pn; };
struct Gemm { const bf16_t* A; const bf16_t* Bt; int M, N, K, lda; };

struct StaticOrder {
    int nM, nN, nwg, G, c;
    __host__ __device__ void init(int M, int N, int G_, int c_) { nM = M / BM; nN = N / BM; nwg = nM * nN; G = G_; c = c_; }
    __host__ __device__ bool next(int i, Unit& u) const {
        const long L = (long)i * G + c; if (L >= nwg) return false;
        int wgid = (int)L; { const int q = nwg / NXCD, r = nwg % NXCD, xcd = wgid % NXCD, off = wgid / NXCD; wgid = (xcd < r ? xcd * (q + 1) : r * (q + 1) + (xcd - r) * q) + off; }
        const int nig = WGM * nN, gid = wgid / nig, fm = gid * WGM, gsz = (nM - fm) < WGM ? (nM - fm) : WGM;
        u.pm = fm + ((wgid % nig) % gsz); u.pn = (wgid % nig) / gsz; return true;
    }
    __device__ __forceinline__ void a_ready(const Unit&) const {}
    __device__ __forceinline__ void done(const Unit&) const {}
};

__device__ __forceinline__ unsigned cvt_pk_bf16(float lo, float hi) { unsigned r; asm volatile("v_cvt_pk_bf16_f32 %0, %1, %2" : "=v"(r) : "v"(lo), "v"(hi)); return r; }
typedef float f32x2 __attribute__((ext_vector_type(2)));
__device__ __forceinline__ f32x2 gelu_pk(f32x2 v) {
    const f32x2 av = __builtin_elementwise_abs(v), d = av * 0.2316418882f + 1.0f;
    f32x2 t; t.x = __builtin_amdgcn_rcpf(d.x); t.y = __builtin_amdgcn_rcpf(d.y);
    f32x2 q = t * 0.5307027145f + (-0.7265760135f); q = q * t + 0.7107068705f; q = q * t + (-0.142248368f); q = q * t + 0.127414796f; q = q * t;
    const f32x2 s = (v * v) * (-0.72134752044f);
    f32x2 e; e.x = __builtin_amdgcn_exp2f(s.x); e.y = __builtin_amdgcn_exp2f(s.y);
    const f32x2 m = v * (q * e), r = v - m;
    f32x2 o; o.x = v.x < 0.f ? m.x : r.x; o.y = v.y < 0.f ? m.y : r.y; return o;
}
typedef unsigned u32x2 __attribute__((ext_vector_type(2)));
__device__ __forceinline__ float sigm(float x) { return __builtin_amdgcn_rcpf(1.0f + __builtin_amdgcn_exp2f(x * -1.44269504089f)); }
__device__ __forceinline__ float bf_lo(unsigned u) { return __uint_as_float(u << 16); }
__device__ __forceinline__ float bf_hi(unsigned u) { return __uint_as_float(u & 0xffff0000u); }

struct EpiG1 {
    static constexpr bool PERM = true, AFTER_DRAIN = false;
    bf16_t* GLU; bf16_t* UV; bf16_t* GG;
    __device__ __forceinline__ void operator()(const f32x4 (&acc)[2][2][4][2], const Unit& u, int wr, int wc, int fr, int fq) const {
        const int row0 = u.pm * BM + wr * 64 + fr;
        if (u.pn < 8) {
            const int col = u.pn * 128 + wc * 32 + 8 * fq;
#pragma unroll
            for (int ai = 0; ai < 2; ++ai)
#pragma unroll
                for (int m = 0; m < 4; ++m) {
                    const f32x4 v0 = acc[ai][0][m][0], v1 = acc[ai][0][m][1], g0 = acc[ai][1][m][0], g1 = acc[ai][1][m][1];
                    u32x4 w; w.x = cvt_pk_bf16(v0[0] * sigm(g0[0]), v0[1] * sigm(g0[1])); w.y = cvt_pk_bf16(v0[2] * sigm(g0[2]), v0[3] * sigm(g0[3]));
                    w.z = cvt_pk_bf16(v1[0] * sigm(g1[0]), v1[1] * sigm(g1[1])); w.w = cvt_pk_bf16(v1[2] * sigm(g1[2]), v1[3] * sigm(g1[3]));
                    *(u32x4*)(GLU + (size_t)(row0 + ai * HALF + m * 16) * 1024 + col) = w; }
        } else {
            const bool isg = u.pn < 16;
            bf16_t* base = isg ? UV : GG;
            const int col0 = (isg ? (u.pn - 8) : (u.pn - 16)) * BM + wc * 32 + 8 * fq;
#pragma unroll
            for (int ai = 0; ai < 2; ++ai)
#pragma unroll
                for (int m = 0; m < 4; ++m) { bf16_t* rowp = base + (size_t)(row0 + ai * HALF + m * 16) * 2048 + col0;
#pragma unroll
                    for (int bj = 0; bj < 2; ++bj) { f32x4 v0 = acc[ai][bj][m][0], v1 = acc[ai][bj][m][1];
                        if (isg) { f32x2 a = gelu_pk((f32x2){v0[0], v0[1]}), b = gelu_pk((f32x2){v0[2], v0[3]}), c = gelu_pk((f32x2){v1[0], v1[1]}), d = gelu_pk((f32x2){v1[2], v1[3]});
                            v0 = (f32x4){a.x, a.y, b.x, b.y}; v1 = (f32x4){c.x, c.y, d.x, d.y}; }
                        else { v0 = (f32x4){sigm(v0[0]), sigm(v0[1]), sigm(v0[2]), sigm(v0[3])}; v1 = (f32x4){sigm(v1[0]), sigm(v1[1]), sigm(v1[2]), sigm(v1[3])}; }
                        u32x4 w; w.x = cvt_pk_bf16(v0[0], v0[1]); w.y = cvt_pk_bf16(v0[2], v0[3]); w.z = cvt_pk_bf16(v1[0], v1[1]); w.w = cvt_pk_bf16(v1[2], v1[3]);
                        *(u32x4*)(rowp + bj * HALF) = w; } }
        }
    }
};
template <int MODE> struct EpiMerge {
    static constexpr bool PERM = true, AFTER_DRAIN = false;
    bf16_t* MG; const bf16_t* GG;
    __device__ __forceinline__ void operator()(const f32x4 (&acc)[2][2][4][2], const Unit& u, int wr, int wc, int fr, int fq) const {
        const int row0 = u.pm * BM + wr * 64 + fr, col0 = u.pn * BM + wc * 32 + 8 * fq;
#pragma unroll
        for (int ai = 0; ai < 2; ++ai) {
            u32x4 gv[4][2], pv[4][2];
#pragma unroll
            for (int m = 0; m < 4; ++m)
#pragma unroll
                for (int bj = 0; bj < 2; ++bj) { const size_t row = (size_t)(row0 + ai * HALF + m * 16); const int col = col0 + bj * HALF;
                    gv[m][bj] = *(const u32x4*)(GG + row * 2048 + MODE * 1024 + col);
                    if (MODE == 1) pv[m][bj] = *(const u32x4*)(MG + row * 1024 + col); }
#pragma unroll
            for (int m = 0; m < 4; ++m)
#pragma unroll
                for (int bj = 0; bj < 2; ++bj) { const size_t row = (size_t)(row0 + ai * HALF + m * 16); const int col = col0 + bj * HALF;
                    const u32x4 g = gv[m][bj];
                    f32x4 v0 = acc[ai][bj][m][0], v1 = acc[ai][bj][m][1];
                    v0 = v0 * (f32x4){bf_lo(g.x), bf_hi(g.x), bf_lo(g.y), bf_hi(g.y)}; v1 = v1 * (f32x4){bf_lo(g.z), bf_hi(g.z), bf_lo(g.w), bf_hi(g.w)};
                    if (MODE == 1) { const u32x4 p = pv[m][bj];
                        v0 = v0 + (f32x4){bf_lo(p.x), bf_hi(p.x), bf_lo(p.y), bf_hi(p.y)}; v1 = v1 + (f32x4){bf_lo(p.z), bf_hi(p.z), bf_lo(p.w), bf_hi(p.w)}; }
                    u32x4 w; w.x = cvt_pk_bf16(v0[0], v0[1]); w.y = cvt_pk_bf16(v0[2], v0[3]); w.z = cvt_pk_bf16(v1[0], v1[1]); w.w = cvt_pk_bf16(v1[2], v1[3]);
                    *(u32x4*)(MG + row * 1024 + col) = w; }
            asm volatile("" ::: "memory"); }
    }
};
template <bool RB16> struct EpiRes {
    static constexpr bool PERM = false, AFTER_DRAIN = false;
    const float* R; const bf16_t* RB; float* Y; bf16_t* YB; float* ss;
    __device__ __forceinline__ void operator()(const f32x4 (&acc)[2][2][4][2], const Unit& u, int wr, int wc, int fr, int fq) const {
        const int row0 = u.pm * BM + wr * 64 + fr, col0 = u.pn * BM + wc * 32 + 4 * fq;
#pragma unroll
        for (int ai = 0; ai < 2; ++ai)
#pragma unroll
            for (int mh = 0; mh < 4; mh += 2) {
                f32x4 rv[2][2][2];
#pragma unroll
                for (int mm = 0; mm < 2; ++mm)
#pragma unroll
                    for (int bj = 0; bj < 2; ++bj)
#pragma unroll
                        for (int n = 0; n < 2; ++n) { const size_t off = (size_t)(row0 + ai * HALF + (mh + mm) * 16) * 1024 + col0 + bj * HALF + n * 16;
                            if (RB16) { const u32x2 p = *(const u32x2*)(RB + off); rv[mm][bj][n] = (f32x4){bf_lo(p.x), bf_hi(p.x), bf_lo(p.y), bf_hi(p.y)}; }
                            else rv[mm][bj][n] = *(const f32x4*)(R + off); }
#pragma unroll
                for (int mm = 0; mm < 2; ++mm) { const int m = mh + mm; const size_t row = (size_t)(row0 + ai * HALF + m * 16); float s = 0.f;
#pragma unroll
                    for (int bj = 0; bj < 2; ++bj)
#pragma unroll
                        for (int n = 0; n < 2; ++n) { const size_t off = row * 1024 + col0 + bj * HALF + n * 16;
                            const f32x4 h = rv[mm][bj][n] + acc[ai][bj][m][n];
                            if (RB16) *(f32x4*)(Y + off) = h;
                            else { u32x2 w; w.x = cvt_pk_bf16(h[0], h[1]); w.y = cvt_pk_bf16(h[2], h[3]); *(u32x2*)(YB + off) = w; }
                            s += (h[0] * h[0] + h[1] * h[1]) + (h[2] * h[2] + h[3] * h[3]); }
                    s += __shfl_xor(s, 16); s += __shfl_xor(s, 32);
                    if (fq == 0) atomicAdd(ss + row, s); }
                asm volatile("" ::: "memory"); }
    }
};
struct EpiUpFused {
    static constexpr bool PERM = true, AFTER_DRAIN = false;
    bf16_t* ACT; const float* ss; const float* dwf; const float* bdw; const float* stf; float* sideLast; float* sideFirst; float* out_fs;
    __device__ __forceinline__ void operator()(const f32x4 (&acc)[2][2][4][2], const Unit& u, int wr, int wc, int fr, int fq) const {
        constexpr int DFF_ = 2816, MP_ = 16384;
        const int cch = u.pn * 128 + wc * 32 + 8 * fq;
        const int lane = fq * 16 + fr, src1 = (lane & 48) | ((fr - 1) & 15), src2 = (lane & 48) | ((fr - 2) & 15);
        f32x4 w0[2], w1[2], w2[2], bs[2];
#pragma unroll
        for (int n = 0; n < 2; ++n) { w0[n] = *(const f32x4*)(dwf + cch + 4 * n); w1[n] = *(const f32x4*)(dwf + DFF_ + cch + 4 * n); w2[n] = *(const f32x4*)(dwf + 2 * DFF_ + cch + 4 * n); bs[n] = *(const f32x4*)(bdw + cch + 4 * n); }
        const bool sample = u.pm >= 64;
#pragma unroll
        for (int ai = 0; ai < 2; ++ai) {
            const int blk = u.pm * 4 + ai * 2 + wr;
            f32x4 p1[2], p2[2];
#pragma unroll
            for (int n = 0; n < 2; ++n) { p1[n] = (f32x4){0.f, 0.f, 0.f, 0.f}; p2[n] = (f32x4){0.f, 0.f, 0.f, 0.f}; }
#pragma unroll
            for (int m = 0; m < 4; ++m) {
                const int row = blk * 64 + 16 * m + fr;
                const float rs = __builtin_amdgcn_rsqf(ss[row] * (1.0f / 1024.0f) + 1e-6f);
                const int t4 = fr & 3, sq = (row - MP_) >> 2;
                u32x4 wout;
#pragma unroll
                for (int n = 0; n < 2; ++n) {
                    const f32x4 av = acc[ai][0][m][n] * rs, bv = acc[ai][1][m][n] * rs;
                    f32x4 r1, r2;
#pragma unroll
                    for (int j = 0; j < 4; ++j) { r1[j] = __shfl(av[j], src1); r2[j] = __shfl(av[j], src2); }
                    f32x4 x1, x2;
                    if (!sample) {
                        x1 = fr == 0 ? p1[n] : r1; x2 = fr < 2 ? p2[n] : r2;
                        if (m == 0 && fr < 2) { float* sf = sideFirst + ((size_t)(blk * 2 + fr) * 2) * DFF_ + cch + 4 * n; *(f32x4*)sf = av; *(f32x4*)(sf + DFF_) = bv; }
                        if (m == 3 && fr >= 14) *(f32x4*)(sideLast + (size_t)(blk * 2 + fr - 14) * DFF_ + cch + 4 * n) = av;
                    } else {
                        const f32x4 s0 = *(const f32x4*)(stf + ((size_t)sq * 2 + 0) * DFF_ + cch + 4 * n), s1 = *(const f32x4*)(stf + ((size_t)sq * 2 + 1) * DFF_ + cch + 4 * n);
                        x1 = t4 >= 1 ? r1 : s1; x2 = t4 >= 2 ? r2 : (t4 == 1 ? s1 : s0);
                        if (t4 >= 2) *(f32x4*)(out_fs + ((size_t)sq * 2 + (t4 - 2)) * DFF_ + cch + 4 * n) = av;
                    }
                    p1[n] = r1; p2[n] = r2;
                    const f32x4 cv = w0[n] * x2 + w1[n] * x1 + w2[n] * av + bs[n];
                    const f32x2 g0 = gelu_pk((f32x2){cv[0], cv[1]}), g1 = gelu_pk((f32x2){cv[2], cv[3]});
                    const unsigned lo = cvt_pk_bf16(g0.x * bv[0], g0.y * bv[1]), hi = cvt_pk_bf16(g1.x * bv[2], g1.y * bv[3]);
                    if (n == 0) { wout.x = lo; wout.y = hi; } else { wout.z = lo; wout.w = hi; }
                }
                *(u32x4*)(ACT + (size_t)row * DFF_ + cch) = wout;
            }
        }
    }
};
template <class Epi, class Sched, bool ALIGN_EPI = false, bool SP2 = false>
__device__ __forceinline__ void gemm_phase(PG8_LAS unsigned char* lds, const Gemm g, const Sched& S, const Epi& E) {
    int tid_ = threadIdx.x; asm volatile("" : "+v"(tid_));
    const int tid = tid_, wid = __builtin_amdgcn_readfirstlane(tid >> 6), lane = tid & 63, wr = wid >> 2, wc = wid & 3, fr = lane & 15, fq = lane >> 4;
    const int K = g.K, nt = K / BK;
    unsigned voffA[2], voffB[2];
#pragma unroll
    for (int i = 0; i < 2; ++i) { int R, C; stage_rc(tid * 16 + i * 8192, R, C); const int Rb = Epi::PERM ? ((R & ~31) + perm32(R & 31)) : R;
        voffA[i] = (unsigned)(R * g.lda + C) * 2u; voffB[i] = (unsigned)(Rb * K + C) * 2u; }
    const size_t kstep = (size_t)(BK * 2);
    const size_t hA = (size_t)HALF * g.lda * 2, hB = (size_t)HALF * K * 2;
    const size_t tA = 2 * hA, tB = 2 * hB;
    const unsigned ldsw = (unsigned)wid * 1024u;
    const int aoff = lds_byte(wr * 64 + fr, fq * 8), boff = lds_byte(wc * 32 + fr, fq * 8);
#define PG8_SA(b, h) (((b) * 2 + (h)) * HTB)
#define PG8_SB(b, h) ((4 + (b) * 2 + (h)) * HTB)
#define PG8_STAGE(bufoff, gbase, voff) do { _Pragma("unroll") for (int _i = 0; _i < 2; ++_i) \
        __builtin_amdgcn_global_load_lds((const unsigned*)((const char*)(gbase) + (voff)[_i]), (PG8_LAS unsigned*)(lds + (bufoff) + ldsw + _i * 8192), 16, 0, 0); } while (0)
#define PG8_LDA(dst, b, h) do { _Pragma("unroll") for (int m = 0; m < 4; ++m) _Pragma("unroll") for (int k = 0; k < 2; ++k) dst[m][k] = *(const PG8_LAS bf16x8*)(lds + PG8_SA(b, h) + aoff + m * 2048 + k * 1024); } while (0)
#define PG8_LDB(dst, b, h) do { _Pragma("unroll") for (int n = 0; n < 2; ++n) _Pragma("unroll") for (int k = 0; k < 2; ++k) dst[n][k] = *(const PG8_LAS bf16x8*)(lds + PG8_SB(b, h) + boff + n * 2048 + k * 1024); } while (0)
#define PG8_MMA(ai, bj, At, Bt) do { __builtin_amdgcn_s_setprio(1); _Pragma("unroll") for (int m = 0; m < 4; ++m) _Pragma("unroll") for (int n = 0; n < 2; ++n) _Pragma("unroll") for (int k = 0; k < 2; ++k) \
        acc[ai][bj][m][n] = __builtin_amdgcn_mfma_f32_16x16x32_bf16(Bt[n][k], At[m][k], acc[ai][bj][m][n], 0, 0, 0); __builtin_amdgcn_s_setprio(0); } while (0)
#define PG8_WAIT_V(n) asm volatile("s_waitcnt vmcnt(" #n ")" ::: "memory")
#define PG8_WAIT_L(n) asm volatile("s_waitcnt lgkmcnt(" #n ")" ::: "memory")
#define PG8_BAR __builtin_amdgcn_s_barrier()
#define PG8_SCHED __builtin_amdgcn_sched_barrier(0)
    Unit cur, nxt; int ui = 0;
    if (!S.next(0, cur)) return;
    f32x4 acc[2][2][4][2];
#pragma unroll
    for (int a = 0; a < 2; ++a)
#pragma unroll
        for (int b = 0; b < 2; ++b)
#pragma unroll
            for (int m = 0; m < 4; ++m)
#pragma unroll
                for (int n = 0; n < 2; ++n) acc[a][b][m][n] = (f32x4){0.f, 0.f, 0.f, 0.f};
    bf16x8 At[4][2], B0[2][2], B1[2][2];
    const char* cA = (const char*)g.A + (size_t)cur.pm * tA; const char* cB = (const char*)g.Bt + (size_t)cur.pn * tB;
    S.a_ready(cur);
    if constexpr (SP2) {
        PG8_STAGE(PG8_SB(0, 0), cB, voffB); PG8_STAGE(PG8_SB(0, 1), cB + hB, voffB); PG8_STAGE(PG8_SA(0, 0), cA, voffA); PG8_STAGE(PG8_SA(0, 1), cA + hA, voffA);
        if (wr == 1) PG8_BAR;
        PG8_WAIT_V(2); PG8_BAR;
        PG8_STAGE(PG8_SB(1, 0), cB + kstep, voffB); PG8_STAGE(PG8_SA(1, 0), cA + kstep, voffA); PG8_STAGE(PG8_SB(1, 1), cB + hB + kstep, voffB);
        PG8_WAIT_V(6); PG8_BAR;
    } else {
        PG8_STAGE(PG8_SB(0, 0), cB, voffB); PG8_STAGE(PG8_SA(0, 0), cA, voffA); PG8_STAGE(PG8_SB(0, 1), cB + hB, voffB); PG8_STAGE(PG8_SA(0, 1), cA + hA, voffA);
        if (wr == 1) PG8_BAR;
        PG8_WAIT_V(4); PG8_BAR;
        PG8_STAGE(PG8_SB(1, 0), cB + kstep, voffB); PG8_STAGE(PG8_SA(1, 0), cA + kstep, voffA); PG8_STAGE(PG8_SB(1, 1), cB + hB + kstep, voffB);
        PG8_WAIT_V(6); PG8_BAR;
    }
    for (;;) {
        const bool has_next = S.next(ui + 1, nxt);
        const char* nA = has_next ? (const char*)g.A + (size_t)nxt.pm * tA : cA; const char* nB = has_next ? (const char*)g.Bt + (size_t)nxt.pn * tB : cB;
        for (int t = 0; t < nt; t += 2) {
            const bool last = (t == nt - 2);
            const char* a1 = cA + (size_t)(t + 1) * kstep;
            const char* a2 = last ? nA : cA + (size_t)(t + 2) * kstep; const char* b2 = last ? nB : cB + (size_t)(t + 2) * kstep;
            const char* a3 = a2 + kstep; const char* b3 = b2 + kstep;
            if (last && has_next) S.a_ready(nxt);
            if constexpr (SP2) {
            PG8_LDB(B0, 0, 0); PG8_LDB(B1, 0, 1); PG8_SCHED; PG8_LDA(At, 0, 0); PG8_STAGE(PG8_SA(1, 1), a1 + hA, voffA);
            PG8_WAIT_V(8); PG8_WAIT_L(0); PG8_BAR; PG8_MMA(0, 0, At, B0); PG8_MMA(0, 1, At, B1); PG8_BAR; PG8_SCHED;
            PG8_LDA(At, 0, 1); PG8_STAGE(PG8_SB(0, 0), b2, voffB); PG8_STAGE(PG8_SB(0, 1), b2 + hB, voffB); PG8_STAGE(PG8_SA(0, 0), a2, voffA);
            PG8_WAIT_V(8); PG8_WAIT_L(0); PG8_BAR; PG8_MMA(1, 0, At, B0); PG8_MMA(1, 1, At, B1); PG8_BAR; PG8_SCHED;
            PG8_LDB(B0, 1, 0); PG8_LDB(B1, 1, 1); PG8_SCHED; PG8_LDA(At, 1, 0); PG8_STAGE(PG8_SA(0, 1), a2 + hA, voffA);
            PG8_WAIT_V(8); PG8_WAIT_L(0); PG8_BAR; PG8_MMA(0, 0, At, B0); PG8_MMA(0, 1, At, B1); PG8_BAR; PG8_SCHED;
            PG8_LDA(At, 1, 1); PG8_STAGE(PG8_SB(1, 0), b3, voffB); PG8_STAGE(PG8_SB(1, 1), b3 + hB, voffB); PG8_STAGE(PG8_SA(1, 0), a3, voffA);
            PG8_WAIT_V(8); PG8_WAIT_L(0); PG8_BAR; PG8_MMA(1, 0, At, B0); PG8_MMA(1, 1, At, B1); PG8_BAR; PG8_SCHED;
            } else {
            PG8_LDB(B0, 0, 0); PG8_SCHED; PG8_LDA(At, 0, 0); PG8_STAGE(PG8_SA(1, 1), a1 + hA, voffA);
            PG8_WAIT_L(8); PG8_BAR; PG8_WAIT_L(0); PG8_MMA(0, 0, At, B0); PG8_BAR; PG8_SCHED;
            PG8_LDB(B1, 0, 1); PG8_STAGE(PG8_SB(0, 0), b2, voffB);
            PG8_BAR; PG8_WAIT_L(0); PG8_MMA(0, 1, At, B1); PG8_BAR;
            PG8_LDA(At, 0, 1); PG8_STAGE(PG8_SA(0, 0), a2, voffA);
            PG8_BAR; PG8_WAIT_L(0); PG8_MMA(1, 0, At, B0); PG8_BAR; PG8_SCHED;
            PG8_STAGE(PG8_SB(0, 1), b2 + hB, voffB);
            PG8_WAIT_V(6); PG8_BAR; PG8_MMA(1, 1, At, B1); PG8_BAR;
            PG8_LDB(B0, 1, 0); PG8_SCHED; PG8_LDA(At, 1, 0); PG8_STAGE(PG8_SA(0, 1), a2 + hA, voffA);
            PG8_WAIT_L(8); PG8_BAR; PG8_WAIT_L(0); PG8_MMA(0, 0, At, B0); PG8_BAR; PG8_SCHED;
            PG8_LDB(B1, 1, 1); PG8_STAGE(PG8_SB(1, 0), b3, voffB);
            PG8_BAR; PG8_WAIT_L(0); PG8_MMA(0, 1, At, B1); PG8_BAR;
            PG8_LDA(At, 1, 1); PG8_STAGE(PG8_SA(1, 0), a3, voffA);
            PG8_BAR; PG8_WAIT_L(0); PG8_MMA(1, 0, At, B0); PG8_BAR; PG8_SCHED;
            PG8_STAGE(PG8_SB(1, 1), b3 + hB, voffB);
            PG8_WAIT_V(6); PG8_BAR; PG8_MMA(1, 1, At, B1); PG8_BAR;
            }
        }
        if constexpr (ALIGN_EPI) { if (wr == 0) PG8_BAR; }
        if constexpr (!Epi::AFTER_DRAIN) { E(acc, cur, wr, wc, fr, fq); S.done(cur); }
        if (!has_next) break;
#pragma unroll
        for (int a = 0; a < 2; ++a)
#pragma unroll
            for (int b = 0; b < 2; ++b)
#pragma unroll
                for (int m = 0; m < 4; ++m)
#pragma unroll
                    for (int n = 0; n < 2; ++n) acc[a][b][m][n] = (f32x4){0.f, 0.f, 0.f, 0.f};
        cur = nxt; cA = nA; cB = nB; ++ui;
        if constexpr (ALIGN_EPI) { if (wr == 1) PG8_BAR; }
    }
    PG8_WAIT_V(0);
    if constexpr (!ALIGN_EPI) { if (wr == 0) PG8_BAR; }
    PG8_BAR;
    if constexpr (Epi::AFTER_DRAIN) { E.fused(acc, cur, wr, wc, fr, fq, lds, wid, lane); S.done(cur); }
#undef PG8_SA
#undef PG8_SB
#undef PG8_STAGE
#undef PG8_LDA
#undef PG8_LDB
#undef PG8_MMA
#undef PG8_WAIT_V
#undef PG8_WAIT_L
#undef PG8_BAR
#undef PG8_SCHED
}
}

constexpr int DM = 1024, NBP = 8, SEQ = 2048, NBS = 128, TS = 4, MP = NBP * SEQ, MS = NBS * TS, MT = MP + MS;
constexpr int NIN = 6144, DFF = 2816, NUP = 2 * DFF, CAW = 31, HB = 8;
constexpr float EPS = 1e-6f;
constexpr int NWAVES = 8, NTHR = 512;
constexpr size_t O_Y = 0, O_CAP = (size_t)MT * DM, O_CAS = O_CAP + (size_t)NBP * 30 * DM, O_VS = O_CAS + (size_t)NBS * 30 * DM, O_FP = O_VS + (size_t)MS * DM, O_FS = O_FP + (size_t)NBP * 2 * DFF, O_END = O_FS + (size_t)NBS * 2 * DFF;
constexpr size_t MiB = 1u << 20;
constexpr size_t WS_SS1 = 0, WS_SS2 = 128 * 1024, WS_BAR = 512 * 1024;
constexpr size_t WS_WUP = 1 * MiB, WS_WDN = 12 * MiB, WS_WIN = 18 * MiB, WS_WA = 30 * MiB, WS_WB = 32 * MiB, WS_WO = 34 * MiB;
constexpr size_t WS_XN = 36 * MiB;
constexpr size_t WS_GLU = 69 * MiB, WS_UV = 102 * MiB, WS_GG = 168 * MiB;
constexpr size_t WS_MG = WS_GLU;
constexpr size_t WS_ACT = WS_GLU;
constexpr size_t WS_SL = 192 * MiB, WS_SF = 200 * MiB;
constexpr size_t WS_END = WS_SF + (size_t)256 * 4 * DFF * 4;
static_assert(WS_ACT + (size_t)MT * DFF * 2 <= WS_SL && WS_SL + (size_t)256 * 2 * DFF * 4 <= WS_SF && WS_END <= 256 * MiB && WS_GG + (size_t)MT * 2048 * 2 <= 256 * MiB, "d_ws map");
constexpr int LDS_BYTES = 147456;

#define LAS __attribute__((address_space(3)))
typedef unsigned short bf16;
typedef unsigned v4u __attribute__((ext_vector_type(4)));
typedef unsigned v2u __attribute__((ext_vector_type(2)));
typedef float f32x4 __attribute__((ext_vector_type(4)));
typedef float f32x2 __attribute__((ext_vector_type(2)));
typedef short bf16x8 __attribute__((ext_vector_type(8)));
#define LDS_WAIT() asm volatile("s_waitcnt lgkmcnt(0)" ::: "memory")
__device__ __forceinline__ unsigned f2bf(float f) { unsigned u = __builtin_bit_cast(unsigned, f); return (u + 0x7fffu + ((u >> 16) & 1u)) >> 16; }
__device__ __forceinline__ unsigned pk2(float lo, float hi) { return f2bf(lo) | (f2bf(hi) << 16); }
__device__ __forceinline__ float blo(unsigned u) { return __uint_as_float(u << 16); }
__device__ __forceinline__ float bhi(unsigned u) { return __uint_as_float(u & 0xffff0000u); }
__device__ __forceinline__ float sigmf(float x) { return __builtin_amdgcn_rcpf(1.0f + __builtin_amdgcn_exp2f(x * -1.44269504089f)); }
__device__ __forceinline__ float wave_sum(float v) {
#pragma unroll
    for (int o = 1; o < 64; o <<= 1) v += __shfl_xor(v, o);
    return v;
}

struct Args { const float* in[23]; float* out; unsigned char* ws; };
struct Frame { LAS unsigned char* lds; int tid, lane, wave, vcu, G; };
__device__ __forceinline__ Frame phase_frame(const Frame& F0) { Frame F = F0; int t = F0.tid; asm volatile("" : "+v"(t)); F.tid = t; F.lane = t & 63; return F; }

#define XB_TMO      128
#define XB_XCNT(j)  (256  + 64 * (j))
#define XB_XSUB(j)  (1280 + 64 * (j))
#define XB_XGEN(j)  (2304 + 64 * (j))
#define XB_TOP      3328
#define XB_TOPGEN   3392
#define XCD_BAR_WORDS 3456
#define XB_SPIN_CAP (1u << 18)

__device__ __forceinline__ unsigned xb_ld(unsigned* p)              { return __hip_atomic_load(p, __ATOMIC_RELAXED, __HIP_MEMORY_SCOPE_AGENT); }
__device__ __forceinline__ unsigned xb_add(unsigned* p, unsigned v) { return __hip_atomic_fetch_add(p, v, __ATOMIC_RELAXED, __HIP_MEMORY_SCOPE_AGENT); }
__device__ __forceinline__ unsigned xb_xcc_id() { return (unsigned)__builtin_amdgcn_s_getreg((3 << 11) | 20) & 0xFu; }
#define XB_SPIN(cond, bar) do { unsigned _sp = 0; while (cond) { __builtin_amdgcn_s_sleep(1); \
    if ((++_sp & 255u) == 0u) { if (xb_ld(&(bar)[XB_TMO])) break; if (_sp > XB_SPIN_CAP) { atomicAdd(&(bar)[XB_TMO], 1u); break; } } } } while (0)

struct XcdBarrier {
    unsigned* bar; unsigned x;
    volatile LAS unsigned* st;
};

__device__ __forceinline__ XcdBarrier xcd_barrier_post(unsigned* bar, volatile LAS unsigned* st) {
    XcdBarrier b; b.bar = bar; b.x = xb_xcc_id(); b.st = st;
    if (threadIdx.x == 0) (void)xb_add(&bar[XB_XCNT(b.x)], 1u);
    return b;
}
__device__ __forceinline__ void xcd_barrier_complete(unsigned* bar, unsigned x, unsigned& nloc, unsigned& nx) {
    const unsigned G = gridDim.x * gridDim.y * gridDim.z;
    unsigned sum, cnt, mine, sp = 0u;
    for (;;) {
        sum = 0u; cnt = 0u; mine = 0u;
#pragma unroll
        for (unsigned j = 0; j < 16; ++j) { const unsigned c = xb_ld(&bar[XB_XCNT(j)]); sum += c; cnt += (c > 0u) ? 1u : 0u; mine = (j == x) ? c : mine; }
        if (sum == G) break;
        __builtin_amdgcn_s_sleep(1);
        if ((++sp & 255u) == 0u) { if (xb_ld(&bar[XB_TMO])) break; if (sp > XB_SPIN_CAP) { atomicAdd(&bar[XB_TMO], 1u); break; } }
    }
    nloc = mine > 0u ? mine : 1u; nx = cnt > 0u ? cnt : 1u;
}

__device__ __forceinline__ void xcd_barrier(const XcdBarrier& b) {
    asm volatile("s_waitcnt vmcnt(0)" ::: "memory");
    __syncthreads();
    if (threadIdx.x == 0) {
        unsigned* bar = b.bar;
        __builtin_amdgcn_s_waitcnt(0);
        unsigned nloc = b.st[0], nx = b.st[1];
        if (nloc == 0u) { xcd_barrier_complete(bar, b.x, nloc, nx); b.st[0] = nloc; b.st[1] = nx; }
        const unsigned old = xb_add(&bar[XB_XSUB(b.x)], 1u);
        const unsigned gen = old / nloc;
        if (old + 1u == (gen + 1u) * nloc) {
            __builtin_amdgcn_fence(__ATOMIC_RELEASE, "agent");
            asm volatile("s_waitcnt vmcnt(0)" ::: "memory");
            const unsigned og = xb_add(&bar[XB_TOP], 1u);
            const unsigned tg = og / nx;
            if (og + 1u == (tg + 1u) * nx) xb_add(&bar[XB_TOPGEN], 1u);
            else XB_SPIN(xb_ld(&bar[XB_TOPGEN]) == tg, bar);
            __builtin_amdgcn_fence(__ATOMIC_ACQUIRE, "agent");
            xb_add(&bar[XB_XGEN(b.x)], 1u);
            asm volatile("s_waitcnt vmcnt(0)" ::: "memory");
        } else {
            XB_SPIN(xb_ld(&bar[XB_XGEN(b.x)]) == gen, bar);
            __builtin_amdgcn_fence(__ATOMIC_ACQUIRE, "agent");
            asm volatile("s_waitcnt vmcnt(0)" ::: "memory");
        }
    }
    __syncthreads();
}

__device__ __forceinline__ void p0_transpose_item(const float* W, int K, int N, bf16* WT, int mode, const float* kscale, LAS float* scr, int item, int lane) {
    const int nblk = N / 32, kb = item / nblk, nb = item % nblk, k0 = 64 * kb, n0 = 32 * nb;
    float tv[32];
    const float* wp = W + (size_t)(k0 + (lane >> 5)) * N + n0 + (lane & 31);
#pragma unroll
    for (int i = 0; i < 32; ++i) tv[i] = wp[(size_t)(2 * i) * N];
    if (kscale) {
#pragma unroll
        for (int i = 0; i < 32; ++i) tv[i] *= kscale[k0 + 2 * i + (lane >> 5)];
    }
#pragma unroll
    for (int i = 0; i < 32; ++i) scr[(2 * i + (lane >> 5)) * 33 + (lane & 31)] = tv[i];
    LDS_WAIT(); asm volatile("" ::: "memory");
    int n0m = n0;
    if (mode == 1 && n0 < 2048) { const int half = n0 >= 1024 ? 1 : 0, ch = n0 - 1024 * half; n0m = 256 * (ch >> 7) + 128 * half + (ch & 127); }
    if (mode == 2) { const int half = n0 >= 2816 ? 1 : 0, ch = n0 - 2816 * half; n0m = 256 * (ch >> 7) + 128 * half + (ch & 127); }
    const int c = lane & 7;
#pragma unroll
    for (int j = 0; j < 4; ++j) { const int n = (lane >> 3) + 8 * j; const LAS float* s = scr + (8 * c) * 33 + n;
        v4u o; o.x = pk2(s[0 * 33], s[1 * 33]); o.y = pk2(s[2 * 33], s[3 * 33]); o.z = pk2(s[4 * 33], s[5 * 33]); o.w = pk2(s[6 * 33], s[7 * 33]);
        *(v4u*)(WT + (size_t)(n0m + n) * K + k0 + 8 * c) = o; }
    LDS_WAIT(); asm volatile("" ::: "memory");
}
__device__ __forceinline__ void rms_row_to_bf16(const float* xrow, const float* g, bf16* orow, int lane) {
    const f32x4* xr = (const f32x4*)xrow + lane; const f32x4* gr = (const f32x4*)g + lane;
    f32x4 v[4]; float s = 0.f;
#pragma unroll
    for (int j = 0; j < 4; ++j) { v[j] = xr[64 * j]; s += (v[j].x * v[j].x + v[j].y * v[j].y) + (v[j].z * v[j].z + v[j].w * v[j].w); }
    const float rstd = 1.0f / sqrtf(wave_sum(s) * (1.f / DM) + EPS);
    unsigned long long* o8 = (unsigned long long*)orow + lane;
#pragma unroll
    for (int j = 0; j < 4; ++j) { const f32x4 gg = gr[64 * j]; o8[64 * j] = (unsigned long long)pk2(v[j].x * rstd * gg.x, v[j].y * rstd * gg.y) | ((unsigned long long)pk2(v[j].z * rstd * gg.z, v[j].w * rstd * gg.w) << 32); }
}
constexpr int I_IN = (DM / 64) * (NIN / 32), I_SQ = (DM / 64) * (DM / 32), I_UP = (DM / 64) * (NUP / 32), I_DN = (DFF / 64) * (DM / 32), NITEMS = I_IN + 3 * I_SQ + I_UP + I_DN;
__device__ __forceinline__ void p0_weights(const Frame& F0, const Args& a, int it_lo, int it_hi, int widx, int wcnt) {
    const Frame F = phase_frame(F0);
    unsigned char* ws = a.ws;
    LAS float* scr = (LAS float*)(F.lds + F.wave * 16384);
    for (int it = it_lo + widx; it < it_hi; it += wcnt) {
        int r = it;
        if (r < I_IN) { p0_transpose_item(a.in[5], DM, NIN, (bf16*)(ws + WS_WIN), 1, nullptr, scr, r, F.lane); continue; } r -= I_IN;
        if (r < I_SQ) { p0_transpose_item(a.in[10], DM, DM, (bf16*)(ws + WS_WA), 0, nullptr, scr, r, F.lane); continue; } r -= I_SQ;
        if (r < I_SQ) { p0_transpose_item(a.in[15], DM, DM, (bf16*)(ws + WS_WB), 0, nullptr, scr, r, F.lane); continue; } r -= I_SQ;
        if (r < I_SQ) { p0_transpose_item(a.in[16], DM, DM, (bf16*)(ws + WS_WO), 0, nullptr, scr, r, F.lane); continue; } r -= I_SQ;
        if (r < I_UP) { p0_transpose_item(a.in[18], DM, NUP, (bf16*)(ws + WS_WUP), 2, a.in[17], scr, r, F.lane); continue; } r -= I_UP;
        p0_transpose_item(a.in[21], DFF, DM, (bf16*)(ws + WS_WDN), 0, nullptr, scr, r, F.lane);
    }
}
__device__ __forceinline__ void p0_rows(const Frame& F0, const Args& a) {
    const Frame F = phase_frame(F0);
    unsigned char* ws = a.ws;
    const int gw = F.vcu * NWAVES + F.wave, NGW = F.G * NWAVES;
    bf16* XN = (bf16*)(ws + WS_XN);
    for (int m = gw; m < MT; m += 2 * NGW) {
        const int m2 = m + NGW; const bool has2 = m2 < MT; const int mb = has2 ? m2 : m;
        const float* xa = m < MP ? a.in[0] + (size_t)m * DM : a.in[1] + (size_t)(m - MP) * DM;
        const float* xb = mb < MP ? a.in[0] + (size_t)mb * DM : a.in[1] + (size_t)(mb - MP) * DM;
        const f32x4* pa = (const f32x4*)xa + F.lane; const f32x4* pb = (const f32x4*)xb + F.lane; const f32x4* gr = (const f32x4*)a.in[4] + F.lane;
        f32x4 va[4], vb[4]; float sa = 0.f, sb = 0.f;
#pragma unroll
        for (int j = 0; j < 4; ++j) { va[j] = pa[64 * j]; vb[j] = pb[64 * j]; }
#pragma unroll
        for (int j = 0; j < 4; ++j) { sa += (va[j].x * va[j].x + va[j].y * va[j].y) + (va[j].z * va[j].z + va[j].w * va[j].w); sb += (vb[j].x * vb[j].x + vb[j].y * vb[j].y) + (vb[j].z * vb[j].z + vb[j].w * vb[j].w); }
#pragma unroll
        for (int o = 1; o < 64; o <<= 1) { sa += __shfl_xor(sa, o); sb += __shfl_xor(sb, o); }
        const float ra = 1.0f / sqrtf(sa * (1.f / DM) + EPS), rb = 1.0f / sqrtf(sb * (1.f / DM) + EPS);
        unsigned long long* oa = (unsigned long long*)(XN + (size_t)m * DM) + F.lane; unsigned long long* ob = (unsigned long long*)(XN + (size_t)mb * DM) + F.lane;
#pragma unroll
        for (int j = 0; j < 4; ++j) { const f32x4 gg = gr[64 * j];
            oa[64 * j] = (unsigned long long)pk2(va[j].x * ra * gg.x, va[j].y * ra * gg.y) | ((unsigned long long)pk2(va[j].z * ra * gg.z, va[j].w * ra * gg.w) << 32);
            if (has2) ob[64 * j] = (unsigned long long)pk2(vb[j].x * rb * gg.x, vb[j].y * rb * gg.y) | ((unsigned long long)pk2(vb[j].z * rb * gg.z, vb[j].w * rb * gg.w) << 32); }
    }
    float* ss = (float*)(ws + WS_SS1);
    for (int i = F.vcu * NTHR + F.tid; i < (int)(2 * WS_SS2 / 4); i += F.G * NTHR) ss[i] = 0.f;
}

__device__ __forceinline__ void ln_silu_row(const LAS float* src, bf16* dst, const float* g, const float* bt, int lane) {
    f32x4 v[4]; float s = 0.f;
#pragma unroll
    for (int j = 0; j < 4; ++j) { v[j] = *(const LAS f32x4*)(src + 4 * lane + 256 * j); s += (v[j].x + v[j].y) + (v[j].z + v[j].w); }
    const float mean = wave_sum(s) * (1.f / DM); float s2 = 0.f;
#pragma unroll
    for (int j = 0; j < 4; ++j) { v[j] = v[j] - mean; s2 += (v[j].x * v[j].x + v[j].y * v[j].y) + (v[j].z * v[j].z + v[j].w * v[j].w); }
    const float rstd = 1.0f / sqrtf(wave_sum(s2) * (1.f / DM) + EPS);
#pragma unroll
    for (int j = 0; j < 4; ++j) { const f32x4 gg = *(const f32x4*)(g + 4 * lane + 256 * j), bb = *(const f32x4*)(bt + 4 * lane + 256 * j);
        f32x4 y = v[j] * rstd * gg + bb; y = (f32x4){y.x * sigmf(y.x), y.y * sigmf(y.y), y.z * sigmf(y.z), y.w * sigmf(y.w)};
        v2u w; w.x = pk2(y.x, y.y); w.y = pk2(y.z, y.w); *(v2u*)(dst + 4 * lane + 256 * j) = w; }
}
__device__ __forceinline__ void convA_prompt(const Frame& F0, const Args& a, const unsigned* G32, bf16* ACTA, size_t grow0, bool has_hist, float* capout) {
    const Frame F = phase_frame(F0);
    const int c0 = 2 * F.tid;
    LAS float* CB = (LAS float*)F.lds;
    const float* dw = a.in[6];
    f32x2 w[CAW];
#pragma unroll
    for (int k = 0; k < CAW; ++k) w[k] = *(const f32x2*)(dw + k * DM + c0);
    const f32x2 bias = *(const f32x2*)(a.in[7] + c0);
    f32x2 ring[32];
#pragma unroll
    for (int j = 0; j < 32; ++j) ring[j] = (f32x2){0.f, 0.f};
    if (has_hist) {
        const unsigned* hp = G32 + (grow0 - 30) * 512 + F.tid;
#pragma unroll
        for (int j = 0; j < 30; ++j) { const unsigned u = hp[(size_t)j * 512]; ring[2 + j] = (f32x2){blo(u), bhi(u)}; }
    }
    for (int base = 0; base < 64; base += 32) {
        const unsigned* gp = G32 + (grow0 + base) * 512 + F.tid;
#pragma unroll
        for (int jg = 0; jg < 32; jg += 8) {
            unsigned tmp[8];
#pragma unroll
            for (int jj = 0; jj < 8; ++jj) tmp[jj] = gp[(size_t)(jg + jj) * 512];
#pragma unroll
            for (int jj = 0; jj < 8; ++jj) {
                const int j = jg + jj;
                const f32x2 nv = (f32x2){blo(tmp[jj]), bhi(tmp[jj])};
                ring[j] = nv;
                f32x2 o = bias;
#pragma unroll
                for (int k = 0; k < CAW; ++k) o += ring[(j + k + 2) & 31] * w[k];
                *(LAS f32x2*)(CB + j * DM + c0) = o;
            }
            __builtin_amdgcn_sched_barrier(0);
        }
        if (capout && base == 32) {
#pragma unroll
            for (int j = 2; j < 32; ++j) *(f32x2*)(capout + (size_t)(j - 2) * DM + c0) = ring[j];
        }
        __syncthreads();
#pragma unroll 1
        for (int r = F.wave; r < 32; r += NWAVES) ln_silu_row(CB + r * DM, ACTA + (grow0 + base + r) * DM, a.in[8], a.in[9], F.lane);
        __syncthreads();
    }
}
__device__ __forceinline__ void convA_sample(const Frame& F0, const Args& a, const unsigned* G32, bf16* ACTA, int s, const float* hst, float* casout) {
    const Frame F = phase_frame(F0);
    const int c0 = 2 * F.tid;
    LAS float* CB = (LAS float*)F.lds;
    const float* dw = a.in[6];
    f32x2 w[CAW];
#pragma unroll
    for (int k = 0; k < CAW; ++k) w[k] = *(const f32x2*)(dw + k * DM + c0);
    const f32x2 bias = *(const f32x2*)(a.in[7] + c0);
    f32x2 o[4] = {bias, bias, bias, bias};
    const size_t grow0 = (size_t)MP + 4 * s;
#pragma unroll
    for (int i = 0; i < 34; ++i) {
        f32x2 x;
        if (i < 30) x = *(const f32x2*)(hst + i * DM + c0);
        else { const unsigned u = G32[(grow0 + (i - 30)) * 512 + F.tid]; x = (f32x2){blo(u), bhi(u)}; }
        if (i >= 4) *(f32x2*)(casout + (i - 4) * DM + c0) = x;
#pragma unroll
        for (int t = 0; t < 4; ++t) { const int k = i - t; if (k >= 0 && k < CAW) o[t] += x * w[k]; }
    }
#pragma unroll
    for (int t = 0; t < 4; ++t) *(LAS f32x2*)(CB + t * DM + c0) = o[t];
    __syncthreads();
    if (F.wave < 4) ln_silu_row(CB + F.wave * DM, ACTA + (grow0 + F.wave) * DM, a.in[8], a.in[9], F.lane);
    __syncthreads();
}

__device__ __forceinline__ void ln_stats16(const bf16* vrow, int lane, float (&x)[16], float& mean, float& rstd) {
    const v4u p = *(const v4u*)(vrow + 8 * lane), q = *(const v4u*)(vrow + 512 + 8 * lane);
    x[0] = blo(p.x); x[1] = bhi(p.x); x[2] = blo(p.y); x[3] = bhi(p.y); x[4] = blo(p.z); x[5] = bhi(p.z); x[6] = blo(p.w); x[7] = bhi(p.w);
    x[8] = blo(q.x); x[9] = bhi(q.x); x[10] = blo(q.y); x[11] = bhi(q.y); x[12] = blo(q.z); x[13] = bhi(q.z); x[14] = blo(q.w); x[15] = bhi(q.w);
    float s = 0.f;
#pragma unroll
    for (int i = 0; i < 16; ++i) s += x[i];
    mean = wave_sum(s) * (1.f / DM); float s2 = 0.f;
#pragma unroll
    for (int i = 0; i < 16; ++i) { const float d = x[i] - mean; s2 += d * d; }
    rstd = 1.0f / sqrtf(wave_sum(s2) * (1.f / DM) + EPS);
}
constexpr int VT_LD = 130, WT_LD = 136;
constexpr int MB_STAT = 0, MB_VT = 1024, MB_WT = MB_VT + 128 * VT_LD * 2 + 64;
static_assert(MB_WT % 16 == 0 && MB_WT + 128 * WT_LD * 2 <= 131072, "mixer-B LDS map");
__device__ __forceinline__ void mixB_prompt(const Frame& F0, const Args& a, bf16* UV, int ch, int hh) {
    const Frame F = phase_frame(F0);
    const size_t R0 = (size_t)ch * 128;
    LAS f32x2* STAT = (LAS f32x2*)(F.lds + MB_STAT);
    LAS unsigned char* VT = F.lds + MB_VT; LAS unsigned char* WT = F.lds + MB_WT;
    const float* lng = a.in[11]; const float* lnb = a.in[12]; const float* w_s = a.in[13]; const float* b_s = a.in[14];
#pragma unroll 1
    for (int i0 = 0; i0 < 16; i0 += 8) {
        v4u pp[8], qq[8];
#pragma unroll
        for (int i = 0; i < 8; ++i) { const bf16* vrow = UV + (R0 + F.wave * 16 + i0 + i) * 2048 + 1024; pp[i] = *(const v4u*)(vrow + 8 * F.lane); qq[i] = *(const v4u*)(vrow + 512 + 8 * F.lane); }
        float sm[8], sq[8];
#pragma unroll
        for (int i = 0; i < 8; ++i) { float x[16]; const v4u p = pp[i], q = qq[i];
            x[0] = blo(p.x); x[1] = bhi(p.x); x[2] = blo(p.y); x[3] = bhi(p.y); x[4] = blo(p.z); x[5] = bhi(p.z); x[6] = blo(p.w); x[7] = bhi(p.w);
            x[8] = blo(q.x); x[9] = bhi(q.x); x[10] = blo(q.y); x[11] = bhi(q.y); x[12] = blo(q.z); x[13] = bhi(q.z); x[14] = blo(q.w); x[15] = bhi(q.w);
            float s1 = 0.f, s2 = 0.f;
#pragma unroll
            for (int k = 0; k < 16; ++k) { s1 += x[k]; s2 += x[k] * x[k]; }
            sm[i] = s1; sq[i] = s2; }
#pragma unroll
        for (int o = 1; o < 64; o <<= 1) {
#pragma unroll
            for (int i = 0; i < 8; ++i) { sm[i] += __shfl_xor(sm[i], o); sq[i] += __shfl_xor(sq[i], o); } }
        if (F.lane == 0) {
#pragma unroll
            for (int i = 0; i < 8; ++i) { const float mean = sm[i] * (1.f / DM), var = fmaxf(sq[i] * (1.f / DM) - mean * mean, 0.f); STAT[F.wave * 16 + i0 + i] = (f32x2){mean, 1.0f / sqrtf(var + EPS)}; } }
    }
    __syncthreads();
    const int lr = F.lane & 15, lq = F.lane >> 4;
    for (int hq = 0; hq < 4; ++hq) {
        const int h = hh * 4 + hq;
#pragma unroll
        for (int i = 0; i < 4; ++i) { const int idx = F.tid + NTHR * i, r = idx >> 4, cgp = idx & 15, c = h * 128 + cgp * 8;
            const v4u p = *(const v4u*)(UV + (R0 + r) * 2048 + 1024 + c); const f32x2 st = STAT[r];
            const f32x4 g0 = *(const f32x4*)(lng + c), g1 = *(const f32x4*)(lng + c + 4), b0 = *(const f32x4*)(lnb + c), b1 = *(const f32x4*)(lnb + c + 4);
            LAS unsigned* dst = (LAS unsigned*)(VT + (r * VT_LD + cgp * 8) * 2);
            dst[0] = pk2((blo(p.x) - st.x) * st.y * g0.x + b0.x, (bhi(p.x) - st.x) * st.y * g0.y + b0.y);
            dst[1] = pk2((blo(p.y) - st.x) * st.y * g0.z + b0.z, (bhi(p.y) - st.x) * st.y * g0.w + b0.w);
            dst[2] = pk2((blo(p.z) - st.x) * st.y * g1.x + b1.x, (bhi(p.z) - st.x) * st.y * g1.y + b1.y);
            dst[3] = pk2((blo(p.w) - st.x) * st.y * g1.z + b1.z, (bhi(p.w) - st.x) * st.y * g1.w + b1.w); }
#pragma unroll
        for (int i = 0; i < 8; ++i) { const int idx = F.tid + NTHR * i, t = idx >> 5, sg = idx & 31;
            const f32x4 wv = *(const f32x4*)(w_s + ((size_t)h * 128 + t) * 128 + sg * 4); const int s0 = sg * 4;
            v2u o; o.x = pk2(s0 <= t ? wv.x : 0.f, s0 + 1 <= t ? wv.y : 0.f); o.y = pk2(s0 + 2 <= t ? wv.z : 0.f, s0 + 3 <= t ? wv.w : 0.f);
            *(LAS v2u*)(WT + (t * WT_LD + s0) * 2) = o; }
        __syncthreads();
        bf16x8 af[4];
#pragma unroll
        for (int ks = 0; ks < 4; ++ks) {
#pragma unroll
            for (int kk = 0; kk < 8; ++kk) af[ks][kk] = (short)*(const LAS unsigned short*)(VT + ((32 * ks + 8 * lq + kk) * VT_LD + 16 * F.wave + lr) * 2);
        }
        v2u uu[8]; float bsv[8];
#pragma unroll
        for (int tb = 0; tb < 8; ++tb) { uu[tb] = *(const v2u*)(UV + (R0 + 16 * tb + lr) * 2048 + h * 128 + 16 * F.wave + 4 * lq); bsv[tb] = b_s[h * 128 + 16 * tb + lr]; }
        v2u oo[8];
#pragma unroll
        for (int tb = 0; tb < 8; ++tb) {
            f32x4 acc = (f32x4){0.f, 0.f, 0.f, 0.f};
#pragma unroll
            for (int ks = 0; ks < 4; ++ks) {
                if (32 * ks <= 16 * tb + 15) {
                    const bf16x8 bfr = *(const LAS bf16x8*)(WT + ((16 * tb + lr) * WT_LD + 32 * ks + 8 * lq) * 2);
                    acc = __builtin_amdgcn_mfma_f32_16x16x32_bf16(af[ks], bfr, acc, 0, 0, 0);
                }
            }
            oo[tb].x = pk2(blo(uu[tb].x) * (acc[0] + bsv[tb]), bhi(uu[tb].x) * (acc[1] + bsv[tb])); oo[tb].y = pk2(blo(uu[tb].y) * (acc[2] + bsv[tb]), bhi(uu[tb].y) * (acc[3] + bsv[tb]));
        }
#pragma unroll
        for (int tb = 0; tb < 8; ++tb) *(v2u*)(UV + (R0 + 16 * tb + lr) * 2048 + h * 128 + 16 * F.wave + 4 * lq) = oo[tb];
        __syncthreads();
    }
}
__device__ __forceinline__ void mixB_sample(const Frame& F0, const Args& a, bf16* UV, int s, float* out_vs) {
    const Frame F = phase_frame(F0);
    LAS float* SV = (LAS float*)F.lds;
    const float* lng = a.in[11]; const float* lnb = a.in[12]; const float* w_s = a.in[13]; const float* b_s = a.in[14];
    const size_t R0 = (size_t)MP + 4 * s;
    if (F.wave < 4) {
        const int t = F.wave; float x[16], mean, rstd; ln_stats16(UV + (R0 + t) * 2048 + 1024, F.lane, x, mean, rstd);
#pragma unroll
        for (int hf = 0; hf < 2; ++hf) { const int c = 512 * hf + 8 * F.lane;
#pragma unroll
            for (int q = 0; q < 2; ++q) { const f32x4 g = *(const f32x4*)(lng + c + 4 * q), b = *(const f32x4*)(lnb + c + 4 * q);
                const f32x4 xv = (f32x4){x[8 * hf + 4 * q], x[8 * hf + 4 * q + 1], x[8 * hf + 4 * q + 2], x[8 * hf + 4 * q + 3]};
                const f32x4 y = (xv - mean) * rstd * g + b;
                *(f32x4*)(out_vs + ((size_t)4 * s + t) * DM + c + 4 * q) = y; *(LAS f32x4*)(SV + t * DM + c + 4 * q) = y; } }
    }
    __syncthreads();
    const int c0 = 2 * F.tid, h = c0 >> 7;
#pragma unroll
    for (int t = 0; t < 4; ++t) {
        const float bsv = b_s[h * 128 + t]; float s0 = bsv, s1 = bsv;
#pragma unroll
        for (int sp = 0; sp <= t; ++sp) { const float wv = w_s[((size_t)h * 128 + t) * 128 + sp]; const f32x2 vv = *(const LAS f32x2*)(SV + sp * DM + c0); s0 += wv * vv.x; s1 += wv * vv.y; }
        unsigned* up = (unsigned*)(UV + (R0 + t) * 2048 + c0); const unsigned uu = *up;
        *up = pk2(blo(uu) * s0, bhi(uu) * s1);
    }
    __syncthreads();
}

__device__ __forceinline__ void ld8f(const float* p, float (&x)[8]) { const f32x4 a = *(const f32x4*)p, b = *(const f32x4*)(p + 4); x[0] = a.x; x[1] = a.y; x[2] = a.z; x[3] = a.w; x[4] = b.x; x[5] = b.y; x[6] = b.z; x[7] = b.w; }
__device__ __forceinline__ void st8f(float* p, const float (&x)[8]) { *(f32x4*)p = (f32x4){x[0], x[1], x[2], x[3]}; *(f32x4*)(p + 4) = (f32x4){x[4], x[5], x[6], x[7]}; }
__device__ __forceinline__ void p6_fixup(const Frame& F0, const Args& a, float* out) {
    const Frame F = phase_frame(F0);
    bf16* ACT = (bf16*)(a.ws + WS_ACT); const float* SL = (const float*)(a.ws + WS_SL); const float* SF = (const float*)(a.ws + WS_SF);
    constexpr int NG = DFF / 8, NIT = 256 * 2 * NG;
    const float* dwf = a.in[19]; const float* bdw = a.in[20];
    for (int it = F.vcu * NTHR + F.tid; it < NIT; it += F.G * NTHR) {
        const int bi = it / NG, cgp = it - bi * NG, c = cgp * 8, blk = bi >> 1, i = bi & 1;
        if ((blk & 31) != 0) {
            float l0[8], l1[8], f0[8], f1[8], fb[8], w0[8], w1[8], w2[8], bs[8];
            ld8f(SL + ((size_t)(blk - 1) * 2 + 0) * DFF + c, l0); ld8f(SL + ((size_t)(blk - 1) * 2 + 1) * DFF + c, l1);
            ld8f(SF + ((size_t)(blk * 2 + 0) * 2 + 0) * DFF + c, f0); ld8f(SF + ((size_t)(blk * 2 + 1) * 2 + 0) * DFF + c, f1); ld8f(SF + ((size_t)(blk * 2 + i) * 2 + 1) * DFF + c, fb);
            ld8f(dwf + c, w0); ld8f(dwf + DFF + c, w1); ld8f(dwf + 2 * DFF + c, w2); ld8f(bdw + c, bs);
            float o[8];
#pragma unroll
            for (int j = 0; j < 8; j += 2) {
                const float x2a = i == 0 ? l0[j] : l1[j], x1a = i == 0 ? l1[j] : f0[j], x0a = i == 0 ? f0[j] : f1[j];
                const float x2b = i == 0 ? l0[j + 1] : l1[j + 1], x1b = i == 0 ? l1[j + 1] : f0[j + 1], x0b = i == 0 ? f0[j + 1] : f1[j + 1];
                f32x2 cv = (f32x2){x2a * w0[j] + x1a * w1[j] + x0a * w2[j] + bs[j], x2b * w0[j + 1] + x1b * w1[j + 1] + x0b * w2[j + 1] + bs[j + 1]};
                cv = pg8::gelu_pk(cv); o[j] = cv.x * fb[j]; o[j + 1] = cv.y * fb[j + 1]; }
            v4u w; w.x = pk2(o[0], o[1]); w.y = pk2(o[2], o[3]); w.z = pk2(o[4], o[5]); w.w = pk2(o[6], o[7]);
            *(v4u*)(ACT + ((size_t)blk * 64 + i) * DFF + c) = w;
        }
        if ((blk & 31) == 31) { float l[8]; ld8f(SL + ((size_t)blk * 2 + i) * DFF + c, l); st8f(out + O_FP + ((size_t)(blk >> 5) * 2 + i) * DFF + c, l); }
    }
}

struct SmallSrc { const bf16* A; int lda; const bf16* Bt; };
template <int NSRC, class Epi>
__device__ __forceinline__ void small_gemm(const Frame& F0, const SmallSrc (&src)[NSRC], int K, int N, const Epi& E) {
    const Frame F = phase_frame(F0);
    const int fr = F.lane & 15, fq = F.lane >> 4;
    const int ntn = N / 32, ntiles = (MS / 32) * ntn;
    for (int tile = F.wave * F.G + F.vcu; tile < ntiles; tile += F.G * NWAVES) {
        const int tm = tile / ntn, tn = tile - tm * ntn;
        f32x4 acc[NSRC][2][2];
#pragma unroll
        for (int sidx = 0; sidx < NSRC; ++sidx) {
            const bf16* ap = src[sidx].A + (size_t)(32 * tm + fr) * src[sidx].lda + 8 * fq;
            const bf16* bp = src[sidx].Bt + (size_t)(32 * tn + fr) * K + 8 * fq;
            const size_t a16 = (size_t)16 * src[sidx].lda, b16 = (size_t)16 * K;
            f32x4 c00 = (f32x4){0.f, 0.f, 0.f, 0.f}, c01 = c00, c10 = c00, c11 = c00;
            bf16x8 a0[2][4], b0[2][4], a1[2][4], b1[2][4];
#define SG_LOAD(A_, B_, kk) do { _Pragma("unroll") for (int i = 0; i < 4; ++i) { A_[0][i] = *(const bf16x8*)(ap + (kk) + 32 * i); A_[1][i] = *(const bf16x8*)(ap + a16 + (kk) + 32 * i); \
        B_[0][i] = *(const bf16x8*)(bp + (kk) + 32 * i); B_[1][i] = *(const bf16x8*)(bp + b16 + (kk) + 32 * i); } } while (0)
#define SG_MMA(A_, B_) do { _Pragma("unroll") for (int i = 0; i < 4; ++i) { c00 = __builtin_amdgcn_mfma_f32_16x16x32_bf16(B_[0][i], A_[0][i], c00, 0, 0, 0); c01 = __builtin_amdgcn_mfma_f32_16x16x32_bf16(B_[1][i], A_[0][i], c01, 0, 0, 0); \
        c10 = __builtin_amdgcn_mfma_f32_16x16x32_bf16(B_[0][i], A_[1][i], c10, 0, 0, 0); c11 = __builtin_amdgcn_mfma_f32_16x16x32_bf16(B_[1][i], A_[1][i], c11, 0, 0, 0); } } while (0)
            SG_LOAD(a0, b0, 0);
#pragma unroll 1
            for (int k = 0; k < K; k += 256) {
                SG_LOAD(a1, b1, k + 128);
                SG_MMA(a0, b0);
                if (k + 256 < K) SG_LOAD(a0, b0, k + 256);
                SG_MMA(a1, b1);
            }
#undef SG_LOAD
#undef SG_MMA
            acc[sidx][0][0] = c00; acc[sidx][0][1] = c01; acc[sidx][1][0] = c10; acc[sidx][1][1] = c11;
        }
#pragma unroll
        for (int i = 0; i < 2; ++i)
#pragma unroll
            for (int j = 0; j < 2; ++j) { f32x4 sub[NSRC];
#pragma unroll
                for (int sidx = 0; sidx < NSRC; ++sidx) sub[sidx] = acc[sidx][i][j];
                E(sub, 32 * tm + 16 * i + fr, 32 * tn + 16 * j + 4 * fq, fq); }
    }
}
struct SEpiMerge {
    bf16* MG; const bf16* GG;
    __device__ __forceinline__ void operator()(const f32x4 (&acc)[2], int r, int c, int fq) const {
        const size_t row = (size_t)MP + r;
        const v2u ga = *(const v2u*)(GG + row * 2048 + c), gb = *(const v2u*)(GG + row * 2048 + 1024 + c);
        v2u o; o.x = pk2(blo(ga.x) * acc[0][0] + blo(gb.x) * acc[1][0], bhi(ga.x) * acc[0][1] + bhi(gb.x) * acc[1][1]);
        o.y = pk2(blo(ga.y) * acc[0][2] + blo(gb.y) * acc[1][2], bhi(ga.y) * acc[0][3] + bhi(gb.y) * acc[1][3]);
        *(v2u*)(MG + row * DM + c) = o;
    }
};
template <bool RB16> struct SEpiRes {
    const float* R; const bf16* RB; float* Y; bf16* YB; float* ss;
    __device__ __forceinline__ void operator()(const f32x4 (&acc)[1], int r, int c, int fq) const {
        const size_t off = (size_t)r * DM + c;
        f32x4 h;
        if (RB16) { const v2u p = *(const v2u*)(RB + off); h = (f32x4){blo(p.x), bhi(p.x), blo(p.y), bhi(p.y)} + acc[0]; *(f32x4*)(Y + off) = h; }
        else { h = *(const f32x4*)(R + off) + acc[0]; v2u w; w.x = pk2(h[0], h[1]); w.y = pk2(h[2], h[3]); *(v2u*)(YB + off) = w; }
        float sq = (h[0] * h[0] + h[1] * h[1]) + (h[2] * h[2] + h[3] * h[3]);
        sq += __shfl_xor(sq, 16); sq += __shfl_xor(sq, 32);
        if (fq == 0) atomicAdd(ss + r, sq);
    }
};

__global__ void __launch_bounds__(NTHR, 2) fwd_mega(Args a) {
    extern __shared__ __attribute__((aligned(16))) unsigned char lds_raw[];
    cg::grid_group grid = cg::this_grid();
    Frame F; F.lds = (LAS unsigned char*)lds_raw; F.tid = threadIdx.x; F.lane = F.tid & 63; F.wave = __builtin_amdgcn_readfirstlane(F.tid >> 6);
    F.G = gridDim.x; { const int bx = blockIdx.x; F.vcu = (F.G % 8 == 0) ? (bx % 8) * (F.G / 8) + bx / 8 : bx; }
    unsigned char* ws = a.ws; float* out = a.out;
    volatile LAS unsigned* bst = (volatile LAS unsigned*)(F.lds + 131072 + 64);
    if (F.tid < 2) bst[F.tid] = 0u;
    __syncthreads();
    bf16* XN = (bf16*)(ws + WS_XN); bf16* GLU = (bf16*)(ws + WS_GLU); bf16* UV = (bf16*)(ws + WS_UV); bf16* GG = (bf16*)(ws + WS_GG);
    bf16* MG = (bf16*)(ws + WS_MG); bf16* ACT = (bf16*)(ws + WS_ACT); bf16* ACTA = (bf16*)(out + O_Y);
    float* ss1 = (float*)(ws + WS_SS1); float* ss2 = (float*)(ws + WS_SS2);

    const XcdBarrier bar = xcd_barrier_post((unsigned*)(ws + WS_BAR), bst);
    if (a.ws == nullptr) grid.sync();
    p0_weights(F, a, 0, I_IN, F.vcu * NWAVES + F.wave, F.G * NWAVES);
    p0_rows(F, a);
    xcd_barrier(bar);
    { pg8::Gemm g{XN, (const bf16*)(ws + WS_WIN), MT, NIN, DM, DM}; pg8::StaticOrder S; S.init(MT, NIN, F.G, (int)blockIdx.x);
      pg8::EpiG1 E{GLU, UV, GG};
      pg8::gemm_phase<pg8::EpiG1, pg8::StaticOrder, true, true>(F.lds, g, S, E);
      const int nu = (MT / 256) * (NIN / 256), extra = nu % F.G;
      if (extra == 0) p0_weights(F, a, I_IN, NITEMS, (int)blockIdx.x * NWAVES + F.wave, F.G * NWAVES);
      else if ((int)blockIdx.x >= extra) p0_weights(F, a, I_IN, NITEMS, ((int)blockIdx.x - extra) * NWAVES + F.wave, (F.G - extra) * NWAVES); }
    xcd_barrier(bar);
    for (int u = F.vcu; u < 256; u += F.G) {
        mixB_prompt(F, a, UV, u >> 1, u & 1);
        { const int b = u >> 5, t0 = (u & 31) * 64; const bool last = (u & 31) == 31;
          convA_prompt(F, a, (const unsigned*)GLU, ACTA, (size_t)b * SEQ + t0, t0 > 0, last ? out + O_CAP + (size_t)b * 30 * DM : nullptr); }
        if (u < 128) convA_sample(F, a, (const unsigned*)GLU, ACTA, u, a.in[2] + (size_t)u * 30 * DM, out + O_CAS + (size_t)u * 30 * DM);
        else mixB_sample(F, a, UV, u - 128, out + O_VS);
    }
    xcd_barrier(bar);
    { const SmallSrc src[2] = {{ACTA + (size_t)MP * DM, DM, (const bf16*)(ws + WS_WA)}, {UV + (size_t)MP * 2048, 2048, (const bf16*)(ws + WS_WB)}};
      SEpiMerge E{MG, GG}; small_gemm<2, SEpiMerge>(F, src, DM, DM, E); }
    { pg8::Gemm g{ACTA, (const bf16*)(ws + WS_WA), MP, DM, DM, DM}; pg8::StaticOrder S; S.init(MP, DM, F.G, (int)blockIdx.x);
      pg8::EpiMerge<0> E{MG, GG};
      pg8::gemm_phase<pg8::EpiMerge<0>, pg8::StaticOrder, true, true>(F.lds, g, S, E); }
    { pg8::Gemm g{UV, (const bf16*)(ws + WS_WB), MP, DM, DM, 2048}; pg8::StaticOrder S; S.init(MP, DM, F.G, (int)blockIdx.x);
      pg8::EpiMerge<1> E{MG, GG};
      pg8::gemm_phase<pg8::EpiMerge<1>, pg8::StaticOrder, true, true>(F.lds, g, S, E); }
    xcd_barrier(bar);
    { const SmallSrc src[1] = {{MG + (size_t)MP * DM, DM, (const bf16*)(ws + WS_WO)}};
      SEpiRes<false> E{a.in[1], nullptr, nullptr, XN + (size_t)MP * DM, ss1 + MP}; small_gemm<1, SEpiRes<false>>(F, src, DM, DM, E); }
    { pg8::Gemm g{MG, (const bf16*)(ws + WS_WO), MP, DM, DM, DM}; pg8::StaticOrder S; S.init(MP, DM, F.G, (int)blockIdx.x);
      pg8::EpiRes<false> E{a.in[0], nullptr, nullptr, XN, ss1};
      pg8::gemm_phase<pg8::EpiRes<false>, pg8::StaticOrder, true, true>(F.lds, g, S, E); }
    xcd_barrier(bar);
    { pg8::Gemm g{XN, (const bf16*)(ws + WS_WUP), MT, NUP, DM, DM}; pg8::StaticOrder S; S.init(MT, NUP, F.G, (int)blockIdx.x);
      pg8::EpiUpFused E{ACT, ss1, a.in[19], a.in[20], a.in[3], (float*)(ws + WS_SL), (float*)(ws + WS_SF), out + O_FS};
      pg8::gemm_phase<pg8::EpiUpFused, pg8::StaticOrder, true, true>(F.lds, g, S, E); }
    xcd_barrier(bar);
    p6_fixup(F, a, out);
    xcd_barrier(bar);
    { const SmallSrc src[1] = {{ACT + (size_t)MP * DFF, DFF, (const bf16*)(ws + WS_WDN)}};
      SEpiRes<true> E{nullptr, XN + (size_t)MP * DM, out + O_Y + (size_t)MP * DM, nullptr, ss2 + MP}; small_gemm<1, SEpiRes<true>>(F, src, DFF, DM, E); }
    { pg8::Gemm g{ACT, (const bf16*)(ws + WS_WDN), MP, DM, DFF, DFF}; pg8::StaticOrder S; S.init(MP, DM, F.G, (int)blockIdx.x);
      pg8::EpiRes<true> E{nullptr, XN, out + O_Y, nullptr, ss2};
      pg8::gemm_phase<pg8::EpiRes<true>, pg8::StaticOrder, true, true>(F.lds, g, S, E); }
    xcd_barrier(bar);
    { const Frame F8 = phase_frame(F); const f32x4* gr = (const f32x4*)a.in[22] + F8.lane;
      const int NGW = F.G * NWAVES;
      for (int m = F8.vcu * NWAVES + F8.wave; m < MT; m += 4 * NGW) {
          f32x4 v[4][4]; float rstd[4];
#pragma unroll
          for (int q = 0; q < 4; ++q) { const int mq = (m + q * NGW < MT) ? m + q * NGW : m; const f32x4* yr = (const f32x4*)(out + O_Y + (size_t)mq * DM) + F8.lane;
              rstd[q] = ss2[mq];
#pragma unroll
              for (int j = 0; j < 4; ++j) v[q][j] = yr[64 * j]; }
#pragma unroll
          for (int q = 0; q < 4; ++q) { if (m + q * NGW < MT) { f32x4* yw = (f32x4*)(out + O_Y + (size_t)(m + q * NGW) * DM) + F8.lane; const float r = 1.0f / sqrtf(rstd[q] * (1.f / DM) + EPS);
#pragma unroll
              for (int j = 0; j < 4; ++j) yw[64 * j] = v[q][j] * r * gr[64 * j]; } } } }
}

extern "C" void kernel_launch(void* const* d_in, const int* in_sizes, int n_in, void* d_out, int out_size, void* d_ws, size_t ws_size, hipStream_t stream) {
    static int grid = 0;
    if (grid == 0) {
        if (n_in != 23 || (size_t)out_size != O_END || ws_size < WS_END) { fprintf(stderr, "kernel_launch: unexpected shapes: n_in %d out %d ws %zu\n", n_in, out_size, ws_size); grid = -1; return; }
        int dev = 0, cus = 0, per_cu = 0;
        if (hipGetDevice(&dev) != hipSuccess || hipDeviceGetAttribute(&cus, hipDeviceAttributeMultiprocessorCount, dev) != hipSuccess) { grid = -1; return; }
        if (hipFuncSetAttribute((const void*)fwd_mega, hipFuncAttributeMaxDynamicSharedMemorySize, LDS_BYTES) != hipSuccess) { fprintf(stderr, "kernel_launch: hipFuncSetAttribute failed\n"); grid = -1; return; }
        if (hipOccupancyMaxActiveBlocksPerMultiprocessor(&per_cu, (const void*)fwd_mega, NTHR, LDS_BYTES) != hipSuccess || per_cu < 1) { fprintf(stderr, "kernel_launch: occupancy query says %d\n", per_cu); per_cu = 1; }
        (void)hipGetLastError();
        grid = cus * 1;
        fprintf(stderr, "kernel_launch: cus %d per_cu %d grid %d\n", cus, per_cu, grid);
    }
    if (grid < 0) return;
    if (hipMemsetAsync((char*)d_ws + WS_BAR, 0, XCD_BAR_WORDS * 4, stream) != hipSuccess) { fprintf(stderr, "kernel_launch: memset failed\n"); return; }
    Args a{};
    for (int i = 0; i < 23; ++i) a.in[i] = (const float*)d_in[i];
    a.out = (float*)d_out; a.ws = (unsigned char*)d_ws;
    void* args[] = {&a};
    hipError_t e = hipLaunchCooperativeKernel((const void*)fwd_mega, dim3(grid), dim3(NTHR), args, LDS_BYTES, stream);
    if (e != hipSuccess) fprintf(stderr, "kernel_launch: cooperative launch failed: %s (grid %d)\n", hipGetErrorString(e), grid);
}
```

```cpp
#include <hip/hip_runtime.h>
#include <hip/hip_cooperative_groups.h>
#include <cstdio>
#include <cstdint>
namespace cg = cooperative_groups;
namespace pg8 {
#define PG8_LAS __attribute__((address_space(3)))
typedef unsigned short bf16_t;
typedef short bf16x8 __attribute__((ext_vector_type(8)));
typedef float f32x4 __attribute__((ext_vector_type(4)));
typedef unsigned u32x4 __attribute__((ext_vector_type(4)));
constexpr int BM = 256, BK = 64, HALF = 128, HTB = HALF * BK * 2  , STAGE_BYTES = 8 * HTB, NXCD = 8, WGM = 8;

__host__ __device__ __forceinline__ int lds_byte(int r, int c) { const int st = (r >> 4) * 2 + (c >> 5), rr = r & 15, cc = c & 31, ob = rr * 64 + cc * 2; return st * 1024 + (ob ^ (((ob >> 9) & 1) << 5)); }
__host__ __device__ __forceinline__ void stage_rc(int b, int& R, int& C) { const int st = b / 1024, sb = b % 1024, swz = sb ^ (((sb >> 9) & 1) << 5); R = (st >> 1) * 16 + swz / 64; C = (st & 1) * 32 + (swz % 64) / 2; }
__host__ __device__ __forceinline__ int perm32(int rho) { const int n = rho >> 4, i = rho & 15; return 8 * (i >> 2) + 4 * n + (i & 3); }

struct Unit { int pm, pn, src; };
struct Gemm { const bf16_t* A; const bf16_t* Bt; int M, N, K, lda; const bf16_t* A2; const bf16_t* Bt2; };

struct StaticOrder {
    int nM, nN, nwg, G, c;
    __host__ __device__ void init(int M, int N, int G_, int c_) { nM = M / BM; nN = N / BM; nwg = nM * nN; G = G_; c = c_; }
    __host__ __device__ bool next(int i, Unit& u) const {
        const long L = (long)i * G + c; if (L >= nwg) return false;
        int wgid = (int)L; { const int q = nwg / NXCD, r = nwg % NXCD, xcd = wgid % NXCD, off = wgid / NXCD; wgid = (xcd < r ? xcd * (q + 1) : r * (q + 1) + (xcd - r) * q) + off; }
        const int nig = WGM * nN, gid = wgid / nig, fm = gid * WGM, gsz = (nM - fm) < WGM ? (nM - fm) : WGM;
        u.pm = fm + ((wgid % nig) % gsz); u.pn = (wgid % nig) / gsz; u.src = 0; return true;
    }
    __device__ __forceinline__ void a_ready(const Unit&) const {}
    __device__ __forceinline__ void done(const Unit&) const {}
};

struct PairOrder : StaticOrder {
    __host__ __device__ bool next(int i, Unit& u) const { if (!StaticOrder::next(i >> 1, u)) return false; u.src = i & 1; return true; }
};
__device__ __forceinline__ unsigned cvt_pk_bf16(float lo, float hi) { unsigned r; asm volatile("v_cvt_pk_bf16_f32 %0, %1, %2" : "=v"(r) : "v"(lo), "v"(hi)); return r; }
typedef float f32x2 __attribute__((ext_vector_type(2)));
__device__ __forceinline__ f32x2 gelu_pk(f32x2 v) {
    const f32x2 av = __builtin_elementwise_abs(v), d = av * 0.2316418882f + 1.0f;
    f32x2 t; t.x = __builtin_amdgcn_rcpf(d.x); t.y = __builtin_amdgcn_rcpf(d.y);
    f32x2 q = t * 0.5307027145f + (-0.7265760135f); q = q * t + 0.7107068705f; q = q * t + (-0.142248368f); q = q * t + 0.127414796f; q = q * t;
    const f32x2 s = (v * v) * (-0.72134752044f);
    f32x2 e; e.x = __builtin_amdgcn_exp2f(s.x); e.y = __builtin_amdgcn_exp2f(s.y);
    const f32x2 m = v * (q * e), r = v - m;
    f32x2 o; o.x = v.x < 0.f ? m.x : r.x; o.y = v.y < 0.f ? m.y : r.y; return o;
}
typedef unsigned u32x2 __attribute__((ext_vector_type(2)));
__device__ __forceinline__ float sigm(float x) { return __builtin_amdgcn_rcpf(1.0f + __builtin_amdgcn_exp2f(x * -1.44269504089f)); }
__device__ __forceinline__ float bf_lo(unsigned u) { return __uint_as_float(u << 16); }
__device__ __forceinline__ float bf_hi(unsigned u) { return __uint_as_float(u & 0xffff0000u); }

struct EpiG1 {
    static constexpr bool PERM = true, AFTER_DRAIN = false;
    bf16_t* GLU; bf16_t* UV; bf16_t* GG;
    __device__ __forceinline__ void operator()(const f32x4 (&acc)[2][2][4][2], const Unit& u, int wr, int wc, int fr, int fq) const {
        const int row0 = u.pm * BM + wr * 64 + fr;
        if (u.pn < 8) {
            const int col = u.pn * 128 + wc * 32 + 8 * fq;
#pragma unroll
            for (int ai = 0; ai < 2; ++ai)
#pragma unroll
                for (int m = 0; m < 4; ++m) {
                    const f32x4 v0 = acc[ai][0][m][0], v1 = acc[ai][0][m][1], g0 = acc[ai][1][m][0], g1 = acc[ai][1][m][1];
                    u32x4 w; w.x = cvt_pk_bf16(v0[0] * sigm(g0[0]), v0[1] * sigm(g0[1])); w.y = cvt_pk_bf16(v0[2] * sigm(g0[2]), v0[3] * sigm(g0[3]));
                    w.z = cvt_pk_bf16(v1[0] * sigm(g1[0]), v1[1] * sigm(g1[1])); w.w = cvt_pk_bf16(v1[2] * sigm(g1[2]), v1[3] * sigm(g1[3]));
                    *(u32x4*)(GLU + (size_t)(row0 + ai * HALF + m * 16) * 1024 + col) = w; }
        } else {
            const bool isg = u.pn < 16;
            bf16_t* base = isg ? UV : GG;
            const int col0 = (isg ? (u.pn - 8) : (u.pn - 16)) * BM + wc * 32 + 8 * fq;
#pragma unroll
            for (int ai = 0; ai < 2; ++ai)
#pragma unroll
                for (int m = 0; m < 4; ++m) { bf16_t* rowp = base + (size_t)(row0 + ai * HALF + m * 16) * 2048 + col0;
#pragma unroll
                    for (int bj = 0; bj < 2; ++bj) { f32x4 v0 = acc[ai][bj][m][0], v1 = acc[ai][bj][m][1];
                        if (isg) { f32x2 a = gelu_pk((f32x2){v0[0], v0[1]}), b = gelu_pk((f32x2){v0[2], v0[3]}), c = gelu_pk((f32x2){v1[0], v1[1]}), d = gelu_pk((f32x2){v1[2], v1[3]});
                            v0 = (f32x4){a.x, a.y, b.x, b.y}; v1 = (f32x4){c.x, c.y, d.x, d.y}; }
                        else { v0 = (f32x4){sigm(v0[0]), sigm(v0[1]), sigm(v0[2]), sigm(v0[3])}; v1 = (f32x4){sigm(v1[0]), sigm(v1[1]), sigm(v1[2]), sigm(v1[3])}; }
                        u32x4 w; w.x = cvt_pk_bf16(v0[0], v0[1]); w.y = cvt_pk_bf16(v0[2], v0[3]); w.z = cvt_pk_bf16(v1[0], v1[1]); w.w = cvt_pk_bf16(v1[2], v1[3]);
                        *(u32x4*)(rowp + bj * HALF) = w; } }
        }
    }
};
struct EpiMerge {
    static constexpr bool PERM = true, AFTER_DRAIN = false;
    bf16_t* MG; const bf16_t* GG;
    __device__ __forceinline__ void operator()(const f32x4 (&acc)[2][2][4][2], const Unit& u, int wr, int wc, int fr, int fq) const {
        const int row0 = u.pm * BM + wr * 64 + fr, col0 = u.pn * BM + wc * 32 + 8 * fq; const int MODE = u.src;
#pragma unroll
        for (int ai = 0; ai < 2; ++ai) {
            u32x4 gv[4][2], pv[4][2];
#pragma unroll
            for (int m = 0; m < 4; ++m)
#pragma unroll
                for (int bj = 0; bj < 2; ++bj) { const size_t row = (size_t)(row0 + ai * HALF + m * 16); const int col = col0 + bj * HALF;
                    gv[m][bj] = *(const u32x4*)(GG + row * 2048 + MODE * 1024 + col);
                    if (MODE == 1) pv[m][bj] = *(const u32x4*)(MG + row * 1024 + col); }
#pragma unroll
            for (int m = 0; m < 4; ++m)
#pragma unroll
                for (int bj = 0; bj < 2; ++bj) { const size_t row = (size_t)(row0 + ai * HALF + m * 16); const int col = col0 + bj * HALF;
                    const u32x4 g = gv[m][bj];
                    f32x4 v0 = acc[ai][bj][m][0], v1 = acc[ai][bj][m][1];
                    v0 = v0 * (f32x4){bf_lo(g.x), bf_hi(g.x), bf_lo(g.y), bf_hi(g.y)}; v1 = v1 * (f32x4){bf_lo(g.z), bf_hi(g.z), bf_lo(g.w), bf_hi(g.w)};
                    if (MODE == 1) { const u32x4 p = pv[m][bj];
                        v0 = v0 + (f32x4){bf_lo(p.x), bf_hi(p.x), bf_lo(p.y), bf_hi(p.y)}; v1 = v1 + (f32x4){bf_lo(p.z), bf_hi(p.z), bf_lo(p.w), bf_hi(p.w)}; }
                    u32x4 w; w.x = cvt_pk_bf16(v0[0], v0[1]); w.y = cvt_pk_bf16(v0[2], v0[3]); w.z = cvt_pk_bf16(v1[0], v1[1]); w.w = cvt_pk_bf16(v1[2], v1[3]);
                    *(u32x4*)(MG + row * 1024 + col) = w; }
            asm volatile("" ::: "memory"); }
    }
};
template <bool RB16> struct EpiRes {
    static constexpr bool PERM = false, AFTER_DRAIN = false;
    const float* R; const bf16_t* RB; float* Y; bf16_t* YB; float* ss;
    __device__ __forceinline__ void operator()(const f32x4 (&acc)[2][2][4][2], const Unit& u, int wr, int wc, int fr, int fq) const {
        const int row0 = u.pm * BM + wr * 64 + fr, col0 = u.pn * BM + wc * 32 + 4 * fq;
#pragma unroll
        for (int ai = 0; ai < 2; ++ai)
#pragma unroll
            for (int mh = 0; mh < 4; mh += 2) {
                f32x4 rv[2][2][2];
#pragma unroll
                for (int mm = 0; mm < 2; ++mm)
#pragma unroll
                    for (int bj = 0; bj < 2; ++bj)
#pragma unroll
                        for (int n = 0; n < 2; ++n) { const size_t off = (size_t)(row0 + ai * HALF + (mh + mm) * 16) * 1024 + col0 + bj * HALF + n * 16;
                            if (RB16) { const u32x2 p = *(const u32x2*)(RB + off); rv[mm][bj][n] = (f32x4){bf_lo(p.x), bf_hi(p.x), bf_lo(p.y), bf_hi(p.y)}; }
                            else rv[mm][bj][n] = *(const f32x4*)(R + off); }
#pragma unroll
                for (int mm = 0; mm < 2; ++mm) { const int m = mh + mm; const size_t row = (size_t)(row0 + ai * HALF + m * 16); float s = 0.f;
#pragma unroll
                    for (int bj = 0; bj < 2; ++bj)
#pragma unroll
                        for (int n = 0; n < 2; ++n) { const size_t off = row * 1024 + col0 + bj * HALF + n * 16;
                            const f32x4 h = rv[mm][bj][n] + acc[ai][bj][m][n];
                            if (RB16) *(f32x4*)(Y + off) = h;
                            else { u32x2 w; w.x = cvt_pk_bf16(h[0], h[1]); w.y = cvt_pk_bf16(h[2], h[3]); *(u32x2*)(YB + off) = w; }
                            s += (h[0] * h[0] + h[1] * h[1]) + (h[2] * h[2] + h[3] * h[3]); }
                    s += __shfl_xor(s, 16); s += __shfl_xor(s, 32);
                    if (fq == 0) atomicAdd(ss + row, s); }
                asm volatile("" ::: "memory"); }
    }
};
struct EpiUpFused {
    static constexpr bool PERM = true, AFTER_DRAIN = false;
    bf16_t* ACT; const float* ss; const float* dwf; const float* bdw; const float* stf; float* sideLast; float* sideFirst; float* out_fs;
    __device__ __forceinline__ void operator()(const f32x4 (&acc)[2][2][4][2], const Unit& u, int wr, int wc, int fr, int fq) const {
        constexpr int DFF_ = 2816, MP_ = 16384;
        const int cch = u.pn * 128 + wc * 32 + 8 * fq;
        const int lane = fq * 16 + fr, src1 = (lane & 48) | ((fr - 1) & 15), src2 = (lane & 48) | ((fr - 2) & 15);
        f32x4 w0[2], w1[2], w2[2], bs[2];
#pragma unroll
        for (int n = 0; n < 2; ++n) { w0[n] = *(const f32x4*)(dwf + cch + 4 * n); w1[n] = *(const f32x4*)(dwf + DFF_ + cch + 4 * n); w2[n] = *(const f32x4*)(dwf + 2 * DFF_ + cch + 4 * n); bs[n] = *(const f32x4*)(bdw + cch + 4 * n); }
        const bool sample = u.pm >= 64;
#pragma unroll
        for (int ai = 0; ai < 2; ++ai) {
            const int blk = u.pm * 4 + ai * 2 + wr;
            f32x4 p1[2], p2[2];
#pragma unroll
            for (int n = 0; n < 2; ++n) { p1[n] = (f32x4){0.f, 0.f, 0.f, 0.f}; p2[n] = (f32x4){0.f, 0.f, 0.f, 0.f}; }
#pragma unroll
            for (int m = 0; m < 4; ++m) {
                const int row = blk * 64 + 16 * m + fr;
                const float rs = __builtin_amdgcn_rsqf(ss[row] * (1.0f / 1024.0f) + 1e-6f);
                const int t4 = fr & 3, sq = (row - MP_) >> 2;
                u32x4 wout;
#pragma unroll
                for (int n = 0; n < 2; ++n) {
                    const f32x4 av = acc[ai][0][m][n] * rs, bv = acc[ai][1][m][n] * rs;
                    f32x4 r1, r2;
#pragma unroll
                    for (int j = 0; j < 4; ++j) { r1[j] = __shfl(av[j], src1); r2[j] = __shfl(av[j], src2); }
                    f32x4 x1, x2;
                    if (!sample) {
                        x1 = fr == 0 ? p1[n] : r1; x2 = fr < 2 ? p2[n] : r2;
                        if (m == 0 && fr < 2) { float* sf = sideFirst + ((size_t)(blk * 2 + fr) * 2) * DFF_ + cch + 4 * n; *(f32x4*)sf = av; *(f32x4*)(sf + DFF_) = bv; }
                        if (m == 3 && fr >= 14) *(f32x4*)(sideLast + (size_t)(blk * 2 + fr - 14) * DFF_ + cch + 4 * n) = av;
                    } else {
                        const f32x4 s0 = *(const f32x4*)(stf + ((size_t)sq * 2 + 0) * DFF_ + cch + 4 * n), s1 = *(const f32x4*)(stf + ((size_t)sq * 2 + 1) * DFF_ + cch + 4 * n);
                        x1 = t4 >= 1 ? r1 : s1; x2 = t4 >= 2 ? r2 : (t4 == 1 ? s1 : s0);
                        if (t4 >= 2) *(f32x4*)(out_fs + ((size_t)sq * 2 + (t4 - 2)) * DFF_ + cch + 4 * n) = av;
                    }
                    p1[n] = r1; p2[n] = r2;
                    const f32x4 cv = w0[n] * x2 + w1[n] * x1 + w2[n] * av + bs[n];
                    const f32x2 g0 = gelu_pk((f32x2){cv[0], cv[1]}), g1 = gelu_pk((f32x2){cv[2], cv[3]});
                    const unsigned lo = cvt_pk_bf16(g0.x * bv[0], g0.y * bv[1]), hi = cvt_pk_bf16(g1.x * bv[2], g1.y * bv[3]);
                    if (n == 0) { wout.x = lo; wout.y = hi; } else { wout.z = lo; wout.w = hi; }
                }
                *(u32x4*)(ACT + (size_t)row * DFF_ + cch) = wout;
            }
        }
    }
};
template <class Epi, class Sched, bool ALIGN_EPI = false, bool SP2 = false>
__device__ __forceinline__ void gemm_phase(PG8_LAS unsigned char* lds, const Gemm g, const Sched& S, const Epi& E) {
    int tid_ = threadIdx.x; asm volatile("" : "+v"(tid_));
    const int tid = tid_, wid = __builtin_amdgcn_readfirstlane(tid >> 6), lane = tid & 63, wr = wid >> 2, wc = wid & 3, fr = lane & 15, fq = lane >> 4;
    const int K = g.K, nt = K / BK;
    unsigned voffA[2], voffB[2];
#pragma unroll
    for (int i = 0; i < 2; ++i) { int R, C; stage_rc(tid * 16 + i * 8192, R, C); const int Rb = Epi::PERM ? ((R & ~31) + perm32(R & 31)) : R;
        voffA[i] = (unsigned)(R * g.lda + C) * 2u; voffB[i] = (unsigned)(Rb * K + C) * 2u; }
    const size_t kstep = (size_t)(BK * 2);
    const size_t hA = (size_t)HALF * g.lda * 2, hB = (size_t)HALF * K * 2;
    const size_t tA = 2 * hA, tB = 2 * hB;
    const unsigned ldsw = (unsigned)wid * 1024u;
    const int aoff = lds_byte(wr * 64 + fr, fq * 8), boff = lds_byte(wc * 32 + fr, fq * 8);
#define PG8_SA(b, h) (((b) * 2 + (h)) * HTB)
#define PG8_SB(b, h) ((4 + (b) * 2 + (h)) * HTB)
#define PG8_STAGE(bufoff, gbase, voff) do { _Pragma("unroll") for (int _i = 0; _i < 2; ++_i) \
        __builtin_amdgcn_global_load_lds((const unsigned*)((const char*)(gbase) + (voff)[_i]), (PG8_LAS unsigned*)(lds + (bufoff) + ldsw + _i * 8192), 16, 0, 0); } while (0)
#define PG8_LDA(dst, b, h) do { _Pragma("unroll") for (int m = 0; m < 4; ++m) _Pragma("unroll") for (int k = 0; k < 2; ++k) dst[m][k] = *(const PG8_LAS bf16x8*)(lds + PG8_SA(b, h) + aoff + m * 2048 + k * 1024); } while (0)
#define PG8_LDB(dst, b, h) do { _Pragma("unroll") for (int n = 0; n < 2; ++n) _Pragma("unroll") for (int k = 0; k < 2; ++k) dst[n][k] = *(const PG8_LAS bf16x8*)(lds + PG8_SB(b, h) + boff + n * 2048 + k * 1024); } while (0)
#define PG8_MMA(ai, bj, At, Bt) do { __builtin_amdgcn_s_setprio(1); _Pragma("unroll") for (int m = 0; m < 4; ++m) _Pragma("unroll") for (int n = 0; n < 2; ++n) _Pragma("unroll") for (int k = 0; k < 2; ++k) \
        acc[ai][bj][m][n] = __builtin_amdgcn_mfma_f32_16x16x32_bf16(Bt[n][k], At[m][k], acc[ai][bj][m][n], 0, 0, 0); __builtin_amdgcn_s_setprio(0); } while (0)
#define PG8_WAIT_V(n) asm volatile("s_waitcnt vmcnt(" #n ")" ::: "memory")
#define PG8_WAIT_L(n) asm volatile("s_waitcnt lgkmcnt(" #n ")" ::: "memory")
#define PG8_BAR __builtin_amdgcn_s_barrier()
#define PG8_SCHED __builtin_amdgcn_sched_barrier(0)
    Unit cur, nxt; int ui = 0;
    if (!S.next(0, cur)) return;
    f32x4 acc[2][2][4][2];
#pragma unroll
    for (int a = 0; a < 2; ++a)
#pragma unroll
        for (int b = 0; b < 2; ++b)
#pragma unroll
            for (int m = 0; m < 4; ++m)
#pragma unroll
                for (int n = 0; n < 2; ++n) acc[a][b][m][n] = (f32x4){0.f, 0.f, 0.f, 0.f};
    bf16x8 At[4][2], B0[2][2], B1[2][2];
    const char* cA = (const char*)(cur.src ? g.A2 : g.A) + (size_t)cur.pm * tA; const char* cB = (const char*)(cur.src ? g.Bt2 : g.Bt) + (size_t)cur.pn * tB;
    S.a_ready(cur);
    if constexpr (SP2) {
        PG8_STAGE(PG8_SB(0, 0), cB, voffB); PG8_STAGE(PG8_SB(0, 1), cB + hB, voffB); PG8_STAGE(PG8_SA(0, 0), cA, voffA); PG8_STAGE(PG8_SA(0, 1), cA + hA, voffA);
        if (wr == 1) PG8_BAR;
        PG8_WAIT_V(2); PG8_BAR;
        PG8_STAGE(PG8_SB(1, 0), cB + kstep, voffB); PG8_STAGE(PG8_SA(1, 0), cA + kstep, voffA); PG8_STAGE(PG8_SB(1, 1), cB + hB + kstep, voffB);
        PG8_WAIT_V(6); PG8_BAR;
    } else {
        PG8_STAGE(PG8_SB(0, 0), cB, voffB); PG8_STAGE(PG8_SA(0, 0), cA, voffA); PG8_STAGE(PG8_SB(0, 1), cB + hB, voffB); PG8_STAGE(PG8_SA(0, 1), cA + hA, voffA);
        if (wr == 1) PG8_BAR;
        PG8_WAIT_V(4); PG8_BAR;
        PG8_STAGE(PG8_SB(1, 0), cB + kstep, voffB); PG8_STAGE(PG8_SA(1, 0), cA + kstep, voffA); PG8_STAGE(PG8_SB(1, 1), cB + hB + kstep, voffB);
        PG8_WAIT_V(6); PG8_BAR;
    }
    for (;;) {
        const bool has_next = S.next(ui + 1, nxt);
        const char* nA = has_next ? (const char*)(nxt.src ? g.A2 : g.A) + (size_t)nxt.pm * tA : cA; const char* nB = has_next ? (const char*)(nxt.src ? g.Bt2 : g.Bt) + (size_t)nxt.pn * tB : cB;
        for (int t = 0; t < nt; t += 2) {
            const bool last = (t == nt - 2);
            const char* a1 = cA + (size_t)(t + 1) * kstep;
            const char* a2 = last ? nA : cA + (size_t)(t + 2) * kstep; const char* b2 = last ? nB : cB + (size_t)(t + 2) * kstep;
            const char* a3 = a2 + kstep; const char* b3 = b2 + kstep;
            if (last && has_next) S.a_ready(nxt);
            if constexpr (SP2) {
            PG8_LDB(B0, 0, 0); PG8_LDB(B1, 0, 1); PG8_SCHED; PG8_LDA(At, 0, 0); PG8_STAGE(PG8_SA(1, 1), a1 + hA, voffA);
            PG8_WAIT_V(8); PG8_WAIT_L(0); PG8_BAR; PG8_MMA(0, 0, At, B0); PG8_MMA(0, 1, At, B1); PG8_BAR; PG8_SCHED;
            PG8_LDA(At, 0, 1); PG8_STAGE(PG8_SB(0, 0), b2, voffB); PG8_STAGE(PG8_SB(0, 1), b2 + hB, voffB); PG8_STAGE(PG8_SA(0, 0), a2, voffA);
            PG8_WAIT_V(8); PG8_WAIT_L(0); PG8_BAR; PG8_MMA(1, 0, At, B0); PG8_MMA(1, 1, At, B1); PG8_BAR; PG8_SCHED;
            PG8_LDB(B0, 1, 0); PG8_LDB(B1, 1, 1); PG8_SCHED; PG8_LDA(At, 1, 0); PG8_STAGE(PG8_SA(0, 1), a2 + hA, voffA);
            PG8_WAIT_V(8); PG8_WAIT_L(0); PG8_BAR; PG8_MMA(0, 0, At, B0); PG8_MMA(0, 1, At, B1); PG8_BAR; PG8_SCHED;
            PG8_LDA(At, 1, 1); PG8_STAGE(PG8_SB(1, 0), b3, voffB); PG8_STAGE(PG8_SB(1, 1), b3 + hB, voffB); PG8_STAGE(PG8_SA(1, 0), a3, voffA);
            PG8_WAIT_V(8); PG8_WAIT_L(0); PG8_BAR; PG8_MMA(1, 0, At, B0); PG8_MMA(1, 1, At, B1); PG8_BAR; PG8_SCHED;
            } else {
            PG8_LDB(B0, 0, 0); PG8_SCHED; PG8_LDA(At, 0, 0); PG8_STAGE(PG8_SA(1, 1), a1 + hA, voffA);
            PG8_WAIT_L(8); PG8_BAR; PG8_WAIT_L(0); PG8_MMA(0, 0, At, B0); PG8_BAR; PG8_SCHED;
            PG8_LDB(B1, 0, 1); PG8_STAGE(PG8_SB(0, 0), b2, voffB);
            PG8_BAR; PG8_WAIT_L(0); PG8_MMA(0, 1, At, B1); PG8_BAR;
            PG8_LDA(At, 0, 1); PG8_STAGE(PG8_SA(0, 0), a2, voffA);
            PG8_BAR; PG8_WAIT_L(0); PG8_MMA(1, 0, At, B0); PG8_BAR; PG8_SCHED;
            PG8_STAGE(PG8_SB(0, 1), b2 + hB, voffB);
            PG8_WAIT_V(6); PG8_BAR; PG8_MMA(1, 1, At, B1); PG8_BAR;
            PG8_LDB(B0, 1, 0); PG8_SCHED; PG8_LDA(At, 1, 0); PG8_STAGE(PG8_SA(0, 1), a2 + hA, voffA);
            PG8_WAIT_L(8); PG8_BAR; PG8_WAIT_L(0); PG8_MMA(0, 0, At, B0); PG8_BAR; PG8_SCHED;
            PG8_LDB(B1, 1, 1); PG8_STAGE(PG8_SB(1, 0), b3, voffB);
            PG8_BAR; PG8_WAIT_L(0); PG8_MMA(0, 1, At, B1); PG8_BAR;
            PG8_LDA(At, 1, 1); PG8_STAGE(PG8_SA(1, 0), a3, voffA);
            PG8_BAR; PG8_WAIT_L(0); PG8_MMA(1, 0, At, B0); PG8_BAR; PG8_SCHED;
            PG8_STAGE(PG8_SB(1, 1), b3 + hB, voffB);
            PG8_WAIT_V(6); PG8_BAR; PG8_MMA(1, 1, At, B1); PG8_BAR;
            }
        }
        if constexpr (ALIGN_EPI) { if (wr == 0) PG8_BAR; }
        if constexpr (!Epi::AFTER_DRAIN) { E(acc, cur, wr, wc, fr, fq); S.done(cur); }
        if (!has_next) break;
#pragma unroll
        for (int a = 0; a < 2; ++a)
#pragma unroll
            for (int b = 0; b < 2; ++b)
#pragma unroll
                for (int m = 0; m < 4; ++m)
#pragma unroll
                    for (int n = 0; n < 2; ++n) acc[a][b][m][n] = (f32x4){0.f, 0.f, 0.f, 0.f};
        cur = nxt; cA = nA; cB = nB; ++ui;
        if constexpr (ALIGN_EPI) { if (wr == 1) PG8_BAR; }
    }
    PG8_WAIT_V(0);
    if constexpr (!ALIGN_EPI) { if (wr == 0) PG8_BAR; }
    PG8_BAR;
    if constexpr (Epi::AFTER_DRAIN) { E.fused(acc, cur, wr, wc, fr, fq, lds, wid, lane); S.done(cur); }
#undef PG8_SA
#undef PG8_SB
#undef PG8_STAGE
#undef PG8_LDA
#undef PG8_LDB
#undef PG8_MMA
#undef PG8_WAIT_V
#undef PG8_WAIT_L
#undef PG8_BAR
#undef PG8_SCHED
}
}

constexpr int DM = 1024, NBP = 8, SEQ = 2048, NBS = 128, TS = 4, MP = NBP * SEQ, MS = NBS * TS, MT = MP + MS;
constexpr int NIN = 6144, DFF = 2816, NUP = 2 * DFF, CAW = 31, HB = 8;
constexpr float EPS = 1e-6f;
constexpr int NWAVES = 8, NTHR = 512;
constexpr size_t O_Y = 0, O_CAP = (size_t)MT * DM, O_CAS = O_CAP + (size_t)NBP * 30 * DM, O_VS = O_CAS + (size_t)NBS * 30 * DM, O_FP = O_VS + (size_t)MS * DM, O_FS = O_FP + (size_t)NBP * 2 * DFF, O_END = O_FS + (size_t)NBS * 2 * DFF;
constexpr size_t MiB = 1u << 20;
constexpr size_t WS_SS1 = 0, WS_SS2 = 128 * 1024, WS_BAR = 512 * 1024;
constexpr size_t WS_WUP = 1 * MiB, WS_WDN = 12 * MiB, WS_WIN = 18 * MiB, WS_WA = 30 * MiB, WS_WB = 32 * MiB, WS_WO = 34 * MiB;
constexpr size_t WS_XN = 36 * MiB;
constexpr size_t WS_GLU = 69 * MiB, WS_UV = 102 * MiB, WS_GG = 168 * MiB;
constexpr size_t WS_MG = WS_GLU;
constexpr size_t WS_ACT = WS_GLU;
constexpr size_t WS_SL = 192 * MiB, WS_SF = 200 * MiB;
constexpr size_t WS_END = WS_SF + (size_t)256 * 4 * DFF * 4;
static_assert(WS_ACT + (size_t)MT * DFF * 2 <= WS_SL && WS_SL + (size_t)256 * 2 * DFF * 4 <= WS_SF && WS_END <= 256 * MiB && WS_GG + (size_t)MT * 2048 * 2 <= 256 * MiB, "d_ws map");
constexpr int LDS_BYTES = 147456;

#define LAS __attribute__((address_space(3)))
typedef unsigned short bf16;
typedef unsigned v4u __attribute__((ext_vector_type(4)));
typedef unsigned v2u __attribute__((ext_vector_type(2)));
typedef float f32x4 __attribute__((ext_vector_type(4)));
typedef float f32x2 __attribute__((ext_vector_type(2)));
typedef short bf16x8 __attribute__((ext_vector_type(8)));
#define LDS_WAIT() asm volatile("s_waitcnt lgkmcnt(0)" ::: "memory")
__device__ __forceinline__ unsigned f2bf(float f) { unsigned u = __builtin_bit_cast(unsigned, f); return (u + 0x7fffu + ((u >> 16) & 1u)) >> 16; }
__device__ __forceinline__ unsigned pk2(float lo, float hi) { return f2bf(lo) | (f2bf(hi) << 16); }
__device__ __forceinline__ float blo(unsigned u) { return __uint_as_float(u << 16); }
__device__ __forceinline__ float bhi(unsigned u) { return __uint_as_float(u & 0xffff0000u); }
__device__ __forceinline__ float sigmf(float x) { return __builtin_amdgcn_rcpf(1.0f + __builtin_amdgcn_exp2f(x * -1.44269504089f)); }
__device__ __forceinline__ float wave_sum(float v) {
#pragma unroll
    for (int o = 1; o < 64; o <<= 1) v += __shfl_xor(v, o);
    return v;
}

struct Args { const float* in[23]; float* out; unsigned char* ws; };
struct Frame { LAS unsigned char* lds; int tid, lane, wave, vcu, G; };
__device__ __forceinline__ Frame phase_frame(const Frame& F0) { Frame F = F0; int t = F0.tid; asm volatile("" : "+v"(t)); F.tid = t; F.lane = t & 63; return F; }

#define XB_TMO      128
#define XB_XCNT(j)  (256  + 64 * (j))
#define XB_XSUB(j)  (1280 + 64 * (j))
#define XB_XGEN(j)  (2304 + 64 * (j))
#define XB_TOP      3328
#define XB_TOPGEN   3392
#define XCD_BAR_WORDS 3456
#define XB_SPIN_CAP (1u << 18)

__device__ __forceinline__ unsigned xb_ld(unsigned* p)              { return __hip_atomic_load(p, __ATOMIC_RELAXED, __HIP_MEMORY_SCOPE_AGENT); }
__device__ __forceinline__ unsigned xb_add(unsigned* p, unsigned v) { return __hip_atomic_fetch_add(p, v, __ATOMIC_RELAXED, __HIP_MEMORY_SCOPE_AGENT); }
__device__ __forceinline__ unsigned xb_xcc_id() { return (unsigned)__builtin_amdgcn_s_getreg((3 << 11) | 20) & 0xFu; }
#define XB_SPIN(cond, bar) do { unsigned _sp = 0; while (cond) { __builtin_amdgcn_s_sleep(1); \
    if ((++_sp & 255u) == 0u) { if (xb_ld(&(bar)[XB_TMO])) break; if (_sp > XB_SPIN_CAP) { atomicAdd(&(bar)[XB_TMO], 1u); break; } } } } while (0)

struct XcdBarrier {
    unsigned* bar; unsigned x;
    volatile LAS unsigned* st;
};

__device__ __forceinline__ XcdBarrier xcd_barrier_post(unsigned* bar, volatile LAS unsigned* st) {
    XcdBarrier b; b.bar = bar; b.x = xb_xcc_id(); b.st = st;
    if (threadIdx.x == 0) (void)xb_add(&bar[XB_XCNT(b.x)], 1u);
    return b;
}
__device__ __forceinline__ void xcd_barrier_complete(unsigned* bar, unsigned x, unsigned& nloc, unsigned& nx) {
    const unsigned G = gridDim.x * gridDim.y * gridDim.z;
    unsigned sum, cnt, mine, sp = 0u;
    for (;;) {
        sum = 0u; cnt = 0u; mine = 0u;
#pragma unroll
        for (unsigned j = 0; j < 16; ++j) { const unsigned c = xb_ld(&bar[XB_XCNT(j)]); sum += c; cnt += (c > 0u) ? 1u : 0u; mine = (j == x) ? c : mine; }
        if (sum == G) break;
        __builtin_amdgcn_s_sleep(1);
        if ((++sp & 255u) == 0u) { if (xb_ld(&bar[XB_TMO])) break; if (sp > XB_SPIN_CAP) { atomicAdd(&bar[XB_TMO], 1u); break; } }
    }
    nloc = mine > 0u ? mine : 1u; nx = cnt > 0u ? cnt : 1u;
}

__device__ __forceinline__ void xcd_barrier(const XcdBarrier& b) {
    asm volatile("s_waitcnt vmcnt(0)" ::: "memory");
    __syncthreads();
    if (threadIdx.x == 0) {
        unsigned* bar = b.bar;
        __builtin_amdgcn_s_waitcnt(0);
        unsigned nloc = b.st[0], nx = b.st[1];
        if (nloc == 0u) { xcd_barrier_complete(bar, b.x, nloc, nx); b.st[0] = nloc; b.st[1] = nx; }
        const unsigned old = xb_add(&bar[XB_XSUB(b.x)], 1u);
        const unsigned gen = old / nloc;
        if (old + 1u == (gen + 1u) * nloc) {
            __builtin_amdgcn_fence(__ATOMIC_RELEASE, "agent");
            asm volatile("s_waitcnt vmcnt(0)" ::: "memory");
            const unsigned og = xb_add(&bar[XB_TOP], 1u);
            const unsigned tg = og / nx;
            if (og + 1u == (tg + 1u) * nx) xb_add(&bar[XB_TOPGEN], 1u);
            else XB_SPIN(xb_ld(&bar[XB_TOPGEN]) == tg, bar);
            __builtin_amdgcn_fence(__ATOMIC_ACQUIRE, "agent");
            xb_add(&bar[XB_XGEN(b.x)], 1u);
            asm volatile("s_waitcnt vmcnt(0)" ::: "memory");
        } else {
            XB_SPIN(xb_ld(&bar[XB_XGEN(b.x)]) == gen, bar);
            __builtin_amdgcn_fence(__ATOMIC_ACQUIRE, "agent");
            asm volatile("s_waitcnt vmcnt(0)" ::: "memory");
        }
    }
    __syncthreads();
}

__device__ __forceinline__ void p0_transpose_item(const float* W, int K, int N, bf16* WT, int mode, const float* kscale, LAS float* scr, int item, int lane) {
    const int nblk = N / 32, kb = item / nblk, nb = item % nblk, k0 = 64 * kb, n0 = 32 * nb;
    float tv[32];
    const float* wp = W + (size_t)(k0 + (lane >> 5)) * N + n0 + (lane & 31);
#pragma unroll
    for (int i = 0; i < 32; ++i) tv[i] = wp[(size_t)(2 * i) * N];
    if (kscale) {
#pragma unroll
        for (int i = 0; i < 32; ++i) tv[i] *= kscale[k0 + 2 * i + (lane >> 5)];
    }
#pragma unroll
    for (int i = 0; i < 32; ++i) scr[(2 * i + (lane >> 5)) * 33 + (lane & 31)] = tv[i];
    LDS_WAIT(); asm volatile("" ::: "memory");
    int n0m = n0;
    if (mode == 1 && n0 < 2048) { const int half = n0 >= 1024 ? 1 : 0, ch = n0 - 1024 * half; n0m = 256 * (ch >> 7) + 128 * half + (ch & 127); }
    if (mode == 2) { const int half = n0 >= 2816 ? 1 : 0, ch = n0 - 2816 * half; n0m = 256 * (ch >> 7) + 128 * half + (ch & 127); }
    const int c = lane & 7;
#pragma unroll
    for (int j = 0; j < 4; ++j) { const int n = (lane >> 3) + 8 * j; const LAS float* s = scr + (8 * c) * 33 + n;
        v4u o; o.x = pk2(s[0 * 33], s[1 * 33]); o.y = pk2(s[2 * 33], s[3 * 33]); o.z = pk2(s[4 * 33], s[5 * 33]); o.w = pk2(s[6 * 33], s[7 * 33]);
        *(v4u*)(WT + (size_t)(n0m + n) * K + k0 + 8 * c) = o; }
    LDS_WAIT(); asm volatile("" ::: "memory");
}
__device__ __forceinline__ void rms_row_to_bf16(const float* xrow, const float* g, bf16* orow, int lane) {
    const f32x4* xr = (const f32x4*)xrow + lane; const f32x4* gr = (const f32x4*)g + lane;
    f32x4 v[4]; float s = 0.f;
#pragma unroll
    for (int j = 0; j < 4; ++j) { v[j] = xr[64 * j]; s += (v[j].x * v[j].x + v[j].y * v[j].y) + (v[j].z * v[j].z + v[j].w * v[j].w); }
    const float rstd = 1.0f / sqrtf(wave_sum(s) * (1.f / DM) + EPS);
    unsigned long long* o8 = (unsigned long long*)orow + lane;
#pragma unroll
    for (int j = 0; j < 4; ++j) { const f32x4 gg = gr[64 * j]; o8[64 * j] = (unsigned long long)pk2(v[j].x * rstd * gg.x, v[j].y * rstd * gg.y) | ((unsigned long long)pk2(v[j].z * rstd * gg.z, v[j].w * rstd * gg.w) << 32); }
}
constexpr int I_IN = (DM / 64) * (NIN / 32), I_SQ = (DM / 64) * (DM / 32), I_UP = (DM / 64) * (NUP / 32), I_DN = (DFF / 64) * (DM / 32), NITEMS = I_IN + 3 * I_SQ + I_UP + I_DN;
__device__ __forceinline__ void p0_weights(const Frame& F0, const Args& a, int it_lo, int it_hi, int widx, int wcnt) {
    const Frame F = phase_frame(F0);
    unsigned char* ws = a.ws;
    LAS float* scr = (LAS float*)(F.lds + F.wave * 16384);
    for (int it = it_lo + widx; it < it_hi; it += wcnt) {
        int r = it;
        if (r < I_IN) { p0_transpose_item(a.in[5], DM, NIN, (bf16*)(ws + WS_WIN), 1, nullptr, scr, r, F.lane); continue; } r -= I_IN;
        if (r < I_SQ) { p0_transpose_item(a.in[10], DM, DM, (bf16*)(ws + WS_WA), 0, nullptr, scr, r, F.lane); continue; } r -= I_SQ;
        if (r < I_SQ) { p0_transpose_item(a.in[15], DM, DM, (bf16*)(ws + WS_WB), 0, nullptr, scr, r, F.lane); continue; } r -= I_SQ;
        if (r < I_SQ) { p0_transpose_item(a.in[16], DM, DM, (bf16*)(ws + WS_WO), 0, nullptr, scr, r, F.lane); continue; } r -= I_SQ;
        if (r < I_UP) { p0_transpose_item(a.in[18], DM, NUP, (bf16*)(ws + WS_WUP), 2, a.in[17], scr, r, F.lane); continue; } r -= I_UP;
        p0_transpose_item(a.in[21], DFF, DM, (bf16*)(ws + WS_WDN), 0, nullptr, scr, r, F.lane);
    }
}
__device__ __forceinline__ void p0_rows(const Frame& F0, const Args& a) {
    const Frame F = phase_frame(F0);
    unsigned char* ws = a.ws;
    const int gw = F.vcu * NWAVES + F.wave, NGW = F.G * NWAVES;
    bf16* XN = (bf16*)(ws + WS_XN);
    for (int m = gw; m < MT; m += 2 * NGW) {
        const int m2 = m + NGW; const bool has2 = m2 < MT; const int mb = has2 ? m2 : m;
        const float* xa = m < MP ? a.in[0] + (size_t)m * DM : a.in[1] + (size_t)(m - MP) * DM;
        const float* xb = mb < MP ? a.in[0] + (size_t)mb * DM : a.in[1] + (size_t)(mb - MP) * DM;
        const f32x4* pa = (const f32x4*)xa + F.lane; const f32x4* pb = (const f32x4*)xb + F.lane; const f32x4* gr = (const f32x4*)a.in[4] + F.lane;
        f32x4 va[4], vb[4]; float sa = 0.f, sb = 0.f;
#pragma unroll
        for (int j = 0; j < 4; ++j) { va[j] = pa[64 * j]; vb[j] = pb[64 * j]; }
#pragma unroll
        for (int j = 0; j < 4; ++j) { sa += (va[j].x * va[j].x + va[j].y * va[j].y) + (va[j].z * va[j].z + va[j].w * va[j].w); sb += (vb[j].x * vb[j].x + vb[j].y * vb[j].y) + (vb[j].z * vb[j].z + vb[j].w * vb[j].w); }
#pragma unroll
        for (int o = 1; o < 64; o <<= 1) { sa += __shfl_xor(sa, o); sb += __shfl_xor(sb, o); }
        const float ra = 1.0f / sqrtf(sa * (1.f / DM) + EPS), rb = 1.0f / sqrtf(sb * (1.f / DM) + EPS);
        unsigned long long* oa = (unsigned long long*)(XN + (size_t)m * DM) + F.lane; unsigned long long* ob = (unsigned long long*)(XN + (size_t)mb * DM) + F.lane;
#pragma unroll
        for (int j = 0; j < 4; ++j) { const f32x4 gg = gr[64 * j];
            oa[64 * j] = (unsigned long long)pk2(va[j].x * ra * gg.x, va[j].y * ra * gg.y) | ((unsigned long long)pk2(va[j].z * ra * gg.z, va[j].w * ra * gg.w) << 32);
            if (has2) ob[64 * j] = (unsigned long long)pk2(vb[j].x * rb * gg.x, vb[j].y * rb * gg.y) | ((unsigned long long)pk2(vb[j].z * rb * gg.z, vb[j].w * rb * gg.w) << 32); }
    }
    float* ss = (float*)(ws + WS_SS1);
    for (int i = F.vcu * NTHR + F.tid; i < (int)(2 * WS_SS2 / 4); i += F.G * NTHR) ss[i] = 0.f;
}

__device__ __forceinline__ void ln_silu_row(const LAS float* src, bf16* dst, const float* g, const float* bt, int lane) {
    f32x4 v[4]; float s = 0.f;
#pragma unroll
    for (int j = 0; j < 4; ++j) { v[j] = *(const LAS f32x4*)(src + 4 * lane + 256 * j); s += (v[j].x + v[j].y) + (v[j].z + v[j].w); }
    const float mean = wave_sum(s) * (1.f / DM); float s2 = 0.f;
#pragma unroll
    for (int j = 0; j < 4; ++j) { v[j] = v[j] - mean; s2 += (v[j].x * v[j].x + v[j].y * v[j].y) + (v[j].z * v[j].z + v[j].w * v[j].w); }
    const float rstd = 1.0f / sqrtf(wave_sum(s2) * (1.f / DM) + EPS);
#pragma unroll
    for (int j = 0; j < 4; ++j) { const f32x4 gg = *(const f32x4*)(g + 4 * lane + 256 * j), bb = *(const f32x4*)(bt + 4 * lane + 256 * j);
        f32x4 y = v[j] * rstd * gg + bb; y = (f32x4){y.x * sigmf(y.x), y.y * sigmf(y.y), y.z * sigmf(y.z), y.w * sigmf(y.w)};
        v2u w; w.x = pk2(y.x, y.y); w.y = pk2(y.z, y.w); *(v2u*)(dst + 4 * lane + 256 * j) = w; }
}
__device__ __forceinline__ void convA_prompt(const Frame& F0, const Args& a, const unsigned* G32, bf16* ACTA, size_t grow0, bool has_hist, float* capout) {
    const Frame F = phase_frame(F0);
    const int c0 = 2 * F.tid;
    LAS float* CB = (LAS float*)F.lds;
    const float* dw = a.in[6];
    f32x2 w[CAW];
#pragma unroll
    for (int k = 0; k < CAW; ++k) w[k] = *(const f32x2*)(dw + k * DM + c0);
    const f32x2 bias = *(const f32x2*)(a.in[7] + c0);
    f32x2 ring[32];
#pragma unroll
    for (int j = 0; j < 32; ++j) ring[j] = (f32x2){0.f, 0.f};
    if (has_hist) {
        const unsigned* hp = G32 + (grow0 - 30) * 512 + F.tid;
#pragma unroll
        for (int j = 0; j < 30; ++j) { const unsigned u = hp[(size_t)j * 512]; ring[2 + j] = (f32x2){blo(u), bhi(u)}; }
    }
    for (int base = 0; base < 64; base += 32) {
        const unsigned* gp = G32 + (grow0 + base) * 512 + F.tid;
#pragma unroll
        for (int jg = 0; jg < 32; jg += 8) {
            unsigned tmp[8];
#pragma unroll
            for (int jj = 0; jj < 8; ++jj) tmp[jj] = gp[(size_t)(jg + jj) * 512];
#pragma unroll
            for (int jj = 0; jj < 8; ++jj) {
                const int j = jg + jj;
                const f32x2 nv = (f32x2){blo(tmp[jj]), bhi(tmp[jj])};
                ring[j] = nv;
                f32x2 o = bias;
#pragma unroll
                for (int k = 0; k < CAW; ++k) o += ring[(j + k + 2) & 31] * w[k];
                *(LAS f32x2*)(CB + j * DM + c0) = o;
            }
            __builtin_amdgcn_sched_barrier(0);
        }
        if (capout && base == 32) {
#pragma unroll
            for (int j = 2; j < 32; ++j) *(f32x2*)(capout + (size_t)(j - 2) * DM + c0) = ring[j];
        }
        __syncthreads();
#pragma unroll 1
        for (int r = F.wave; r < 32; r += NWAVES) ln_silu_row(CB + r * DM, ACTA + (grow0 + base + r) * 2048, a.in[8], a.in[9], F.lane);
        __syncthreads();
    }
}
__device__ __forceinline__ void convA_sample(const Frame& F0, const Args& a, const unsigned* G32, bf16* ACTA, int s, const float* hst, float* casout) {
    const Frame F = phase_frame(F0);
    const int c0 = 2 * F.tid;
    LAS float* CB = (LAS float*)F.lds;
    const float* dw = a.in[6];
    f32x2 w[CAW];
#pragma unroll
    for (int k = 0; k < CAW; ++k) w[k] = *(const f32x2*)(dw + k * DM + c0);
    const f32x2 bias = *(const f32x2*)(a.in[7] + c0);
    f32x2 o[4] = {bias, bias, bias, bias};
    const size_t grow0 = (size_t)MP + 4 * s;
#pragma unroll
    for (int i = 0; i < 34; ++i) {
        f32x2 x;
        if (i < 30) x = *(const f32x2*)(hst + i * DM + c0);
        else { const unsigned u = G32[(grow0 + (i - 30)) * 512 + F.tid]; x = (f32x2){blo(u), bhi(u)}; }
        if (i >= 4) *(f32x2*)(casout + (i - 4) * DM + c0) = x;
#pragma unroll
        for (int t = 0; t < 4; ++t) { const int k = i - t; if (k >= 0 && k < CAW) o[t] += x * w[k]; }
    }
#pragma unroll
    for (int t = 0; t < 4; ++t) *(LAS f32x2*)(CB + t * DM + c0) = o[t];
    __syncthreads();
    if (F.wave < 4) ln_silu_row(CB + F.wave * DM, ACTA + (grow0 + F.wave) * 2048, a.in[8], a.in[9], F.lane);
    __syncthreads();
}

__device__ __forceinline__ void ln_stats16(const bf16* vrow, int lane, float (&x)[16], float& mean, float& rstd) {
    const v4u p = *(const v4u*)(vrow + 8 * lane), q = *(const v4u*)(vrow + 512 + 8 * lane);
    x[0] = blo(p.x); x[1] = bhi(p.x); x[2] = blo(p.y); x[3] = bhi(p.y); x[4] = blo(p.z); x[5] = bhi(p.z); x[6] = blo(p.w); x[7] = bhi(p.w);
    x[8] = blo(q.x); x[9] = bhi(q.x); x[10] = blo(q.y); x[11] = bhi(q.y); x[12] = blo(q.z); x[13] = bhi(q.z); x[14] = blo(q.w); x[15] = bhi(q.w);
    float s = 0.f;
#pragma unroll
    for (int i = 0; i < 16; ++i) s += x[i];
    mean = wave_sum(s) * (1.f / DM); float s2 = 0.f;
#pragma unroll
    for (int i = 0; i < 16; ++i) { const float d = x[i] - mean; s2 += d * d; }
    rstd = 1.0f / sqrtf(wave_sum(s2) * (1.f / DM) + EPS);
}
constexpr int VT_LD = 130, WT_LD = 136;
constexpr int MB_STAT = 0, MB_VT = 1024, MB_WT = MB_VT + 128 * VT_LD * 2 + 64;
static_assert(MB_WT % 16 == 0 && MB_WT + 128 * WT_LD * 2 <= 131072, "mixer-B LDS map");
__device__ __forceinline__ void mixB_prompt(const Frame& F0, const Args& a, bf16* UV, int ch, int hh) {
    const Frame F = phase_frame(F0);
    const size_t R0 = (size_t)ch * 128;
    LAS f32x2* STAT = (LAS f32x2*)(F.lds + MB_STAT);
    LAS unsigned char* VT = F.lds + MB_VT; LAS unsigned char* WT = F.lds + MB_WT;
    const float* lng = a.in[11]; const float* lnb = a.in[12]; const float* w_s = a.in[13]; const float* b_s = a.in[14];
#pragma unroll 1
    for (int i0 = 0; i0 < 16; i0 += 8) {
        v4u pp[8], qq[8];
#pragma unroll
        for (int i = 0; i < 8; ++i) { const bf16* vrow = UV + (R0 + F.wave * 16 + i0 + i) * 2048 + 1024; pp[i] = *(const v4u*)(vrow + 8 * F.lane); qq[i] = *(const v4u*)(vrow + 512 + 8 * F.lane); }
        float sm[8], sq[8];
#pragma unroll
        for (int i = 0; i < 8; ++i) { float x[16]; const v4u p = pp[i], q = qq[i];
            x[0] = blo(p.x); x[1] = bhi(p.x); x[2] = blo(p.y); x[3] = bhi(p.y); x[4] = blo(p.z); x[5] = bhi(p.z); x[6] = blo(p.w); x[7] = bhi(p.w);
            x[8] = blo(q.x); x[9] = bhi(q.x); x[10] = blo(q.y); x[11] = bhi(q.y); x[12] = blo(q.z); x[13] = bhi(q.z); x[14] = blo(q.w); x[15] = bhi(q.w);
            float s1 = 0.f, s2 = 0.f;
#pragma unroll
            for (int k = 0; k < 16; ++k) { s1 += x[k]; s2 += x[k] * x[k]; }
            sm[i] = s1; sq[i] = s2; }
#pragma unroll
        for (int o = 1; o < 64; o <<= 1) {
#pragma unroll
            for (int i = 0; i < 8; ++i) { sm[i] += __shfl_xor(sm[i], o); sq[i] += __shfl_xor(sq[i], o); } }
        if (F.lane == 0) {
#pragma unroll
            for (int i = 0; i < 8; ++i) { const float mean = sm[i] * (1.f / DM), var = fmaxf(sq[i] * (1.f / DM) - mean * mean, 0.f); STAT[F.wave * 16 + i0 + i] = (f32x2){mean, 1.0f / sqrtf(var + EPS)}; } }
    }
    __syncthreads();
    const int lr = F.lane & 15, lq = F.lane >> 4;
    for (int hq = 0; hq < 4; ++hq) {
        const int h = hh * 4 + hq;
#pragma unroll
        for (int i = 0; i < 4; ++i) { const int idx = F.tid + NTHR * i, r = idx >> 4, cgp = idx & 15, c = h * 128 + cgp * 8;
            const v4u p = *(const v4u*)(UV + (R0 + r) * 2048 + 1024 + c); const f32x2 st = STAT[r];
            const f32x4 g0 = *(const f32x4*)(lng + c), g1 = *(const f32x4*)(lng + c + 4), b0 = *(const f32x4*)(lnb + c), b1 = *(const f32x4*)(lnb + c + 4);
            LAS unsigned* dst = (LAS unsigned*)(VT + (r * VT_LD + cgp * 8) * 2);
            dst[0] = pk2((blo(p.x) - st.x) * st.y * g0.x + b0.x, (bhi(p.x) - st.x) * st.y * g0.y + b0.y);
            dst[1] = pk2((blo(p.y) - st.x) * st.y * g0.z + b0.z, (bhi(p.y) - st.x) * st.y * g0.w + b0.w);
            dst[2] = pk2((blo(p.z) - st.x) * st.y * g1.x + b1.x, (bhi(p.z) - st.x) * st.y * g1.y + b1.y);
            dst[3] = pk2((blo(p.w) - st.x) * st.y * g1.z + b1.z, (bhi(p.w) - st.x) * st.y * g1.w + b1.w); }
#pragma unroll
        for (int i = 0; i < 8; ++i) { const int idx = F.tid + NTHR * i, t = idx >> 5, sg = idx & 31;
            const f32x4 wv = *(const f32x4*)(w_s + ((size_t)h * 128 + t) * 128 + sg * 4); const int s0 = sg * 4;
            v2u o; o.x = pk2(s0 <= t ? wv.x : 0.f, s0 + 1 <= t ? wv.y : 0.f); o.y = pk2(s0 + 2 <= t ? wv.z : 0.f, s0 + 3 <= t ? wv.w : 0.f);
            *(LAS v2u*)(WT + (t * WT_LD + s0) * 2) = o; }
        __syncthreads();
        bf16x8 af[4];
#pragma unroll
        for (int ks = 0; ks < 4; ++ks) {
#pragma unroll
            for (int kk = 0; kk < 8; ++kk) af[ks][kk] = (short)*(const LAS unsigned short*)(VT + ((32 * ks + 8 * lq + kk) * VT_LD + 16 * F.wave + lr) * 2);
        }
        v2u uu[8]; float bsv[8];
#pragma unroll
        for (int tb = 0; tb < 8; ++tb) { uu[tb] = *(const v2u*)(UV + (R0 + 16 * tb + lr) * 2048 + h * 128 + 16 * F.wave + 4 * lq); bsv[tb] = b_s[h * 128 + 16 * tb + lr]; }
        v2u oo[8];
#pragma unroll
        for (int tb = 0; tb < 8; ++tb) {
            f32x4 acc = (f32x4){0.f, 0.f, 0.f, 0.f};
#pragma unroll
            for (int ks = 0; ks < 4; ++ks) {
                if (32 * ks <= 16 * tb + 15) {
                    const bf16x8 bfr = *(const LAS bf16x8*)(WT + ((16 * tb + lr) * WT_LD + 32 * ks + 8 * lq) * 2);
                    acc = __builtin_amdgcn_mfma_f32_16x16x32_bf16(af[ks], bfr, acc, 0, 0, 0);
                }
            }
            oo[tb].x = pk2(blo(uu[tb].x) * (acc[0] + bsv[tb]), bhi(uu[tb].x) * (acc[1] + bsv[tb])); oo[tb].y = pk2(blo(uu[tb].y) * (acc[2] + bsv[tb]), bhi(uu[tb].y) * (acc[3] + bsv[tb]));
        }
#pragma unroll
        for (int tb = 0; tb < 8; ++tb) *(v2u*)(UV + (R0 + 16 * tb + lr) * 2048 + h * 128 + 16 * F.wave + 4 * lq) = oo[tb];
        __syncthreads();
    }
}
__device__ __forceinline__ void mixB_sample(const Frame& F0, const Args& a, bf16* UV, int s, float* out_vs) {
    const Frame F = phase_frame(F0);
    LAS float* SV = (LAS float*)F.lds;
    const float* lng = a.in[11]; const float* lnb = a.in[12]; const float* w_s = a.in[13]; const float* b_s = a.in[14];
    const size_t R0 = (size_t)MP + 4 * s;
    if (F.wave < 4) {
        const int t = F.wave; float x[16], mean, rstd; ln_stats16(UV + (R0 + t) * 2048 + 1024, F.lane, x, mean, rstd);
#pragma unroll
        for (int hf = 0; hf < 2; ++hf) { const int c = 512 * hf + 8 * F.lane;
#pragma unroll
            for (int q = 0; q < 2; ++q) { const f32x4 g = *(const f32x4*)(lng + c + 4 * q), b = *(const f32x4*)(lnb + c + 4 * q);
                const f32x4 xv = (f32x4){x[8 * hf + 4 * q], x[8 * hf + 4 * q + 1], x[8 * hf + 4 * q + 2], x[8 * hf + 4 * q + 3]};
                const f32x4 y = (xv - mean) * rstd * g + b;
                *(f32x4*)(out_vs + ((size_t)4 * s + t) * DM + c + 4 * q) = y; *(LAS f32x4*)(SV + t * DM + c + 4 * q) = y; } }
    }
    __syncthreads();
    const int c0 = 2 * F.tid, h = c0 >> 7;
#pragma unroll
    for (int t = 0; t < 4; ++t) {
        const float bsv = b_s[h * 128 + t]; float s0 = bsv, s1 = bsv;
#pragma unroll
        for (int sp = 0; sp <= t; ++sp) { const float wv = w_s[((size_t)h * 128 + t) * 128 + sp]; const f32x2 vv = *(const LAS f32x2*)(SV + sp * DM + c0); s0 += wv * vv.x; s1 += wv * vv.y; }
        unsigned* up = (unsigned*)(UV + (R0 + t) * 2048 + c0); const unsigned uu = *up;
        *up = pk2(blo(uu) * s0, bhi(uu) * s1);
    }
    __syncthreads();
}

__device__ __forceinline__ void ld8f(const float* p, float (&x)[8]) { const f32x4 a = *(const f32x4*)p, b = *(const f32x4*)(p + 4); x[0] = a.x; x[1] = a.y; x[2] = a.z; x[3] = a.w; x[4] = b.x; x[5] = b.y; x[6] = b.z; x[7] = b.w; }
__device__ __forceinline__ void st8f(float* p, const float (&x)[8]) { *(f32x4*)p = (f32x4){x[0], x[1], x[2], x[3]}; *(f32x4*)(p + 4) = (f32x4){x[4], x[5], x[6], x[7]}; }
__device__ __forceinline__ void p6_fixup(const Frame& F0, const Args& a, float* out) {
    const Frame F = phase_frame(F0);
    bf16* ACT = (bf16*)(a.ws + WS_ACT); const float* SL = (const float*)(a.ws + WS_SL); const float* SF = (const float*)(a.ws + WS_SF);
    constexpr int NG = DFF / 8, NIT = 256 * 2 * NG;
    const float* dwf = a.in[19]; const float* bdw = a.in[20];
    for (int it = F.vcu * NTHR + F.tid; it < NIT; it += F.G * NTHR) {
        const int bi = it / NG, cgp = it - bi * NG, c = cgp * 8, blk = bi >> 1, i = bi & 1;
        if ((blk & 31) != 0) {
            float l0[8], l1[8], f0[8], f1[8], fb[8], w0[8], w1[8], w2[8], bs[8];
            ld8f(SL + ((size_t)(blk - 1) * 2 + 0) * DFF + c, l0); ld8f(SL + ((size_t)(blk - 1) * 2 + 1) * DFF + c, l1);
            ld8f(SF + ((size_t)(blk * 2 + 0) * 2 + 0) * DFF + c, f0); ld8f(SF + ((size_t)(blk * 2 + 1) * 2 + 0) * DFF + c, f1); ld8f(SF + ((size_t)(blk * 2 + i) * 2 + 1) * DFF + c, fb);
            ld8f(dwf + c, w0); ld8f(dwf + DFF + c, w1); ld8f(dwf + 2 * DFF + c, w2); ld8f(bdw + c, bs);
            float o[8];
#pragma unroll
            for (int j = 0; j < 8; j += 2) {
                const float x2a = i == 0 ? l0[j] : l1[j], x1a = i == 0 ? l1[j] : f0[j], x0a = i == 0 ? f0[j] : f1[j];
                const float x2b = i == 0 ? l0[j + 1] : l1[j + 1], x1b = i == 0 ? l1[j + 1] : f0[j + 1], x0b = i == 0 ? f0[j + 1] : f1[j + 1];
                f32x2 cv = (f32x2){x2a * w0[j] + x1a * w1[j] + x0a * w2[j] + bs[j], x2b * w0[j + 1] + x1b * w1[j + 1] + x0b * w2[j + 1] + bs[j + 1]};
                cv = pg8::gelu_pk(cv); o[j] = cv.x * fb[j]; o[j + 1] = cv.y * fb[j + 1]; }
            v4u w; w.x = pk2(o[0], o[1]); w.y = pk2(o[2], o[3]); w.z = pk2(o[4], o[5]); w.w = pk2(o[6], o[7]);
            *(v4u*)(ACT + ((size_t)blk * 64 + i) * DFF + c) = w;
        }
        if ((blk & 31) == 31) { float l[8]; ld8f(SL + ((size_t)blk * 2 + i) * DFF + c, l); st8f(out + O_FP + ((size_t)(blk >> 5) * 2 + i) * DFF + c, l); }
    }
}

struct SmallSrc { const bf16* A; int lda; const bf16* Bt; };
template <int NSRC, class Epi>
__device__ __forceinline__ void small_gemm(const Frame& F0, const SmallSrc (&src)[NSRC], int K, int N, const Epi& E) {
    const Frame F = phase_frame(F0);
    const int fr = F.lane & 15, fq = F.lane >> 4;
    const int ntn = N / 32, ntiles = (MS / 32) * ntn;
    for (int tile = F.wave * F.G + F.vcu; tile < ntiles; tile += F.G * NWAVES) {
        const int tm = tile / ntn, tn = tile - tm * ntn;
        f32x4 acc[NSRC][2][2];
#pragma unroll
        for (int sidx = 0; sidx < NSRC; ++sidx) {
            const bf16* ap = src[sidx].A + (size_t)(32 * tm + fr) * src[sidx].lda + 8 * fq;
            const bf16* bp = src[sidx].Bt + (size_t)(32 * tn + fr) * K + 8 * fq;
            const size_t a16 = (size_t)16 * src[sidx].lda, b16 = (size_t)16 * K;
            f32x4 c00 = (f32x4){0.f, 0.f, 0.f, 0.f}, c01 = c00, c10 = c00, c11 = c00;
            bf16x8 a0[2][4], b0[2][4], a1[2][4], b1[2][4];
#define SG_LOAD(A_, B_, kk) do { _Pragma("unroll") for (int i = 0; i < 4; ++i) { A_[0][i] = *(const bf16x8*)(ap + (kk) + 32 * i); A_[1][i] = *(const bf16x8*)(ap + a16 + (kk) + 32 * i); \
        B_[0][i] = *(const bf16x8*)(bp + (kk) + 32 * i); B_[1][i] = *(const bf16x8*)(bp + b16 + (kk) + 32 * i); } } while (0)
#define SG_MMA(A_, B_) do { _Pragma("unroll") for (int i = 0; i < 4; ++i) { c00 = __builtin_amdgcn_mfma_f32_16x16x32_bf16(B_[0][i], A_[0][i], c00, 0, 0, 0); c01 = __builtin_amdgcn_mfma_f32_16x16x32_bf16(B_[1][i], A_[0][i], c01, 0, 0, 0); \
        c10 = __builtin_amdgcn_mfma_f32_16x16x32_bf16(B_[0][i], A_[1][i], c10, 0, 0, 0); c11 = __builtin_amdgcn_mfma_f32_16x16x32_bf16(B_[1][i], A_[1][i], c11, 0, 0, 0); } } while (0)
            SG_LOAD(a0, b0, 0);
#pragma unroll 1
            for (int k = 0; k < K; k += 256) {
                SG_LOAD(a1, b1, k + 128);
                SG_MMA(a0, b0);
                if (k + 256 < K) SG_LOAD(a0, b0, k + 256);
                SG_MMA(a1, b1);
            }
#undef SG_LOAD
#undef SG_MMA
            acc[sidx][0][0] = c00; acc[sidx][0][1] = c01; acc[sidx][1][0] = c10; acc[sidx][1][1] = c11;
        }
#pragma unroll
        for (int i = 0; i < 2; ++i)
#pragma unroll
            for (int j = 0; j < 2; ++j) { f32x4 sub[NSRC];
#pragma unroll
                for (int sidx = 0; sidx < NSRC; ++sidx) sub[sidx] = acc[sidx][i][j];
                E(sub, 32 * tm + 16 * i + fr, 32 * tn + 16 * j + 4 * fq, fq); }
    }
}
struct SEpiMerge {
    bf16* MG; const bf16* GG;
    __device__ __forceinline__ void operator()(const f32x4 (&acc)[2], int r, int c, int fq) const {
        const size_t row = (size_t)MP + r;
        const v2u ga = *(const v2u*)(GG + row * 2048 + c), gb = *(const v2u*)(GG + row * 2048 + 1024 + c);
        v2u o; o.x = pk2(blo(ga.x) * acc[0][0] + blo(gb.x) * acc[1][0], bhi(ga.x) * acc[0][1] + bhi(gb.x) * acc[1][1]);
        o.y = pk2(blo(ga.y) * acc[0][2] + blo(gb.y) * acc[1][2], bhi(ga.y) * acc[0][3] + bhi(gb.y) * acc[1][3]);
        *(v2u*)(MG + row * DM + c) = o;
    }
};
template <bool RB16> struct SEpiRes {
    const float* R; const bf16* RB; float* Y; bf16* YB; float* ss;
    __device__ __forceinline__ void operator()(const f32x4 (&acc)[1], int r, int c, int fq) const {
        const size_t off = (size_t)r * DM + c;
        f32x4 h;
        if (RB16) { const v2u p = *(const v2u*)(RB + off); h = (f32x4){blo(p.x), bhi(p.x), blo(p.y), bhi(p.y)} + acc[0]; *(f32x4*)(Y + off) = h; }
        else { h = *(const f32x4*)(R + off) + acc[0]; v2u w; w.x = pk2(h[0], h[1]); w.y = pk2(h[2], h[3]); *(v2u*)(YB + off) = w; }
        float sq = (h[0] * h[0] + h[1] * h[1]) + (h[2] * h[2] + h[3] * h[3]);
        sq += __shfl_xor(sq, 16); sq += __shfl_xor(sq, 32);
        if (fq == 0) atomicAdd(ss + r, sq);
    }
};

__global__ void __launch_bounds__(NTHR, 2) fwd_mega(Args a) {
    extern __shared__ __attribute__((aligned(16))) unsigned char lds_raw[];
    cg::grid_group grid = cg::this_grid();
    Frame F; F.lds = (LAS unsigned char*)lds_raw; F.tid = threadIdx.x; F.lane = F.tid & 63; F.wave = __builtin_amdgcn_readfirstlane(F.tid >> 6);
    F.G = gridDim.x; { const int bx = blockIdx.x; F.vcu = (F.G % 8 == 0) ? (bx % 8) * (F.G / 8) + bx / 8 : bx; }
    unsigned char* ws = a.ws; float* out = a.out;
    volatile LAS unsigned* bst = (volatile LAS unsigned*)(F.lds + 131072 + 64);
    if (F.tid < 2) bst[F.tid] = 0u;
    __syncthreads();
    bf16* XN = (bf16*)(ws + WS_XN); bf16* GLU = (bf16*)(ws + WS_GLU); bf16* UV = (bf16*)(ws + WS_UV); bf16* GG = (bf16*)(ws + WS_GG);
    bf16* MG = (bf16*)(ws + WS_MG); bf16* ACT = (bf16*)(ws + WS_ACT); bf16* ACTA = (bf16*)(out + O_Y);
    float* ss1 = (float*)(ws + WS_SS1); float* ss2 = (float*)(ws + WS_SS2);

    const XcdBarrier bar = xcd_barrier_post((unsigned*)(ws + WS_BAR), bst);
    if (a.ws == nullptr) grid.sync();
    p0_weights(F, a, 0, I_IN, F.vcu * NWAVES + F.wave, F.G * NWAVES);
    p0_rows(F, a);
    xcd_barrier(bar);
    { pg8::Gemm g{XN, (const bf16*)(ws + WS_WIN), MT, NIN, DM, DM}; pg8::StaticOrder S; S.init(MT, NIN, F.G, (int)blockIdx.x);
      pg8::EpiG1 E{GLU, UV, GG};
      pg8::gemm_phase<pg8::EpiG1, pg8::StaticOrder, true, true>(F.lds, g, S, E);
      const int nu = (MT / 256) * (NIN / 256), extra = nu % F.G;
      if (extra == 0) p0_weights(F, a, I_IN, NITEMS, (int)blockIdx.x * NWAVES + F.wave, F.G * NWAVES);
      else if ((int)blockIdx.x >= extra) p0_weights(F, a, I_IN, NITEMS, ((int)blockIdx.x - extra) * NWAVES + F.wave, (F.G - extra) * NWAVES); }
    xcd_barrier(bar);
    for (int u = F.vcu; u < 256; u += F.G) {
        mixB_prompt(F, a, UV, u >> 1, u & 1);
        { const int b = u >> 5, t0 = (u & 31) * 64; const bool last = (u & 31) == 31;
          convA_prompt(F, a, (const unsigned*)GLU, ACTA, (size_t)b * SEQ + t0, t0 > 0, last ? out + O_CAP + (size_t)b * 30 * DM : nullptr); }
        if (u < 128) convA_sample(F, a, (const unsigned*)GLU, ACTA, u, a.in[2] + (size_t)u * 30 * DM, out + O_CAS + (size_t)u * 30 * DM);
        else mixB_sample(F, a, UV, u - 128, out + O_VS);
    }
    xcd_barrier(bar);
    { const SmallSrc src[2] = {{ACTA + (size_t)MP * 2048, 2048, (const bf16*)(ws + WS_WA)}, {UV + (size_t)MP * 2048, 2048, (const bf16*)(ws + WS_WB)}};
      SEpiMerge E{MG, GG}; small_gemm<2, SEpiMerge>(F, src, DM, DM, E); }
    { pg8::Gemm g{ACTA, (const bf16*)(ws + WS_WA), MP, DM, DM, 2048, UV, (const bf16*)(ws + WS_WB)}; pg8::PairOrder S; S.init(MP, DM, F.G, (int)blockIdx.x);
      pg8::EpiMerge E{MG, GG};
      pg8::gemm_phase<pg8::EpiMerge, pg8::PairOrder, true, true>(F.lds, g, S, E); }
    xcd_barrier(bar);
    { const SmallSrc src[1] = {{MG + (size_t)MP * DM, DM, (const bf16*)(ws + WS_WO)}};
      SEpiRes<false> E{a.in[1], nullptr, nullptr, XN + (size_t)MP * DM, ss1 + MP}; small_gemm<1, SEpiRes<false>>(F, src, DM, DM, E); }
    { pg8::Gemm g{MG, (const bf16*)(ws + WS_WO), MP, DM, DM, DM}; pg8::StaticOrder S; S.init(MP, DM, F.G, (int)blockIdx.x);
      pg8::EpiRes<false> E{a.in[0], nullptr, nullptr, XN, ss1};
      pg8::gemm_phase<pg8::EpiRes<false>, pg8::StaticOrder, true, true>(F.lds, g, S, E); }
    xcd_barrier(bar);
    { pg8::Gemm g{XN, (const bf16*)(ws + WS_WUP), MT, NUP, DM, DM}; pg8::StaticOrder S; S.init(MT, NUP, F.G, (int)blockIdx.x);
      pg8::EpiUpFused E{ACT, ss1, a.in[19], a.in[20], a.in[3], (float*)(ws + WS_SL), (float*)(ws + WS_SF), out + O_FS};
      pg8::gemm_phase<pg8::EpiUpFused, pg8::StaticOrder, true, true>(F.lds, g, S, E); }
    xcd_barrier(bar);
    p6_fixup(F, a, out);
    xcd_barrier(bar);
    { const SmallSrc src[1] = {{ACT + (size_t)MP * DFF, DFF, (const bf16*)(ws + WS_WDN)}};
      SEpiRes<true> E{nullptr, XN + (size_t)MP * DM, out + O_Y + (size_t)MP * DM, nullptr, ss2 + MP}; small_gemm<1, SEpiRes<true>>(F, src, DFF, DM, E); }
    { pg8::Gemm g{ACT, (const bf16*)(ws + WS_WDN), MP, DM, DFF, DFF}; pg8::StaticOrder S; S.init(MP, DM, F.G, (int)blockIdx.x);
      pg8::EpiRes<true> E{nullptr, XN, out + O_Y, nullptr, ss2};
      pg8::gemm_phase<pg8::EpiRes<true>, pg8::StaticOrder, true, true>(F.lds, g, S, E); }
    xcd_barrier(bar);
    { const Frame F8 = phase_frame(F); const f32x4* gr = (const f32x4*)a.in[22] + F8.lane;
      const int NGW = F.G * NWAVES;
      for (int m = F8.vcu * NWAVES + F8.wave; m < MT; m += 4 * NGW) {
          f32x4 v[4][4]; float rstd[4];
#pragma unroll
          for (int q = 0; q < 4; ++q) { const int mq = (m + q * NGW < MT) ? m + q * NGW : m; const f32x4* yr = (const f32x4*)(out + O_Y + (size_t)mq * DM) + F8.lane;
              rstd[q] = ss2[mq];
#pragma unroll
              for (int j = 0; j < 4; ++j) v[q][j] = yr[64 * j]; }
#pragma unroll
          for (int q = 0; q < 4; ++q) { if (m + q * NGW < MT) { f32x4* yw = (f32x4*)(out + O_Y + (size_t)(m + q * NGW) * DM) + F8.lane; const float r = 1.0f / sqrtf(rstd[q] * (1.f / DM) + EPS);
#pragma unroll
              for (int j = 0; j < 4; ++j) yw[64 * j] = v[q][j] * r * gr[64 * j]; } } } }
}

extern "C" void kernel_launch(void* const* d_in, const int* in_sizes, int n_in, void* d_out, int out_size, void* d_ws, size_t ws_size, hipStream_t stream) {
    static int grid = 0;
    if (grid == 0) {
        if (n_in != 23 || (size_t)out_size != O_END || ws_size < WS_END) { fprintf(stderr, "kernel_launch: unexpected shapes: n_in %d out %d ws %zu\n", n_in, out_size, ws_size); grid = -1; return; }
        int dev = 0, cus = 0, per_cu = 0;
        if (hipGetDevice(&dev) != hipSuccess || hipDeviceGetAttribute(&cus, hipDeviceAttributeMultiprocessorCount, dev) != hipSuccess) { grid = -1; return; }
        if (hipFuncSetAttribute((const void*)fwd_mega, hipFuncAttributeMaxDynamicSharedMemorySize, LDS_BYTES) != hipSuccess) { fprintf(stderr, "kernel_launch: hipFuncSetAttribute failed\n"); grid = -1; return; }
        if (hipOccupancyMaxActiveBlocksPerMultiprocessor(&per_cu, (const void*)fwd_mega, NTHR, LDS_BYTES) != hipSuccess || per_cu < 1) { fprintf(stderr, "kernel_launch: occupancy query says %d\n", per_cu); per_cu = 1; }
        (void)hipGetLastError();
        grid = cus * 1;
        fprintf(stderr, "kernel_launch: cus %d per_cu %d grid %d\n", cus, per_cu, grid);
    }
    if (grid < 0) return;
    if (hipMemsetAsync((char*)d_ws + WS_BAR, 0, XCD_BAR_WORDS * 4, stream) != hipSuccess) { fprintf(stderr, "kernel_launch: memset failed\n"); return; }
    Args a{};
    for (int i = 0; i < 23; ++i) a.in[i] = (const float*)d_in[i];
    a.out = (float*)d_out; a.ws = (unsigned char*)d_ws;
    void* args[] = {&a};
    hipError_t e = hipLaunchCooperativeKernel((const void*)fwd_mega, dim3(grid), dim3(NTHR), args, LDS_BYTES, stream);
    if (e != hipSuccess) fprintf(stderr, "kernel_launch: cooperative launch failed: %s (grid %d)\n", hipGetErrorString(e), grid);
}
```

```cpp
#include <hip/hip_runtime.h>
#include <hip/hip_cooperative_groups.h>
#include <cstdio>
#include <cstdint>
namespace cg = cooperative_groups;
namespace pg8 {
#define PG8_LAS __attribute__((address_space(3)))
typedef unsigned short bf16_t;
typedef short bf16x8 __attribute__((ext_vector_type(8)));
typedef float f32x4 __attribute__((ext_vector_type(4)));
typedef unsigned u32x4 __attribute__((ext_vector_type(4)));
constexpr int BM = 256, BK = 64, HALF = 128, HTB = HALF * BK * 2  , STAGE_BYTES = 8 * HTB, NXCD = 8, WGM = 8;

__host__ __device__ __forceinline__ int lds_byte(int r, int c) { const int st = (r >> 4) * 2 + (c >> 5), rr = r & 15, cc = c & 31, ob = rr * 64 + cc * 2; return st * 1024 + (ob ^ (((ob >> 9) & 1) << 5)); }
__host__ __device__ __forceinline__ void stage_rc(int b, int& R, int& C) { const int st = b / 1024, sb = b % 1024, swz = sb ^ (((sb >> 9) & 1) << 5); R = (st >> 1) * 16 + swz / 64; C = (st & 1) * 32 + (swz % 64) / 2; }
__host__ __device__ __forceinline__ int perm32(int rho) { const int n = rho >> 4, i = rho & 15; return 8 * (i >> 2) + 4 * n + (i & 3); }

struct Unit { int pm, pn, src; };
struct Gemm { const bf16_t* A; const bf16_t* Bt; int M, N, K, lda; const bf16_t* A2; const bf16_t* Bt2; };

struct StaticOrder {
    int nM, nN, nwg, G, c;
    __host__ __device__ void init(int M, int N, int G_, int c_) { nM = M / BM; nN = N / BM; nwg = nM * nN; G = G_; c = c_; }
    __host__ __device__ bool next(int i, Unit& u) const {
        const long L = (long)i * G + c; if (L >= nwg) return false;
        int wgid = (int)L; { const int q = nwg / NXCD, r = nwg % NXCD, xcd = wgid % NXCD, off = wgid / NXCD; wgid = (xcd < r ? xcd * (q + 1) : r * (q + 1) + (xcd - r) * q) + off; }
        const int nig = WGM * nN, gid = wgid / nig, fm = gid * WGM, gsz = (nM - fm) < WGM ? (nM - fm) : WGM;
        u.pm = fm + ((wgid % nig) % gsz); u.pn = (wgid % nig) / gsz; u.src = 0; return true;
    }
    __device__ __forceinline__ void a_ready(const Unit&) const {}
    __device__ __forceinline__ void done(const Unit&) const {}
};

struct PairOrder : StaticOrder {
    __host__ __device__ bool next(int i, Unit& u) const { if (!StaticOrder::next(i >> 1, u)) return false; u.src = i & 1; return true; }
};
__device__ __forceinline__ unsigned cvt_pk_bf16(float lo, float hi) { unsigned r; asm volatile("v_cvt_pk_bf16_f32 %0, %1, %2" : "=v"(r) : "v"(lo), "v"(hi)); return r; }
typedef float f32x2 __attribute__((ext_vector_type(2)));
__device__ __forceinline__ f32x2 gelu_pk(f32x2 v) {
    const f32x2 av = __builtin_elementwise_abs(v), d = av * 0.2316418882f + 1.0f;
    f32x2 t; t.x = __builtin_amdgcn_rcpf(d.x); t.y = __builtin_amdgcn_rcpf(d.y);
    f32x2 q = t * 0.5307027145f + (-0.7265760135f); q = q * t + 0.7107068705f; q = q * t + (-0.142248368f); q = q * t + 0.127414796f; q = q * t;
    const f32x2 s = (v * v) * (-0.72134752044f);
    f32x2 e; e.x = __builtin_amdgcn_exp2f(s.x); e.y = __builtin_amdgcn_exp2f(s.y);
    const f32x2 m = v * (q * e), r = v - m;
    f32x2 o; o.x = v.x < 0.f ? m.x : r.x; o.y = v.y < 0.f ? m.y : r.y; return o;
}
typedef unsigned u32x2 __attribute__((ext_vector_type(2)));
__device__ __forceinline__ float sigm(float x) { return __builtin_amdgcn_rcpf(1.0f + __builtin_amdgcn_exp2f(x * -1.44269504089f)); }
__device__ __forceinline__ float bf_lo(unsigned u) { return __uint_as_float(u << 16); }
__device__ __forceinline__ float bf_hi(unsigned u) { return __uint_as_float(u & 0xffff0000u); }

struct EpiG1 {
    static constexpr bool PERM = true, AFTER_DRAIN = false;
    bf16_t* GLU; bf16_t* UV; bf16_t* GG;
    __device__ __forceinline__ void operator()(const f32x4 (&acc)[2][2][4][2], const Unit& u, int wr, int wc, int fr, int fq) const {
        const int row0 = u.pm * BM + wr * 64 + fr;
        if (u.pn < 8) {
            const int col = u.pn * 128 + wc * 32 + 8 * fq;
#pragma unroll
            for (int ai = 0; ai < 2; ++ai)
#pragma unroll
                for (int m = 0; m < 4; ++m) {
                    const f32x4 v0 = acc[ai][0][m][0], v1 = acc[ai][0][m][1], g0 = acc[ai][1][m][0], g1 = acc[ai][1][m][1];
                    u32x4 w; w.x = cvt_pk_bf16(v0[0] * sigm(g0[0]), v0[1] * sigm(g0[1])); w.y = cvt_pk_bf16(v0[2] * sigm(g0[2]), v0[3] * sigm(g0[3]));
                    w.z = cvt_pk_bf16(v1[0] * sigm(g1[0]), v1[1] * sigm(g1[1])); w.w = cvt_pk_bf16(v1[2] * sigm(g1[2]), v1[3] * sigm(g1[3]));
                    *(u32x4*)(GLU + (size_t)(row0 + ai * HALF + m * 16) * 1024 + col) = w; }
        } else {
            const bool isg = u.pn < 16;
            bf16_t* base = isg ? UV : GG;
            const int col0 = (isg ? (u.pn - 8) : (u.pn - 16)) * BM + wc * 32 + 8 * fq;
#pragma unroll
            for (int ai = 0; ai < 2; ++ai)
#pragma unroll
                for (int m = 0; m < 4; ++m) { bf16_t* rowp = base + (size_t)(row0 + ai * HALF + m * 16) * 2048 + col0;
#pragma unroll
                    for (int bj = 0; bj < 2; ++bj) { f32x4 v0 = acc[ai][bj][m][0], v1 = acc[ai][bj][m][1];
                        if (isg) { f32x2 a = gelu_pk((f32x2){v0[0], v0[1]}), b = gelu_pk((f32x2){v0[2], v0[3]}), c = gelu_pk((f32x2){v1[0], v1[1]}), d = gelu_pk((f32x2){v1[2], v1[3]});
                            v0 = (f32x4){a.x, a.y, b.x, b.y}; v1 = (f32x4){c.x, c.y, d.x, d.y}; }
                        else { v0 = (f32x4){sigm(v0[0]), sigm(v0[1]), sigm(v0[2]), sigm(v0[3])}; v1 = (f32x4){sigm(v1[0]), sigm(v1[1]), sigm(v1[2]), sigm(v1[3])}; }
                        u32x4 w; w.x = cvt_pk_bf16(v0[0], v0[1]); w.y = cvt_pk_bf16(v0[2], v0[3]); w.z = cvt_pk_bf16(v1[0], v1[1]); w.w = cvt_pk_bf16(v1[2], v1[3]);
                        *(u32x4*)(rowp + bj * HALF) = w; } }
        }
    }
};
struct EpiMerge {
    static constexpr bool PERM = true, AFTER_DRAIN = false;
    bf16_t* MG; const bf16_t* GG;
    __device__ __forceinline__ void operator()(const f32x4 (&acc)[2][2][4][2], const Unit& u, int wr, int wc, int fr, int fq) const {
        const int row0 = u.pm * BM + wr * 64 + fr, col0 = u.pn * BM + wc * 32 + 8 * fq; const int MODE = u.src;
#pragma unroll
        for (int ai = 0; ai < 2; ++ai) {
            u32x4 gv[4][2], pv[4][2];
#pragma unroll
            for (int m = 0; m < 4; ++m)
#pragma unroll
                for (int bj = 0; bj < 2; ++bj) { const size_t row = (size_t)(row0 + ai * HALF + m * 16); const int col = col0 + bj * HALF;
                    gv[m][bj] = *(const u32x4*)(GG + row * 2048 + MODE * 1024 + col);
                    if (MODE == 1) pv[m][bj] = *(const u32x4*)(MG + row * 1024 + col); }
#pragma unroll
            for (int m = 0; m < 4; ++m)
#pragma unroll
                for (int bj = 0; bj < 2; ++bj) { const size_t row = (size_t)(row0 + ai * HALF + m * 16); const int col = col0 + bj * HALF;
                    const u32x4 g = gv[m][bj];
                    f32x4 v0 = acc[ai][bj][m][0], v1 = acc[ai][bj][m][1];
                    v0 = v0 * (f32x4){bf_lo(g.x), bf_hi(g.x), bf_lo(g.y), bf_hi(g.y)}; v1 = v1 * (f32x4){bf_lo(g.z), bf_hi(g.z), bf_lo(g.w), bf_hi(g.w)};
                    if (MODE == 1) { const u32x4 p = pv[m][bj];
                        v0 = v0 + (f32x4){bf_lo(p.x), bf_hi(p.x), bf_lo(p.y), bf_hi(p.y)}; v1 = v1 + (f32x4){bf_lo(p.z), bf_hi(p.z), bf_lo(p.w), bf_hi(p.w)}; }
                    u32x4 w; w.x = cvt_pk_bf16(v0[0], v0[1]); w.y = cvt_pk_bf16(v0[2], v0[3]); w.z = cvt_pk_bf16(v1[0], v1[1]); w.w = cvt_pk_bf16(v1[2], v1[3]);
                    *(u32x4*)(MG + row * 1024 + col) = w; }
            asm volatile("" ::: "memory"); }
    }
};
template <bool RB16> struct EpiRes {
    static constexpr bool PERM = false, AFTER_DRAIN = false;
    const float* R; const bf16_t* RB; float* Y; bf16_t* YB; float* ss;
    __device__ __forceinline__ void operator()(const f32x4 (&acc)[2][2][4][2], const Unit& u, int wr, int wc, int fr, int fq) const {
        const int row0 = u.pm * BM + wr * 64 + fr, col0 = u.pn * BM + wc * 32 + 4 * fq;
#pragma unroll
        for (int ai = 0; ai < 2; ++ai)
#pragma unroll
            for (int mh = 0; mh < 4; mh += 2) {
                f32x4 rv[2][2][2];
#pragma unroll
                for (int mm = 0; mm < 2; ++mm)
#pragma unroll
                    for (int bj = 0; bj < 2; ++bj)
#pragma unroll
                        for (int n = 0; n < 2; ++n) { const size_t off = (size_t)(row0 + ai * HALF + (mh + mm) * 16) * 1024 + col0 + bj * HALF + n * 16;
                            if (RB16) { const u32x2 p = *(const u32x2*)(RB + off); rv[mm][bj][n] = (f32x4){bf_lo(p.x), bf_hi(p.x), bf_lo(p.y), bf_hi(p.y)}; }
                            else rv[mm][bj][n] = *(const f32x4*)(R + off); }
#pragma unroll
                for (int mm = 0; mm < 2; ++mm) { const int m = mh + mm; const size_t row = (size_t)(row0 + ai * HALF + m * 16); float s = 0.f;
#pragma unroll
                    for (int bj = 0; bj < 2; ++bj)
#pragma unroll
                        for (int n = 0; n < 2; ++n) { const size_t off = row * 1024 + col0 + bj * HALF + n * 16;
                            const f32x4 h = rv[mm][bj][n] + acc[ai][bj][m][n];
                            if (RB16) *(f32x4*)(Y + off) = h;
                            else { u32x2 w; w.x = cvt_pk_bf16(h[0], h[1]); w.y = cvt_pk_bf16(h[2], h[3]); *(u32x2*)(YB + off) = w; }
                            s += (h[0] * h[0] + h[1] * h[1]) + (h[2] * h[2] + h[3] * h[3]); }
                    s += __shfl_xor(s, 16); s += __shfl_xor(s, 32);
                    if (fq == 0) atomicAdd(ss + row, s); }
                asm volatile("" ::: "memory"); }
    }
};
struct EpiUpFused {
    static constexpr bool PERM = true, AFTER_DRAIN = false;
    bf16_t* ACT; const float* ss; const float* dwf; const float* bdw; const float* stf; float* sideLast; float* sideFirst; float* out_fs;
    __device__ __forceinline__ void operator()(const f32x4 (&acc)[2][2][4][2], const Unit& u, int wr, int wc, int fr, int fq) const {
        constexpr int DFF_ = 2816, MP_ = 16384;
        const int cch = u.pn * 128 + wc * 32 + 8 * fq;
        const int lane = fq * 16 + fr, src1 = (lane & 48) | ((fr - 1) & 15), src2 = (lane & 48) | ((fr - 2) & 15);
        f32x4 w0[2], w1[2], w2[2], bs[2];
#pragma unroll
        for (int n = 0; n < 2; ++n) { w0[n] = *(const f32x4*)(dwf + cch + 4 * n); w1[n] = *(const f32x4*)(dwf + DFF_ + cch + 4 * n); w2[n] = *(const f32x4*)(dwf + 2 * DFF_ + cch + 4 * n); bs[n] = *(const f32x4*)(bdw + cch + 4 * n); }
        const bool sample = u.pm >= 64;
#pragma unroll
        for (int ai = 0; ai < 2; ++ai) {
            const int blk = u.pm * 4 + ai * 2 + wr;
            f32x4 p1[2], p2[2];
#pragma unroll
            for (int n = 0; n < 2; ++n) { p1[n] = (f32x4){0.f, 0.f, 0.f, 0.f}; p2[n] = (f32x4){0.f, 0.f, 0.f, 0.f}; }
#pragma unroll
            for (int m = 0; m < 4; ++m) {
                const int row = blk * 64 + 16 * m + fr;
                const float rs = __builtin_amdgcn_rsqf(ss[row] * (1.0f / 1024.0f) + 1e-6f);
                const int t4 = fr & 3, sq = (row - MP_) >> 2;
                u32x4 wout;
#pragma unroll
                for (int n = 0; n < 2; ++n) {
                    const f32x4 av = acc[ai][0][m][n] * rs, bv = acc[ai][1][m][n] * rs;
                    f32x4 r1, r2;
#pragma unroll
                    for (int j = 0; j < 4; ++j) { r1[j] = __shfl(av[j], src1); r2[j] = __shfl(av[j], src2); }
                    f32x4 x1, x2;
                    if (!sample) {
                        x1 = fr == 0 ? p1[n] : r1; x2 = fr < 2 ? p2[n] : r2;
                        if (m == 0 && fr < 2) { float* sf = sideFirst + ((size_t)(blk * 2 + fr) * 2) * DFF_ + cch + 4 * n; *(f32x4*)sf = av; *(f32x4*)(sf + DFF_) = bv; }
                        if (m == 3 && fr >= 14) *(f32x4*)(sideLast + (size_t)(blk * 2 + fr - 14) * DFF_ + cch + 4 * n) = av;
                    } else {
                        const f32x4 s0 = *(const f32x4*)(stf + ((size_t)sq * 2 + 0) * DFF_ + cch + 4 * n), s1 = *(const f32x4*)(stf + ((size_t)sq * 2 + 1) * DFF_ + cch + 4 * n);
                        x1 = t4 >= 1 ? r1 : s1; x2 = t4 >= 2 ? r2 : (t4 == 1 ? s1 : s0);
                        if (t4 >= 2) *(f32x4*)(out_fs + ((size_t)sq * 2 + (t4 - 2)) * DFF_ + cch + 4 * n) = av;
                    }
                    p1[n] = r1; p2[n] = r2;
                    const f32x4 cv = w0[n] * x2 + w1[n] * x1 + w2[n] * av + bs[n];
                    const f32x2 g0 = gelu_pk((f32x2){cv[0], cv[1]}), g1 = gelu_pk((f32x2){cv[2], cv[3]});
                    const unsigned lo = cvt_pk_bf16(g0.x * bv[0], g0.y * bv[1]), hi = cvt_pk_bf16(g1.x * bv[2], g1.y * bv[3]);
                    if (n == 0) { wout.x = lo; wout.y = hi; } else { wout.z = lo; wout.w = hi; }
                }
                *(u32x4*)(ACT + (size_t)row * DFF_ + cch) = wout;
            }
        }
    }
};
template <class Epi, class Sched, bool ALIGN_EPI = false, bool SP2 = false>
__device__ __forceinline__ void gemm_phase(PG8_LAS unsigned char* lds, const Gemm g, const Sched& S, const Epi& E) {
    int tid_ = threadIdx.x; asm volatile("" : "+v"(tid_));
    const int tid = tid_, wid = __builtin_amdgcn_readfirstlane(tid >> 6), lane = tid & 63, wr = wid >> 2, wc = wid & 3, fr = lane & 15, fq = lane >> 4;
    const int K = g.K, nt = K / BK;
    unsigned voffA[2], voffB[2];
#pragma unroll
    for (int i = 0; i < 2; ++i) { int R, C; stage_rc(tid * 16 + i * 8192, R, C); const int Rb = Epi::PERM ? ((R & ~31) + perm32(R & 31)) : R;
        voffA[i] = (unsigned)(R * g.lda + C) * 2u; voffB[i] = (unsigned)(Rb * K + C) * 2u; }
    const size_t kstep = (size_t)(BK * 2);
    const size_t hA = (size_t)HALF * g.lda * 2, hB = (size_t)HALF * K * 2;
    const size_t tA = 2 * hA, tB = 2 * hB;
    const unsigned ldsw = (unsigned)wid * 1024u;
    const int aoff = lds_byte(wr * 64 + fr, fq * 8), boff = lds_byte(wc * 32 + fr, fq * 8);
#define PG8_SA(b, h) (((b) * 2 + (h)) * HTB)
#define PG8_SB(b, h) ((4 + (b) * 2 + (h)) * HTB)
#define PG8_STAGE(bufoff, gbase, voff) do { _Pragma("unroll") for (int _i = 0; _i < 2; ++_i) \
        __builtin_amdgcn_global_load_lds((const unsigned*)((const char*)(gbase) + (voff)[_i]), (PG8_LAS unsigned*)(lds + (bufoff) + ldsw + _i * 8192), 16, 0, 0); } while (0)
#define PG8_LDA(dst, b, h) do { _Pragma("unroll") for (int m = 0; m < 4; ++m) _Pragma("unroll") for (int k = 0; k < 2; ++k) dst[m][k] = *(const PG8_LAS bf16x8*)(lds + PG8_SA(b, h) + aoff + m * 2048 + k * 1024); } while (0)
#define PG8_LDB(dst, b, h) do { _Pragma("unroll") for (int n = 0; n < 2; ++n) _Pragma("unroll") for (int k = 0; k < 2; ++k) dst[n][k] = *(const PG8_LAS bf16x8*)(lds + PG8_SB(b, h) + boff + n * 2048 + k * 1024); } while (0)
#define PG8_MMA(ai, bj, At, Bt) do { __builtin_amdgcn_s_setprio(1); _Pragma("unroll") for (int m = 0; m < 4; ++m) _Pragma("unroll") for (int n = 0; n < 2; ++n) _Pragma("unroll") for (int k = 0; k < 2; ++k) \
        acc[ai][bj][m][n] = __builtin_amdgcn_mfma_f32_16x16x32_bf16(Bt[n][k], At[m][k], acc[ai][bj][m][n], 0, 0, 0); __builtin_amdgcn_s_setprio(0); } while (0)
#define PG8_WAIT_V(n) asm volatile("s_waitcnt vmcnt(" #n ")" ::: "memory")
#define PG8_WAIT_L(n) asm volatile("s_waitcnt lgkmcnt(" #n ")" ::: "memory")
#define PG8_BAR __builtin_amdgcn_s_barrier()
#define PG8_SCHED __builtin_amdgcn_sched_barrier(0)
    Unit cur, nxt; int ui = 0;
    if (!S.next(0, cur)) return;
    f32x4 acc[2][2][4][2];
#pragma unroll
    for (int a = 0; a < 2; ++a)
#pragma unroll
        for (int b = 0; b < 2; ++b)
#pragma unroll
            for (int m = 0; m < 4; ++m)
#pragma unroll
                for (int n = 0; n < 2; ++n) acc[a][b][m][n] = (f32x4){0.f, 0.f, 0.f, 0.f};
    bf16x8 At[4][2], B0[2][2], B1[2][2];
    const char* cA = (const char*)(cur.src ? g.A2 : g.A) + (size_t)cur.pm * tA; const char* cB = (const char*)(cur.src ? g.Bt2 : g.Bt) + (size_t)cur.pn * tB;
    S.a_ready(cur);
    if constexpr (SP2) {
        PG8_STAGE(PG8_SB(0, 0), cB, voffB); PG8_STAGE(PG8_SB(0, 1), cB + hB, voffB); PG8_STAGE(PG8_SA(0, 0), cA, voffA); PG8_STAGE(PG8_SA(0, 1), cA + hA, voffA);
        if (wr == 1) PG8_BAR;
        PG8_WAIT_V(2); PG8_BAR;
        PG8_STAGE(PG8_SB(1, 0), cB + kstep, voffB); PG8_STAGE(PG8_SA(1, 0), cA + kstep, voffA); PG8_STAGE(PG8_SB(1, 1), cB + hB + kstep, voffB);
        PG8_WAIT_V(6); PG8_BAR;
    } else {
        PG8_STAGE(PG8_SB(0, 0), cB, voffB); PG8_STAGE(PG8_SA(0, 0), cA, voffA); PG8_STAGE(PG8_SB(0, 1), cB + hB, voffB); PG8_STAGE(PG8_SA(0, 1), cA + hA, voffA);
        if (wr == 1) PG8_BAR;
        PG8_WAIT_V(4); PG8_BAR;
        PG8_STAGE(PG8_SB(1, 0), cB + kstep, voffB); PG8_STAGE(PG8_SA(1, 0), cA + kstep, voffA); PG8_STAGE(PG8_SB(1, 1), cB + hB + kstep, voffB);
        PG8_WAIT_V(6); PG8_BAR;
    }
    for (;;) {
        const bool has_next = S.next(ui + 1, nxt);
        const char* nA = has_next ? (const char*)(nxt.src ? g.A2 : g.A) + (size_t)nxt.pm * tA : cA; const char* nB = has_next ? (const char*)(nxt.src ? g.Bt2 : g.Bt) + (size_t)nxt.pn * tB : cB;
        for (int t = 0; t < nt; t += 2) {
            const bool last = (t == nt - 2);
            const char* a1 = cA + (size_t)(t + 1) * kstep;
            const char* a2 = last ? nA : cA + (size_t)(t + 2) * kstep; const char* b2 = last ? nB : cB + (size_t)(t + 2) * kstep;
            const char* a3 = a2 + kstep; const char* b3 = b2 + kstep;
            if (last && has_next) S.a_ready(nxt);
            if constexpr (SP2) {
            PG8_LDB(B0, 0, 0); PG8_LDB(B1, 0, 1); PG8_SCHED; PG8_LDA(At, 0, 0); PG8_STAGE(PG8_SA(1, 1), a1 + hA, voffA);
            PG8_WAIT_V(8); PG8_WAIT_L(0); PG8_BAR; PG8_MMA(0, 0, At, B0); PG8_MMA(0, 1, At, B1); PG8_BAR; PG8_SCHED;
            PG8_LDA(At, 0, 1); PG8_STAGE(PG8_SB(0, 0), b2, voffB); PG8_STAGE(PG8_SB(0, 1), b2 + hB, voffB); PG8_STAGE(PG8_SA(0, 0), a2, voffA);
            PG8_WAIT_V(8); PG8_WAIT_L(0); PG8_BAR; PG8_MMA(1, 0, At, B0); PG8_MMA(1, 1, At, B1); PG8_BAR; PG8_SCHED;
            PG8_LDB(B0, 1, 0); PG8_LDB(B1, 1, 1); PG8_SCHED; PG8_LDA(At, 1, 0); PG8_STAGE(PG8_SA(0, 1), a2 + hA, voffA);
            PG8_WAIT_V(8); PG8_WAIT_L(0); PG8_BAR; PG8_MMA(0, 0, At, B0); PG8_MMA(0, 1, At, B1); PG8_BAR; PG8_SCHED;
            PG8_LDA(At, 1, 1); PG8_STAGE(PG8_SB(1, 0), b3, voffB); PG8_STAGE(PG8_SB(1, 1), b3 + hB, voffB); PG8_STAGE(PG8_SA(1, 0), a3, voffA);
            PG8_WAIT_V(8); PG8_WAIT_L(0); PG8_BAR; PG8_MMA(1, 0, At, B0); PG8_MMA(1, 1, At, B1); PG8_BAR; PG8_SCHED;
            } else {
            PG8_LDB(B0, 0, 0); PG8_SCHED; PG8_LDA(At, 0, 0); PG8_STAGE(PG8_SA(1, 1), a1 + hA, voffA);
            PG8_WAIT_L(8); PG8_BAR; PG8_WAIT_L(0); PG8_MMA(0, 0, At, B0); PG8_BAR; PG8_SCHED;
            PG8_LDB(B1, 0, 1); PG8_STAGE(PG8_SB(0, 0), b2, voffB);
            PG8_BAR; PG8_WAIT_L(0); PG8_MMA(0, 1, At, B1); PG8_BAR;
            PG8_LDA(At, 0, 1); PG8_STAGE(PG8_SA(0, 0), a2, voffA);
            PG8_BAR; PG8_WAIT_L(0); PG8_MMA(1, 0, At, B0); PG8_BAR; PG8_SCHED;
            PG8_STAGE(PG8_SB(0, 1), b2 + hB, voffB);
            PG8_WAIT_V(6); PG8_BAR; PG8_MMA(1, 1, At, B1); PG8_BAR;
            PG8_LDB(B0, 1, 0); PG8_SCHED; PG8_LDA(At, 1, 0); PG8_STAGE(PG8_SA(0, 1), a2 + hA, voffA);
            PG8_WAIT_L(8); PG8_BAR; PG8_WAIT_L(0); PG8_MMA(0, 0, At, B0); PG8_BAR; PG8_SCHED;
            PG8_LDB(B1, 1, 1); PG8_STAGE(PG8_SB(1, 0), b3, voffB);
            PG8_BAR; PG8_WAIT_L(0); PG8_MMA(0, 1, At, B1); PG8_BAR;
            PG8_LDA(At, 1, 1); PG8_STAGE(PG8_SA(1, 0), a3, voffA);
            PG8_BAR; PG8_WAIT_L(0); PG8_MMA(1, 0, At, B0); PG8_BAR; PG8_SCHED;
            PG8_STAGE(PG8_SB(1, 1), b3 + hB, voffB);
            PG8_WAIT_V(6); PG8_BAR; PG8_MMA(1, 1, At, B1); PG8_BAR;
            }
        }
        if constexpr (ALIGN_EPI) { if (wr == 0) PG8_BAR; }
        if constexpr (!Epi::AFTER_DRAIN) { E(acc, cur, wr, wc, fr, fq); S.done(cur); }
        if (!has_next) break;
#pragma unroll
        for (int a = 0; a < 2; ++a)
#pragma unroll
            for (int b = 0; b < 2; ++b)
#pragma unroll
                for (int m = 0; m < 4; ++m)
#pragma unroll
                    for (int n = 0; n < 2; ++n) acc[a][b][m][n] = (f32x4){0.f, 0.f, 0.f, 0.f};
        cur = nxt; cA = nA; cB = nB; ++ui;
        if constexpr (ALIGN_EPI) { if (wr == 1) PG8_BAR; }
    }
    PG8_WAIT_V(0);
    if constexpr (!ALIGN_EPI) { if (wr == 0) PG8_BAR; }
    PG8_BAR;
    if constexpr (Epi::AFTER_DRAIN) { E.fused(acc, cur, wr, wc, fr, fq, lds, wid, lane); S.done(cur); }
#undef PG8_SA
#undef PG8_SB
#undef PG8_STAGE
#undef PG8_LDA
#undef PG8_LDB
#undef PG8_MMA
#undef PG8_WAIT_V
#undef PG8_WAIT_L
#undef PG8_BAR
#undef PG8_SCHED
}
}

constexpr int DM = 1024, NBP = 8, SEQ = 2048, NBS = 128, TS = 4, MP = NBP * SEQ, MS = NBS * TS, MT = MP + MS;
constexpr int NIN = 6144, DFF = 2816, NUP = 2 * DFF, CAW = 31, HB = 8;
constexpr float EPS = 1e-6f;
constexpr int NWAVES = 8, NTHR = 512;
constexpr size_t O_Y = 0, O_CAP = (size_t)MT * DM, O_CAS = O_CAP + (size_t)NBP * 30 * DM, O_VS = O_CAS + (size_t)NBS * 30 * DM, O_FP = O_VS + (size_t)MS * DM, O_FS = O_FP + (size_t)NBP * 2 * DFF, O_END = O_FS + (size_t)NBS * 2 * DFF;
constexpr size_t MiB = 1u << 20;
constexpr size_t WS_SS1 = 0, WS_SS2 = 128 * 1024, WS_BAR = 512 * 1024;
constexpr size_t WS_WUP = 1 * MiB, WS_WDN = 12 * MiB, WS_WIN = 18 * MiB, WS_WA = 30 * MiB, WS_WB = 32 * MiB, WS_WO = 34 * MiB;
constexpr size_t WS_XN = 36 * MiB;
constexpr size_t WS_GLU = 69 * MiB, WS_UV = 102 * MiB, WS_GG = 168 * MiB;
constexpr size_t WS_MG = WS_GLU;
constexpr size_t WS_ACT = WS_GLU;
constexpr size_t WS_SL = 192 * MiB, WS_SF = 200 * MiB;
constexpr size_t WS_END = WS_SF + (size_t)256 * 4 * DFF * 4;
static_assert(WS_ACT + (size_t)MT * DFF * 2 <= WS_SL && WS_SL + (size_t)256 * 2 * DFF * 4 <= WS_SF && WS_END <= 256 * MiB && WS_GG + (size_t)MT * 2048 * 2 <= 256 * MiB, "d_ws map");
constexpr int LDS_BYTES = 147456;

#define LAS __attribute__((address_space(3)))
typedef unsigned short bf16;
typedef unsigned v4u __attribute__((ext_vector_type(4)));
typedef unsigned v2u __attribute__((ext_vector_type(2)));
typedef float f32x4 __attribute__((ext_vector_type(4)));
typedef float f32x2 __attribute__((ext_vector_type(2)));
typedef short bf16x8 __attribute__((ext_vector_type(8)));
#define LDS_WAIT() asm volatile("s_waitcnt lgkmcnt(0)" ::: "memory")
__device__ __forceinline__ unsigned f2bf(float f) { unsigned u = __builtin_bit_cast(unsigned, f); return (u + 0x7fffu + ((u >> 16) & 1u)) >> 16; }
__device__ __forceinline__ unsigned pk2(float lo, float hi) { return f2bf(lo) | (f2bf(hi) << 16); }
__device__ __forceinline__ float blo(unsigned u) { return __uint_as_float(u << 16); }
__device__ __forceinline__ float bhi(unsigned u) { return __uint_as_float(u & 0xffff0000u); }
__device__ __forceinline__ float sigmf(float x) { return __builtin_amdgcn_rcpf(1.0f + __builtin_amdgcn_exp2f(x * -1.44269504089f)); }
__device__ __forceinline__ float wave_sum(float v) {
#pragma unroll
    for (int o = 1; o < 64; o <<= 1) v += __shfl_xor(v, o);
    return v;
}

struct Args { const float* in[23]; float* out; unsigned char* ws; };
struct Frame { LAS unsigned char* lds; int tid, lane, wave, vcu, G; };
__device__ __forceinline__ Frame phase_frame(const Frame& F0) { Frame F = F0; int t = F0.tid; asm volatile("" : "+v"(t)); F.tid = t; F.lane = t & 63; return F; }

#define XB_TMO      128
#define XB_XCNT(j)  (256  + 64 * (j))
#define XB_XSUB(j)  (1280 + 64 * (j))
#define XB_XGEN(j)  (2304 + 64 * (j))
#define XB_TOP      3328
#define XB_TOPGEN   3392
#define XCD_BAR_WORDS 3456
#define XB_SPIN_CAP (1u << 18)

__device__ __forceinline__ unsigned xb_ld(unsigned* p)              { return __hip_atomic_load(p, __ATOMIC_RELAXED, __HIP_MEMORY_SCOPE_AGENT); }
__device__ __forceinline__ unsigned xb_add(unsigned* p, unsigned v) { return __hip_atomic_fetch_add(p, v, __ATOMIC_RELAXED, __HIP_MEMORY_SCOPE_AGENT); }
__device__ __forceinline__ unsigned xb_xcc_id() { return (unsigned)__builtin_amdgcn_s_getreg((3 << 11) | 20) & 0xFu; }
#define XB_SPIN(cond, bar) do { unsigned _sp = 0; while (cond) { __builtin_amdgcn_s_sleep(1); \
    if ((++_sp & 255u) == 0u) { if (xb_ld(&(bar)[XB_TMO])) break; if (_sp > XB_SPIN_CAP) { atomicAdd(&(bar)[XB_TMO], 1u); break; } } } } while (0)

struct XcdBarrier {
    unsigned* bar; unsigned x;
    volatile LAS unsigned* st;
};

__device__ __forceinline__ XcdBarrier xcd_barrier_post(unsigned* bar, volatile LAS unsigned* st) {
    XcdBarrier b; b.bar = bar; b.x = xb_xcc_id(); b.st = st;
    if (threadIdx.x == 0) (void)xb_add(&bar[XB_XCNT(b.x)], 1u);
    return b;
}
__device__ __forceinline__ void xcd_barrier_complete(unsigned* bar, unsigned x, unsigned& nloc, unsigned& nx) {
    const unsigned G = gridDim.x * gridDim.y * gridDim.z;
    unsigned sum, cnt, mine, sp = 0u;
    for (;;) {
        sum = 0u; cnt = 0u; mine = 0u;
#pragma unroll
        for (unsigned j = 0; j < 16; ++j) { const unsigned c = xb_ld(&bar[XB_XCNT(j)]); sum += c; cnt += (c > 0u) ? 1u : 0u; mine = (j == x) ? c : mine; }
        if (sum == G) break;
        __builtin_amdgcn_s_sleep(1);
        if ((++sp & 255u) == 0u) { if (xb_ld(&bar[XB_TMO])) break; if (sp > XB_SPIN_CAP) { atomicAdd(&bar[XB_TMO], 1u); break; } }
    }
    nloc = mine > 0u ? mine : 1u; nx = cnt > 0u ? cnt : 1u;
}

__device__ __forceinline__ void xcd_barrier(const XcdBarrier& b) {
    asm volatile("s_waitcnt vmcnt(0)" ::: "memory");
    __syncthreads();
    if (threadIdx.x == 0) {
        unsigned* bar = b.bar;
        __builtin_amdgcn_s_waitcnt(0);
        unsigned nloc = b.st[0], nx = b.st[1];
        if (nloc == 0u) { xcd_barrier_complete(bar, b.x, nloc, nx); b.st[0] = nloc; b.st[1] = nx; }
        const unsigned old = xb_add(&bar[XB_XSUB(b.x)], 1u);
        const unsigned gen = old / nloc;
        if (old + 1u == (gen + 1u) * nloc) {
            __builtin_amdgcn_fence(__ATOMIC_RELEASE, "agent");
            asm volatile("s_waitcnt vmcnt(0)" ::: "memory");
            const unsigned og = xb_add(&bar[XB_TOP], 1u);
            const unsigned tg = og / nx;
            if (og + 1u == (tg + 1u) * nx) xb_add(&bar[XB_TOPGEN], 1u);
            else XB_SPIN(xb_ld(&bar[XB_TOPGEN]) == tg, bar);
            __builtin_amdgcn_fence(__ATOMIC_ACQUIRE, "agent");
            xb_add(&bar[XB_XGEN(b.x)], 1u);
            asm volatile("s_waitcnt vmcnt(0)" ::: "memory");
        } else {
            XB_SPIN(xb_ld(&bar[XB_XGEN(b.x)]) == gen, bar);
            __builtin_amdgcn_fence(__ATOMIC_ACQUIRE, "agent");
            asm volatile("s_waitcnt vmcnt(0)" ::: "memory");
        }
    }
    __syncthreads();
}

__device__ __forceinline__ void p0_transpose_item(const float* W, int K, int N, bf16* WT, int mode, const float* kscale, LAS float* scr, int item, int lane) {
    const int nblk = N / 32, kb = item / nblk, nb = item % nblk, k0 = 64 * kb, n0 = 32 * nb;
    float tv[32];
    const float* wp = W + (size_t)(k0 + (lane >> 5)) * N + n0 + (lane & 31);
#pragma unroll
    for (int i = 0; i < 32; ++i) tv[i] = wp[(size_t)(2 * i) * N];
    if (kscale) {
#pragma unroll
        for (int i = 0; i < 32; ++i) tv[i] *= kscale[k0 + 2 * i + (lane >> 5)];
    }
#pragma unroll
    for (int i = 0; i < 32; ++i) scr[(2 * i + (lane >> 5)) * 33 + (lane & 31)] = tv[i];
    LDS_WAIT(); asm volatile("" ::: "memory");
    int n0m = n0;
    if (mode == 1 && n0 < 2048) { const int half = n0 >= 1024 ? 1 : 0, ch = n0 - 1024 * half; n0m = 256 * (ch >> 7) + 128 * half + (ch & 127); }
    if (mode == 2) { const int half = n0 >= 2816 ? 1 : 0, ch = n0 - 2816 * half; n0m = 256 * (ch >> 7) + 128 * half + (ch & 127); }
    const int c = lane & 7;
#pragma unroll
    for (int j = 0; j < 4; ++j) { const int n = (lane >> 3) + 8 * j; const LAS float* s = scr + (8 * c) * 33 + n;
        v4u o; o.x = pk2(s[0 * 33], s[1 * 33]); o.y = pk2(s[2 * 33], s[3 * 33]); o.z = pk2(s[4 * 33], s[5 * 33]); o.w = pk2(s[6 * 33], s[7 * 33]);
        *(v4u*)(WT + (size_t)(n0m + n) * K + k0 + 8 * c) = o; }
    LDS_WAIT(); asm volatile("" ::: "memory");
}
__device__ __forceinline__ void rms_row_to_bf16(const float* xrow, const float* g, bf16* orow, int lane) {
    const f32x4* xr = (const f32x4*)xrow + lane; const f32x4* gr = (const f32x4*)g + lane;
    f32x4 v[4]; float s = 0.f;
#pragma unroll
    for (int j = 0; j < 4; ++j) { v[j] = xr[64 * j]; s += (v[j].x * v[j].x + v[j].y * v[j].y) + (v[j].z * v[j].z + v[j].w * v[j].w); }
    const float rstd = 1.0f / sqrtf(wave_sum(s) * (1.f / DM) + EPS);
    unsigned long long* o8 = (unsigned long long*)orow + lane;
#pragma unroll
    for (int j = 0; j < 4; ++j) { const f32x4 gg = gr[64 * j]; o8[64 * j] = (unsigned long long)pk2(v[j].x * rstd * gg.x, v[j].y * rstd * gg.y) | ((unsigned long long)pk2(v[j].z * rstd * gg.z, v[j].w * rstd * gg.w) << 32); }
}
constexpr int I_IN = (DM / 64) * (NIN / 32), I_SQ = (DM / 64) * (DM / 32), I_UP = (DM / 64) * (NUP / 32), I_DN = (DFF / 64) * (DM / 32), NITEMS = I_IN + 3 * I_SQ + I_UP + I_DN;
__device__ __forceinline__ void p0_weights(const Frame& F0, const Args& a, int it_lo, int it_hi, int widx, int wcnt) {
    const Frame F = phase_frame(F0);
    unsigned char* ws = a.ws;
    LAS float* scr = (LAS float*)(F.lds + F.wave * 16384);
    for (int it = it_lo + widx; it < it_hi; it += wcnt) {
        int r = it;
        if (r < I_IN) { p0_transpose_item(a.in[5], DM, NIN, (bf16*)(ws + WS_WIN), 1, nullptr, scr, r, F.lane); continue; } r -= I_IN;
        if (r < I_SQ) { p0_transpose_item(a.in[10], DM, DM, (bf16*)(ws + WS_WA), 0, nullptr, scr, r, F.lane); continue; } r -= I_SQ;
        if (r < I_SQ) { p0_transpose_item(a.in[15], DM, DM, (bf16*)(ws + WS_WB), 0, nullptr, scr, r, F.lane); continue; } r -= I_SQ;
        if (r < I_SQ) { p0_transpose_item(a.in[16], DM, DM, (bf16*)(ws + WS_WO), 0, nullptr, scr, r, F.lane); continue; } r -= I_SQ;
        if (r < I_UP) { p0_transpose_item(a.in[18], DM, NUP, (bf16*)(ws + WS_WUP), 2, a.in[17], scr, r, F.lane); continue; } r -= I_UP;
        p0_transpose_item(a.in[21], DFF, DM, (bf16*)(ws + WS_WDN), 0, nullptr, scr, r, F.lane);
    }
}
__device__ __forceinline__ void p0_rows(const Frame& F0, const Args& a) {
    const Frame F = phase_frame(F0);
    unsigned char* ws = a.ws;
    const int gw = F.vcu * NWAVES + F.wave, NGW = F.G * NWAVES;
    bf16* XN = (bf16*)(ws + WS_XN);
    for (int m = gw; m < MT; m += 2 * NGW) {
        const int m2 = m + NGW; const bool has2 = m2 < MT; const int mb = has2 ? m2 : m;
        const float* xa = m < MP ? a.in[0] + (size_t)m * DM : a.in[1] + (size_t)(m - MP) * DM;
        const float* xb = mb < MP ? a.in[0] + (size_t)mb * DM : a.in[1] + (size_t)(mb - MP) * DM;
        const f32x4* pa = (const f32x4*)xa + F.lane; const f32x4* pb = (const f32x4*)xb + F.lane; const f32x4* gr = (const f32x4*)a.in[4] + F.lane;
        f32x4 va[4], vb[4]; float sa = 0.f, sb = 0.f;
#pragma unroll
        for (int j = 0; j < 4; ++j) { va[j] = pa[64 * j]; vb[j] = pb[64 * j]; }
#pragma unroll
        for (int j = 0; j < 4; ++j) { sa += (va[j].x * va[j].x + va[j].y * va[j].y) + (va[j].z * va[j].z + va[j].w * va[j].w); sb += (vb[j].x * vb[j].x + vb[j].y * vb[j].y) + (vb[j].z * vb[j].z + vb[j].w * vb[j].w); }
#pragma unroll
        for (int o = 1; o < 64; o <<= 1) { sa += __shfl_xor(sa, o); sb += __shfl_xor(sb, o); }
        const float ra = 1.0f / sqrtf(sa * (1.f / DM) + EPS), rb = 1.0f / sqrtf(sb * (1.f / DM) + EPS);
        unsigned long long* oa = (unsigned long long*)(XN + (size_t)m * DM) + F.lane; unsigned long long* ob = (unsigned long long*)(XN + (size_t)mb * DM) + F.lane;
#pragma unroll
        for (int j = 0; j < 4; ++j) { const f32x4 gg = gr[64 * j];
            oa[64 * j] = (unsigned long long)pk2(va[j].x * ra * gg.x, va[j].y * ra * gg.y) | ((unsigned long long)pk2(va[j].z * ra * gg.z, va[j].w * ra * gg.w) << 32);
            if (has2) ob[64 * j] = (unsigned long long)pk2(vb[j].x * rb * gg.x, vb[j].y * rb * gg.y) | ((unsigned long long)pk2(vb[j].z * rb * gg.z, vb[j].w * rb * gg.w) << 32); }
    }
    float* ss = (float*)(ws + WS_SS1);
    for (int i = F.vcu * NTHR + F.tid; i < (int)(2 * WS_SS2 / 4); i += F.G * NTHR) ss[i] = 0.f;
}

__device__ __forceinline__ void ln_silu_row(const LAS float* src, bf16* dst, const float* g, const float* bt, int lane) {
    f32x4 v[4]; float s = 0.f;
#pragma unroll
    for (int j = 0; j < 4; ++j) { v[j] = *(const LAS f32x4*)(src + 4 * lane + 256 * j); s += (v[j].x + v[j].y) + (v[j].z + v[j].w); }
    const float mean = wave_sum(s) * (1.f / DM); float s2 = 0.f;
#pragma unroll
    for (int j = 0; j < 4; ++j) { v[j] = v[j] - mean; s2 += (v[j].x * v[j].x + v[j].y * v[j].y) + (v[j].z * v[j].z + v[j].w * v[j].w); }
    const float rstd = 1.0f / sqrtf(wave_sum(s2) * (1.f / DM) + EPS);
#pragma unroll
    for (int j = 0; j < 4; ++j) { const f32x4 gg = *(const f32x4*)(g + 4 * lane + 256 * j), bb = *(const f32x4*)(bt + 4 * lane + 256 * j);
        f32x4 y = v[j] * rstd * gg + bb; y = (f32x4){y.x * sigmf(y.x), y.y * sigmf(y.y), y.z * sigmf(y.z), y.w * sigmf(y.w)};
        v2u w; w.x = pk2(y.x, y.y); w.y = pk2(y.z, y.w); *(v2u*)(dst + 4 * lane + 256 * j) = w; }
}
__device__ __forceinline__ void convA_prompt(const Frame& F0, const Args& a, const unsigned* G32, bf16* ACTA, size_t grow0, bool has_hist, float* capout) {
    const Frame F = phase_frame(F0);
    const int c0 = 2 * F.tid;
    LAS float* CB = (LAS float*)F.lds;
    const float* dw = a.in[6];
    f32x2 w[CAW];
#pragma unroll
    for (int k = 0; k < CAW; ++k) w[k] = *(const f32x2*)(dw + k * DM + c0);
    const f32x2 bias = *(const f32x2*)(a.in[7] + c0);
    f32x2 ring[32];
#pragma unroll
    for (int j = 0; j < 32; ++j) ring[j] = (f32x2){0.f, 0.f};
    if (has_hist) {
        const unsigned* hp = G32 + (grow0 - 30) * 512 + F.tid;
#pragma unroll
        for (int j = 0; j < 30; ++j) { const unsigned u = hp[(size_t)j * 512]; ring[2 + j] = (f32x2){blo(u), bhi(u)}; }
    }
    for (int base = 0; base < 64; base += 32) {
        const unsigned* gp = G32 + (grow0 + base) * 512 + F.tid;
        unsigned tmp[2][8];
#pragma unroll
        for (int jj = 0; jj < 8; ++jj) tmp[0][jj] = gp[(size_t)jj * 512];
#pragma unroll
        for (int jg = 0; jg < 32; jg += 8) {
            if (jg + 8 < 32) {
#pragma unroll
                for (int jj = 0; jj < 8; ++jj) tmp[((jg >> 3) + 1) & 1][jj] = gp[(size_t)(jg + 8 + jj) * 512];
            }
#pragma unroll
            for (int jj = 0; jj < 8; ++jj) {
                const int j = jg + jj;
                const unsigned tv = tmp[(jg >> 3) & 1][jj];
                const f32x2 nv = (f32x2){blo(tv), bhi(tv)};
                ring[j] = nv;
                f32x2 o = bias;
#pragma unroll
                for (int k = 0; k < CAW; ++k) o += ring[(j + k + 2) & 31] * w[k];
                *(LAS f32x2*)(CB + j * DM + c0) = o;
            }
            __builtin_amdgcn_sched_barrier(0);
        }
        if (capout && base == 32) {
#pragma unroll
            for (int j = 2; j < 32; ++j) *(f32x2*)(capout + (size_t)(j - 2) * DM + c0) = ring[j];
        }
        __syncthreads();
#pragma unroll 1
        for (int r = F.wave; r < 32; r += NWAVES) ln_silu_row(CB + r * DM, ACTA + (grow0 + base + r) * 2048, a.in[8], a.in[9], F.lane);
        __syncthreads();
    }
}
__device__ __forceinline__ void convA_sample(const Frame& F0, const Args& a, const unsigned* G32, bf16* ACTA, int s, const float* hst, float* casout) {
    const Frame F = phase_frame(F0);
    const int c0 = 2 * F.tid;
    LAS float* CB = (LAS float*)F.lds;
    const float* dw = a.in[6];
    f32x2 w[CAW];
#pragma unroll
    for (int k = 0; k < CAW; ++k) w[k] = *(const f32x2*)(dw + k * DM + c0);
    const f32x2 bias = *(const f32x2*)(a.in[7] + c0);
    f32x2 o[4] = {bias, bias, bias, bias};
    const size_t grow0 = (size_t)MP + 4 * s;
#pragma unroll
    for (int i = 0; i < 34; ++i) {
        f32x2 x;
        if (i < 30) x = *(const f32x2*)(hst + i * DM + c0);
        else { const unsigned u = G32[(grow0 + (i - 30)) * 512 + F.tid]; x = (f32x2){blo(u), bhi(u)}; }
        if (i >= 4) *(f32x2*)(casout + (i - 4) * DM + c0) = x;
#pragma unroll
        for (int t = 0; t < 4; ++t) { const int k = i - t; if (k >= 0 && k < CAW) o[t] += x * w[k]; }
    }
#pragma unroll
    for (int t = 0; t < 4; ++t) *(LAS f32x2*)(CB + t * DM + c0) = o[t];
    __syncthreads();
    if (F.wave < 4) ln_silu_row(CB + F.wave * DM, ACTA + (grow0 + F.wave) * 2048, a.in[8], a.in[9], F.lane);
    __syncthreads();
}

__device__ __forceinline__ void ln_stats16(const bf16* vrow, int lane, float (&x)[16], float& mean, float& rstd) {
    const v4u p = *(const v4u*)(vrow + 8 * lane), q = *(const v4u*)(vrow + 512 + 8 * lane);
    x[0] = blo(p.x); x[1] = bhi(p.x); x[2] = blo(p.y); x[3] = bhi(p.y); x[4] = blo(p.z); x[5] = bhi(p.z); x[6] = blo(p.w); x[7] = bhi(p.w);
    x[8] = blo(q.x); x[9] = bhi(q.x); x[10] = blo(q.y); x[11] = bhi(q.y); x[12] = blo(q.z); x[13] = bhi(q.z); x[14] = blo(q.w); x[15] = bhi(q.w);
    float s = 0.f;
#pragma unroll
    for (int i = 0; i < 16; ++i) s += x[i];
    mean = wave_sum(s) * (1.f / DM); float s2 = 0.f;
#pragma unroll
    for (int i = 0; i < 16; ++i) { const float d = x[i] - mean; s2 += d * d; }
    rstd = 1.0f / sqrtf(wave_sum(s2) * (1.f / DM) + EPS);
}
constexpr int VT_LD = 130, WT_LD = 136;
constexpr int MB_STAT = 0, MB_VT = 1024, MB_WT = MB_VT + 128 * VT_LD * 2 + 64;
static_assert(MB_WT % 16 == 0 && MB_WT + 128 * WT_LD * 2 <= 131072, "mixer-B LDS map");
__device__ __forceinline__ void mixB_prompt(const Frame& F0, const Args& a, bf16* UV, int ch, int hh) {
    const Frame F = phase_frame(F0);
    const size_t R0 = (size_t)ch * 128;
    LAS f32x2* STAT = (LAS f32x2*)(F.lds + MB_STAT);
    LAS unsigned char* VT = F.lds + MB_VT; LAS unsigned char* WT = F.lds + MB_WT;
    const float* lng = a.in[11]; const float* lnb = a.in[12]; const float* w_s = a.in[13]; const float* b_s = a.in[14];
#pragma unroll 1
    for (int i0 = 0; i0 < 16; i0 += 8) {
        v4u pp[8], qq[8];
#pragma unroll
        for (int i = 0; i < 8; ++i) { const bf16* vrow = UV + (R0 + F.wave * 16 + i0 + i) * 2048 + 1024; pp[i] = *(const v4u*)(vrow + 8 * F.lane); qq[i] = *(const v4u*)(vrow + 512 + 8 * F.lane); }
        float sm[8], sq[8];
#pragma unroll
        for (int i = 0; i < 8; ++i) { float x[16]; const v4u p = pp[i], q = qq[i];
            x[0] = blo(p.x); x[1] = bhi(p.x); x[2] = blo(p.y); x[3] = bhi(p.y); x[4] = blo(p.z); x[5] = bhi(p.z); x[6] = blo(p.w); x[7] = bhi(p.w);
            x[8] = blo(q.x); x[9] = bhi(q.x); x[10] = blo(q.y); x[11] = bhi(q.y); x[12] = blo(q.z); x[13] = bhi(q.z); x[14] = blo(q.w); x[15] = bhi(q.w);
            float s1 = 0.f, s2 = 0.f;
#pragma unroll
            for (int k = 0; k < 16; ++k) { s1 += x[k]; s2 += x[k] * x[k]; }
            sm[i] = s1; sq[i] = s2; }
#pragma unroll
        for (int o = 1; o < 64; o <<= 1) {
#pragma unroll
            for (int i = 0; i < 8; ++i) { sm[i] += __shfl_xor(sm[i], o); sq[i] += __shfl_xor(sq[i], o); } }
        if (F.lane == 0) {
#pragma unroll
            for (int i = 0; i < 8; ++i) { const float mean = sm[i] * (1.f / DM), var = fmaxf(sq[i] * (1.f / DM) - mean * mean, 0.f); STAT[F.wave * 16 + i0 + i] = (f32x2){mean, 1.0f / sqrtf(var + EPS)}; } }
    }
    __syncthreads();
    const int lr = F.lane & 15, lq = F.lane >> 4;
    for (int hq = 0; hq < 4; ++hq) {
        const int h = hh * 4 + hq;
#pragma unroll
        for (int i = 0; i < 4; ++i) { const int idx = F.tid + NTHR * i, r = idx >> 4, cgp = idx & 15, c = h * 128 + cgp * 8;
            const v4u p = *(const v4u*)(UV + (R0 + r) * 2048 + 1024 + c); const f32x2 st = STAT[r];
            const f32x4 g0 = *(const f32x4*)(lng + c), g1 = *(const f32x4*)(lng + c + 4), b0 = *(const f32x4*)(lnb + c), b1 = *(const f32x4*)(lnb + c + 4);
            LAS unsigned* dst = (LAS unsigned*)(VT + (r * VT_LD + cgp * 8) * 2);
            dst[0] = pk2((blo(p.x) - st.x) * st.y * g0.x + b0.x, (bhi(p.x) - st.x) * st.y * g0.y + b0.y);
            dst[1] = pk2((blo(p.y) - st.x) * st.y * g0.z + b0.z, (bhi(p.y) - st.x) * st.y * g0.w + b0.w);
            dst[2] = pk2((blo(p.z) - st.x) * st.y * g1.x + b1.x, (bhi(p.z) - st.x) * st.y * g1.y + b1.y);
            dst[3] = pk2((blo(p.w) - st.x) * st.y * g1.z + b1.z, (bhi(p.w) - st.x) * st.y * g1.w + b1.w); }
#pragma unroll
        for (int i = 0; i < 8; ++i) { const int idx = F.tid + NTHR * i, t = idx >> 5, sg = idx & 31;
            const f32x4 wv = *(const f32x4*)(w_s + ((size_t)h * 128 + t) * 128 + sg * 4); const int s0 = sg * 4;
            v2u o; o.x = pk2(s0 <= t ? wv.x : 0.f, s0 + 1 <= t ? wv.y : 0.f); o.y = pk2(s0 + 2 <= t ? wv.z : 0.f, s0 + 3 <= t ? wv.w : 0.f);
            *(LAS v2u*)(WT + (t * WT_LD + s0) * 2) = o; }
        __syncthreads();
        bf16x8 af[4];
#pragma unroll
        for (int ks = 0; ks < 4; ++ks) {
#pragma unroll
            for (int kk = 0; kk < 8; ++kk) af[ks][kk] = (short)*(const LAS unsigned short*)(VT + ((32 * ks + 8 * lq + kk) * VT_LD + 16 * F.wave + lr) * 2);
        }
        v2u uu[8]; float bsv[8];
#pragma unroll
        for (int tb = 0; tb < 8; ++tb) { uu[tb] = *(const v2u*)(UV + (R0 + 16 * tb + lr) * 2048 + h * 128 + 16 * F.wave + 4 * lq); bsv[tb] = b_s[h * 128 + 16 * tb + lr]; }
        v2u oo[8];
#pragma unroll
        for (int tb = 0; tb < 8; ++tb) {
            f32x4 acc = (f32x4){0.f, 0.f, 0.f, 0.f};
#pragma unroll
            for (int ks = 0; ks < 4; ++ks) {
                if (32 * ks <= 16 * tb + 15) {
                    const bf16x8 bfr = *(const LAS bf16x8*)(WT + ((16 * tb + lr) * WT_LD + 32 * ks + 8 * lq) * 2);
                    acc = __builtin_amdgcn_mfma_f32_16x16x32_bf16(af[ks], bfr, acc, 0, 0, 0);
                }
            }
            oo[tb].x = pk2(blo(uu[tb].x) * (acc[0] + bsv[tb]), bhi(uu[tb].x) * (acc[1] + bsv[tb])); oo[tb].y = pk2(blo(uu[tb].y) * (acc[2] + bsv[tb]), bhi(uu[tb].y) * (acc[3] + bsv[tb]));
        }
#pragma unroll
        for (int tb = 0; tb < 8; ++tb) *(v2u*)(UV + (R0 + 16 * tb + lr) * 2048 + h * 128 + 16 * F.wave + 4 * lq) = oo[tb];
        __syncthreads();
    }
}
__device__ __forceinline__ void mixB_sample(const Frame& F0, const Args& a, bf16* UV, int s, float* out_vs) {
    const Frame F = phase_frame(F0);
    LAS float* SV = (LAS float*)F.lds;
    const float* lng = a.in[11]; const float* lnb = a.in[12]; const float* w_s = a.in[13]; const float* b_s = a.in[14];
    const size_t R0 = (size_t)MP + 4 * s;
    if (F.wave < 4) {
        const int t = F.wave; float x[16], mean, rstd; ln_stats16(UV + (R0 + t) * 2048 + 1024, F.lane, x, mean, rstd);
#pragma unroll
        for (int hf = 0; hf < 2; ++hf) { const int c = 512 * hf + 8 * F.lane;
#pragma unroll
            for (int q = 0; q < 2; ++q) { const f32x4 g = *(const f32x4*)(lng + c + 4 * q), b = *(const f32x4*)(lnb + c + 4 * q);
                const f32x4 xv = (f32x4){x[8 * hf + 4 * q], x[8 * hf + 4 * q + 1], x[8 * hf + 4 * q + 2], x[8 * hf + 4 * q + 3]};
                const f32x4 y = (xv - mean) * rstd * g + b;
                *(f32x4*)(out_vs + ((size_t)4 * s + t) * DM + c + 4 * q) = y; *(LAS f32x4*)(SV + t * DM + c + 4 * q) = y; } }
    }
    __syncthreads();
    const int c0 = 2 * F.tid, h = c0 >> 7;
#pragma unroll
    for (int t = 0; t < 4; ++t) {
        const float bsv = b_s[h * 128 + t]; float s0 = bsv, s1 = bsv;
#pragma unroll
        for (int sp = 0; sp <= t; ++sp) { const float wv = w_s[((size_t)h * 128 + t) * 128 + sp]; const f32x2 vv = *(const LAS f32x2*)(SV + sp * DM + c0); s0 += wv * vv.x; s1 += wv * vv.y; }
        unsigned* up = (unsigned*)(UV + (R0 + t) * 2048 + c0); const unsigned uu = *up;
        *up = pk2(blo(uu) * s0, bhi(uu) * s1);
    }
    __syncthreads();
}

__device__ __forceinline__ void ld8f(const float* p, float (&x)[8]) { const f32x4 a = *(const f32x4*)p, b = *(const f32x4*)(p + 4); x[0] = a.x; x[1] = a.y; x[2] = a.z; x[3] = a.w; x[4] = b.x; x[5] = b.y; x[6] = b.z; x[7] = b.w; }
__device__ __forceinline__ void st8f(float* p, const float (&x)[8]) { *(f32x4*)p = (f32x4){x[0], x[1], x[2], x[3]}; *(f32x4*)(p + 4) = (f32x4){x[4], x[5], x[6], x[7]}; }
__device__ __forceinline__ void p6_fixup(const Frame& F0, const Args& a, float* out) {
    const Frame F = phase_frame(F0);
    bf16* ACT = (bf16*)(a.ws + WS_ACT); const float* SL = (const float*)(a.ws + WS_SL); const float* SF = (const float*)(a.ws + WS_SF);
    constexpr int NG = DFF / 8, NIT = 256 * 2 * NG;
    const float* dwf = a.in[19]; const float* bdw = a.in[20];
    for (int it = F.vcu * NTHR + F.tid; it < NIT; it += F.G * NTHR) {
        const int bi = it / NG, cgp = it - bi * NG, c = cgp * 8, blk = bi >> 1, i = bi & 1;
        if ((blk & 31) != 0) {
            float l0[8], l1[8], f0[8], f1[8], fb[8], w0[8], w1[8], w2[8], bs[8];
            ld8f(SL + ((size_t)(blk - 1) * 2 + 0) * DFF + c, l0); ld8f(SL + ((size_t)(blk - 1) * 2 + 1) * DFF + c, l1);
            ld8f(SF + ((size_t)(blk * 2 + 0) * 2 + 0) * DFF + c, f0); ld8f(SF + ((size_t)(blk * 2 + 1) * 2 + 0) * DFF + c, f1); ld8f(SF + ((size_t)(blk * 2 + i) * 2 + 1) * DFF + c, fb);
            ld8f(dwf + c, w0); ld8f(dwf + DFF + c, w1); ld8f(dwf + 2 * DFF + c, w2); ld8f(bdw + c, bs);
            float o[8];
#pragma unroll
            for (int j = 0; j < 8; j += 2) {
                const float x2a = i == 0 ? l0[j] : l1[j], x1a = i == 0 ? l1[j] : f0[j], x0a = i == 0 ? f0[j] : f1[j];
                const float x2b = i == 0 ? l0[j + 1] : l1[j + 1], x1b = i == 0 ? l1[j + 1] : f0[j + 1], x0b = i == 0 ? f0[j + 1] : f1[j + 1];
                f32x2 cv = (f32x2){x2a * w0[j] + x1a * w1[j] + x0a * w2[j] + bs[j], x2b * w0[j + 1] + x1b * w1[j + 1] + x0b * w2[j + 1] + bs[j + 1]};
                cv = pg8::gelu_pk(cv); o[j] = cv.x * fb[j]; o[j + 1] = cv.y * fb[j + 1]; }
            v4u w; w.x = pk2(o[0], o[1]); w.y = pk2(o[2], o[3]); w.z = pk2(o[4], o[5]); w.w = pk2(o[6], o[7]);
            *(v4u*)(ACT + ((size_t)blk * 64 + i) * DFF + c) = w;
        }
        if ((blk & 31) == 31) { float l[8]; ld8f(SL + ((size_t)blk * 2 + i) * DFF + c, l); st8f(out + O_FP + ((size_t)(blk >> 5) * 2 + i) * DFF + c, l); }
    }
}

struct SmallSrc { const bf16* A; int lda; const bf16* Bt; };
template <int NSRC, class Epi>
__device__ __forceinline__ void small_gemm(const Frame& F0, const SmallSrc (&src)[NSRC], int K, int N, const Epi& E) {
    const Frame F = phase_frame(F0);
    const int fr = F.lane & 15, fq = F.lane >> 4;
    const int ntn = N / 32, ntiles = (MS / 32) * ntn;
    for (int tile = F.wave * F.G + F.vcu; tile < ntiles; tile += F.G * NWAVES) {
        const int tm = tile / ntn, tn = tile - tm * ntn;
        f32x4 acc[NSRC][2][2];
#pragma unroll
        for (int sidx = 0; sidx < NSRC; ++sidx) {
            const bf16* ap = src[sidx].A + (size_t)(32 * tm + fr) * src[sidx].lda + 8 * fq;
            const bf16* bp = src[sidx].Bt + (size_t)(32 * tn + fr) * K + 8 * fq;
            const size_t a16 = (size_t)16 * src[sidx].lda, b16 = (size_t)16 * K;
            f32x4 c00 = (f32x4){0.f, 0.f, 0.f, 0.f}, c01 = c00, c10 = c00, c11 = c00;
            bf16x8 a0[2][4], b0[2][4], a1[2][4], b1[2][4];
#define SG_LOAD(A_, B_, kk) do { _Pragma("unroll") for (int i = 0; i < 4; ++i) { A_[0][i] = *(const bf16x8*)(ap + (kk) + 32 * i); A_[1][i] = *(const bf16x8*)(ap + a16 + (kk) + 32 * i); \
        B_[0][i] = *(const bf16x8*)(bp + (kk) + 32 * i); B_[1][i] = *(const bf16x8*)(bp + b16 + (kk) + 32 * i); } } while (0)
#define SG_MMA(A_, B_) do { _Pragma("unroll") for (int i = 0; i < 4; ++i) { c00 = __builtin_amdgcn_mfma_f32_16x16x32_bf16(B_[0][i], A_[0][i], c00, 0, 0, 0); c01 = __builtin_amdgcn_mfma_f32_16x16x32_bf16(B_[1][i], A_[0][i], c01, 0, 0, 0); \
        c10 = __builtin_amdgcn_mfma_f32_16x16x32_bf16(B_[0][i], A_[1][i], c10, 0, 0, 0); c11 = __builtin_amdgcn_mfma_f32_16x16x32_bf16(B_[1][i], A_[1][i], c11, 0, 0, 0); } } while (0)
            SG_LOAD(a0, b0, 0);
#pragma unroll 1
            for (int k = 0; k < K; k += 256) {
                SG_LOAD(a1, b1, k + 128);
                SG_MMA(a0, b0);
                if (k + 256 < K) SG_LOAD(a0, b0, k + 256);
                SG_MMA(a1, b1);
            }
#undef SG_LOAD
#undef SG_MMA
            acc[sidx][0][0] = c00; acc[sidx][0][1] = c01; acc[sidx][1][0] = c10; acc[sidx][1][1] = c11;
        }
#pragma unroll
        for (int i = 0; i < 2; ++i)
#pragma unroll
            for (int j = 0; j < 2; ++j) { f32x4 sub[NSRC];
#pragma unroll
                for (int sidx = 0; sidx < NSRC; ++sidx) sub[sidx] = acc[sidx][i][j];
                E(sub, 32 * tm + 16 * i + fr, 32 * tn + 16 * j + 4 * fq, fq); }
    }
}
struct SEpiMerge {
    bf16* MG; const bf16* GG;
    __device__ __forceinline__ void operator()(const f32x4 (&acc)[2], int r, int c, int fq) const {
        const size_t row = (size_t)MP + r;
        const v2u ga = *(const v2u*)(GG + row * 2048 + c), gb = *(const v2u*)(GG + row * 2048 + 1024 + c);
        v2u o; o.x = pk2(blo(ga.x) * acc[0][0] + blo(gb.x) * acc[1][0], bhi(ga.x) * acc[0][1] + bhi(gb.x) * acc[1][1]);
        o.y = pk2(blo(ga.y) * acc[0][2] + blo(gb.y) * acc[1][2], bhi(ga.y) * acc[0][3] + bhi(gb.y) * acc[1][3]);
        *(v2u*)(MG + row * DM + c) = o;
    }
};
template <bool RB16> struct SEpiRes {
    const float* R; const bf16* RB; float* Y; bf16* YB; float* ss;
    __device__ __forceinline__ void operator()(const f32x4 (&acc)[1], int r, int c, int fq) const {
        const size_t off = (size_t)r * DM + c;
        f32x4 h;
        if (RB16) { const v2u p = *(const v2u*)(RB + off); h = (f32x4){blo(p.x), bhi(p.x), blo(p.y), bhi(p.y)} + acc[0]; *(f32x4*)(Y + off) = h; }
        else { h = *(const f32x4*)(R + off) + acc[0]; v2u w; w.x = pk2(h[0], h[1]); w.y = pk2(h[2], h[3]); *(v2u*)(YB + off) = w; }
        float sq = (h[0] * h[0] + h[1] * h[1]) + (h[2] * h[2] + h[3] * h[3]);
        sq += __shfl_xor(sq, 16); sq += __shfl_xor(sq, 32);
        if (fq == 0) atomicAdd(ss + r, sq);
    }
};

__global__ void __launch_bounds__(NTHR, 2) fwd_mega(Args a) {
    extern __shared__ __attribute__((aligned(16))) unsigned char lds_raw[];
    cg::grid_group grid = cg::this_grid();
    Frame F; F.lds = (LAS unsigned char*)lds_raw; F.tid = threadIdx.x; F.lane = F.tid & 63; F.wave = __builtin_amdgcn_readfirstlane(F.tid >> 6);
    F.G = gridDim.x; { const int bx = blockIdx.x; F.vcu = (F.G % 8 == 0) ? (bx % 8) * (F.G / 8) + bx / 8 : bx; }
    unsigned char* ws = a.ws; float* out = a.out;
    volatile LAS unsigned* bst = (volatile LAS unsigned*)(F.lds + 131072 + 64);
    if (F.tid < 2) bst[F.tid] = 0u;
    __syncthreads();
    bf16* XN = (bf16*)(ws + WS_XN); bf16* GLU = (bf16*)(ws + WS_GLU); bf16* UV = (bf16*)(ws + WS_UV); bf16* GG = (bf16*)(ws + WS_GG);
    bf16* MG = (bf16*)(ws + WS_MG); bf16* ACT = (bf16*)(ws + WS_ACT); bf16* ACTA = (bf16*)(out + O_Y);
    float* ss1 = (float*)(ws + WS_SS1); float* ss2 = (float*)(ws + WS_SS2);

    const XcdBarrier bar = xcd_barrier_post((unsigned*)(ws + WS_BAR), bst);
    if (a.ws == nullptr) grid.sync();
    p0_weights(F, a, 0, I_IN, F.vcu * NWAVES + F.wave, F.G * NWAVES);
    p0_rows(F, a);
    xcd_barrier(bar);
    { pg8::Gemm g{XN, (const bf16*)(ws + WS_WIN), MT, NIN, DM, DM}; pg8::StaticOrder S; S.init(MT, NIN, F.G, (int)blockIdx.x);
      pg8::EpiG1 E{GLU, UV, GG};
      pg8::gemm_phase<pg8::EpiG1, pg8::StaticOrder, true, true>(F.lds, g, S, E);
      const int nu = (MT / 256) * (NIN / 256), extra = nu % F.G;
      if (extra == 0) p0_weights(F, a, I_IN, NITEMS, (int)blockIdx.x * NWAVES + F.wave, F.G * NWAVES);
      else if ((int)blockIdx.x >= extra) p0_weights(F, a, I_IN, NITEMS, ((int)blockIdx.x - extra) * NWAVES + F.wave, (F.G - extra) * NWAVES); }
    xcd_barrier(bar);
    for (int u = F.vcu; u < 256; u += F.G) {
        mixB_prompt(F, a, UV, u >> 1, u & 1);
        { const int b = u >> 5, t0 = (u & 31) * 64; const bool last = (u & 31) == 31;
          convA_prompt(F, a, (const unsigned*)GLU, ACTA, (size_t)b * SEQ + t0, t0 > 0, last ? out + O_CAP + (size_t)b * 30 * DM : nullptr); }
        if (u < 128) convA_sample(F, a, (const unsigned*)GLU, ACTA, u, a.in[2] + (size_t)u * 30 * DM, out + O_CAS + (size_t)u * 30 * DM);
        else mixB_sample(F, a, UV, u - 128, out + O_VS);
    }
    xcd_barrier(bar);
    { const SmallSrc src[2] = {{ACTA + (size_t)MP * 2048, 2048, (const bf16*)(ws + WS_WA)}, {UV + (size_t)MP * 2048, 2048, (const bf16*)(ws + WS_WB)}};
      SEpiMerge E{MG, GG}; small_gemm<2, SEpiMerge>(F, src, DM, DM, E); }
    { pg8::Gemm g{ACTA, (const bf16*)(ws + WS_WA), MP, DM, DM, 2048, UV, (const bf16*)(ws + WS_WB)}; pg8::PairOrder S; S.init(MP, DM, F.G, (int)blockIdx.x);
      pg8::EpiMerge E{MG, GG};
      pg8::gemm_phase<pg8::EpiMerge, pg8::PairOrder, true, true>(F.lds, g, S, E); }
    xcd_barrier(bar);
    { const SmallSrc src[1] = {{MG + (size_t)MP * DM, DM, (const bf16*)(ws + WS_WO)}};
      SEpiRes<false> E{a.in[1], nullptr, nullptr, XN + (size_t)MP * DM, ss1 + MP}; small_gemm<1, SEpiRes<false>>(F, src, DM, DM, E); }
    { pg8::Gemm g{MG, (const bf16*)(ws + WS_WO), MP, DM, DM, DM}; pg8::StaticOrder S; S.init(MP, DM, F.G, (int)blockIdx.x);
      pg8::EpiRes<false> E{a.in[0], nullptr, nullptr, XN, ss1};
      pg8::gemm_phase<pg8::EpiRes<false>, pg8::StaticOrder, true, true>(F.lds, g, S, E); }
    xcd_barrier(bar);
    { pg8::Gemm g{XN, (const bf16*)(ws + WS_WUP), MT, NUP, DM, DM}; pg8::StaticOrder S; S.init(MT, NUP, F.G, (int)blockIdx.x);
      pg8::EpiUpFused E{ACT, ss1, a.in[19], a.in[20], a.in[3], (float*)(ws + WS_SL), (float*)(ws + WS_SF), out + O_FS};
      pg8::gemm_phase<pg8::EpiUpFused, pg8::StaticOrder, true, true>(F.lds, g, S, E); }
    xcd_barrier(bar);
    p6_fixup(F, a, out);
    xcd_barrier(bar);
    { const SmallSrc src[1] = {{ACT + (size_t)MP * DFF, DFF, (const bf16*)(ws + WS_WDN)}};
      SEpiRes<true> E{nullptr, XN + (size_t)MP * DM, out + O_Y + (size_t)MP * DM, nullptr, ss2 + MP}; small_gemm<1, SEpiRes<true>>(F, src, DFF, DM, E); }
    { pg8::Gemm g{ACT, (const bf16*)(ws + WS_WDN), MP, DM, DFF, DFF}; pg8::StaticOrder S; S.init(MP, DM, F.G, (int)blockIdx.x);
      pg8::EpiRes<true> E{nullptr, XN, out + O_Y, nullptr, ss2};
      pg8::gemm_phase<pg8::EpiRes<true>, pg8::StaticOrder, true, true>(F.lds, g, S, E); }
    xcd_barrier(bar);
    { const Frame F8 = phase_frame(F); const f32x4* gr = (const f32x4*)a.in[22] + F8.lane;
      const int NGW = F.G * NWAVES;
      for (int m = F8.vcu * NWAVES + F8.wave; m < MT; m += 4 * NGW) {
          f32x4 v[4][4]; float rstd[4];
#pragma unroll
          for (int q = 0; q < 4; ++q) { const int mq = (m + q * NGW < MT) ? m + q * NGW : m; const f32x4* yr = (const f32x4*)(out + O_Y + (size_t)mq * DM) + F8.lane;
              rstd[q] = ss2[mq];
#pragma unroll
              for (int j = 0; j < 4; ++j) v[q][j] = yr[64 * j]; }
#pragma unroll
          for (int q = 0; q < 4; ++q) { if (m + q * NGW < MT) { f32x4* yw = (f32x4*)(out + O_Y + (size_t)(m + q * NGW) * DM) + F8.lane; const float r = 1.0f / sqrtf(rstd[q] * (1.f / DM) + EPS);
#pragma unroll
              for (int j = 0; j < 4; ++j) yw[64 * j] = v[q][j] * r * gr[64 * j]; } } } }
}

extern "C" void kernel_launch(void* const* d_in, const int* in_sizes, int n_in, void* d_out, int out_size, void* d_ws, size_t ws_size, hipStream_t stream) {
    static int grid = 0;
    if (grid == 0) {
        if (n_in != 23 || (size_t)out_size != O_END || ws_size < WS_END) { fprintf(stderr, "kernel_launch: unexpected shapes: n_in %d out %d ws %zu\n", n_in, out_size, ws_size); grid = -1; return; }
        int dev = 0, cus = 0, per_cu = 0;
        if (hipGetDevice(&dev) != hipSuccess || hipDeviceGetAttribute(&cus, hipDeviceAttributeMultiprocessorCount, dev) != hipSuccess) { grid = -1; return; }
        if (hipFuncSetAttribute((const void*)fwd_mega, hipFuncAttributeMaxDynamicSharedMemorySize, LDS_BYTES) != hipSuccess) { fprintf(stderr, "kernel_launch: hipFuncSetAttribute failed\n"); grid = -1; return; }
        if (hipOccupancyMaxActiveBlocksPerMultiprocessor(&per_cu, (const void*)fwd_mega, NTHR, LDS_BYTES) != hipSuccess || per_cu < 1) { fprintf(stderr, "kernel_launch: occupancy query says %d\n", per_cu); per_cu = 1; }
        (void)hipGetLastError();
        grid = cus * 1;
        fprintf(stderr, "kernel_launch: cus %d per_cu %d grid %d\n", cus, per_cu, grid);
    }
    if (grid < 0) return;
    if (hipMemsetAsync((char*)d_ws + WS_BAR, 0, XCD_BAR_WORDS * 4, stream) != hipSuccess) { fprintf(stderr, "kernel_launch: memset failed\n"); return; }
    Args a{};
    for (int i = 0; i < 23; ++i) a.in[i] = (const float*)d_in[i];
    a.out = (float*)d_out; a.ws = (unsigned char*)d_ws;
    void* args[] = {&a};
    hipError_t e = hipLaunchCooperativeKernel((const void*)fwd_mega, dim3(grid), dim3(NTHR), args, LDS_BYTES, stream);
    if (e != hipSuccess) fprintf(stderr, "kernel_launch: cooperative launch failed: %s (grid %d)\n", hipGetErrorString(e), grid);
}
```
